# Optimizing an MI355X kernel written in HIP

```python
import jax, jax.numpy as jnp
from jax import lax
import numpy as np

D_MODEL = 1024
BATCH = 16
SEQ = 4096
DEPTH = 1

PLE_DIM = 256
POOL_GROUPS = 4
POOL_WINDOWS = (2, 4, 8, 16)
POOL_CH = D_MODEL // 8
POOL_W = POOL_GROUPS * POOL_CH
N_HEADS = 8
HEAD_DIM = 64
ATT_W = N_HEADS * HEAD_DIM
Q_BLOCK = 128
N_BRANCH = 2
IN_W = POOL_W + 3 * ATT_W + N_BRANCH * D_MODEL
N_EXPERTS = 32
TOP_K = 4
D_EXPERT = D_MODEL
SWIGLU_LIMIT = 7.0
SWIGLU_ALPHA = 1.702
EXPERT_BLOCK = 512
EPS = 1e-6

kernel_name = "hybrid_pool_stickbreak_moe_ple"


def rmsnorm(x, g):
    xf = x.astype(jnp.float32)
    y = xf * lax.rsqrt(jnp.mean(xf * xf, axis=-1, keepdims=True) + EPS)
    return (y * g.astype(jnp.float32)).astype(x.dtype)


def causal_multiscale_pool(u):
    s = u.shape[1]
    uf = u.astype(jnp.float32)
    csum = jnp.cumsum(uf, axis=1)
    t = jnp.arange(s)
    outs = []
    for g, w in enumerate(POOL_WINDOWS):
        c = csum[:, :, g]
        lag = jnp.pad(c, ((0, 0), (w, 0), (0, 0)))[:, :s]
        count = jnp.minimum(t + 1, w).astype(jnp.float32)[None, :, None]
        outs.append((c - lag) / count - uf[:, :, g])
    return jnp.stack(outs, axis=2).astype(u.dtype)


def stick_breaking_attention(q, k, v):
    s = q.shape[2]
    scale = HEAD_DIM ** -0.5
    outs = []
    for blk in range(s // Q_BLOCK):
        q0 = blk * Q_BLOCK
        kv_len = q0 + Q_BLOCK
        qb = q[:, :, q0:kv_len]
        kb = k[:, :, :kv_len]
        vb = v[:, :, :kv_len]
        z = jnp.einsum('bhqd,bhkd->bhqk', qb, kb).astype(jnp.float32) * scale
        t_pos = q0 + jnp.arange(Q_BLOCK)
        s_pos = jnp.arange(kv_len)
        mask = s_pos[None, :] < t_pos[:, None]
        log_keep = jnp.where(mask, -jax.nn.softplus(z), 0.0)
        later = lax.cumsum(log_keep, axis=3, reverse=True) - log_keep
        weights = jnp.where(mask, jnp.exp(jax.nn.log_sigmoid(z) + later), 0.0)
        outs.append(jnp.einsum('bhqk,bhkd->bhqd', weights.astype(v.dtype), vb))
    return jnp.concatenate(outs, axis=2)


def hybrid_mixer(h, w_in, w_pool_grp, pool_scale, w_pool_up, w_attn_up, w_out):
    b, s, _ = h.shape
    proj = h @ w_in
    u, q, k, v, gate_logits = jnp.split(
        proj, [POOL_W, POOL_W + ATT_W, POOL_W + 2 * ATT_W, POOL_W + 3 * ATT_W], axis=-1)
    pooled = causal_multiscale_pool(u.reshape(b, s, POOL_GROUPS, POOL_CH))
    y_pool = jnp.einsum('bsgc,gcd->bsgd', pooled, w_pool_grp).reshape(b, s, POOL_W) * pool_scale
    to_heads = lambda t: t.reshape(b, s, N_HEADS, HEAD_DIM).transpose(0, 2, 1, 3)
    o = stick_breaking_attention(to_heads(q), to_heads(k), to_heads(v))
    y_att = o.transpose(0, 2, 1, 3).reshape(b, s, ATT_W)
    g_pool, g_att = jnp.split(jax.nn.sigmoid(gate_logits), 2, axis=-1)
    merged = g_pool * (y_pool @ w_pool_up) + g_att * (y_att @ w_attn_up)
    return merged @ w_out


def moe_ffn(h, w_router, b_router, w_gu, b_gu, w_down, b_down):
    b, s, d = h.shape
    n_tok = b * s
    n_assign = n_tok * TOP_K
    xt = h.reshape(n_tok, d)
    logits = (xt @ w_router + b_router).astype(jnp.float32)
    top_logit, top_e = lax.top_k(logits, TOP_K)
    top_w = jax.nn.softmax(top_logit, axis=-1)
    flat_e = top_e.reshape(-1)
    order = jnp.argsort(flat_e)
    sorted_e = flat_e[order]
    token_of = order // TOP_K
    counts = jax.ops.segment_sum(jnp.ones_like(flat_e), flat_e, num_segments=N_EXPERTS)
    starts = jnp.cumsum(counts) - counts
    padded = (counts + EXPERT_BLOCK - 1) // EXPERT_BLOCK * EXPERT_BLOCK
    pad_ends = jnp.cumsum(padded)
    pad_starts = pad_ends - padded
    dest = pad_starts[sorted_e] + jnp.arange(n_assign) - starts[sorted_e]
    n_blocks = -(-n_assign // EXPERT_BLOCK) + N_EXPERTS
    n_pad = n_blocks * EXPERT_BLOCK
    buf = jnp.zeros((n_pad, d), h.dtype).at[dest].set(xt[token_of])
    block_e = jnp.minimum(
        jnp.searchsorted(pad_ends, jnp.arange(n_blocks) * EXPERT_BLOCK, side='right'),
        N_EXPERTS - 1)

    def expert_block(args):
        xb, e = args
        gu = xb @ w_gu[e] + b_gu[e]
        gate = jnp.minimum(gu[:, :D_EXPERT], SWIGLU_LIMIT)
        up = jnp.clip(gu[:, D_EXPERT:], -SWIGLU_LIMIT, SWIGLU_LIMIT)
        glu = gate * jax.nn.sigmoid(SWIGLU_ALPHA * gate)
        return ((up + 1.0) * glu) @ w_down[e] + b_down[e]

    y_buf = lax.map(expert_block, (buf.reshape(n_blocks, EXPERT_BLOCK, d), block_e)).reshape(n_pad, d)
    contrib = y_buf[dest].astype(jnp.float32) * top_w.reshape(-1)[order][:, None]
    out = jax.ops.segment_sum(contrib, token_of, num_segments=n_tok)
    return out.astype(h.dtype).reshape(b, s, d)


def setup_inputs(seed: int = 0) -> dict:
    key = jax.random.key(seed)
    ks = jax.random.split(key, 24)
    f32 = jnp.float32

    def nrm(k, shape, fan_in):
        return jax.random.normal(k, shape, f32) * (fan_in ** -0.5)

    def gain(k, shape):
        return 1.0 + 0.02 * jax.random.normal(k, shape, f32)

    def bias(k, shape, sc=0.02):
        return sc * jax.random.normal(k, shape, f32)

    return {
        "x": jax.random.normal(ks[0], (BATCH, SEQ, D_MODEL), f32),
        "p": jax.random.normal(ks[1], (DEPTH, BATCH, SEQ, PLE_DIM), f32),
        "g_mix": gain(ks[2], (DEPTH, D_MODEL)),
        "w_in": nrm(ks[3], (DEPTH, D_MODEL, IN_W), D_MODEL),
        "w_pool_grp": nrm(ks[4], (DEPTH, POOL_GROUPS, POOL_CH, POOL_CH), POOL_CH),
        "pool_scale": gain(ks[5], (DEPTH, POOL_W)),
        "w_pool_up": nrm(ks[6], (DEPTH, POOL_W, D_MODEL), POOL_W),
        "w_attn_up": nrm(ks[7], (DEPTH, ATT_W, D_MODEL), ATT_W),
        "w_out": nrm(ks[8], (DEPTH, D_MODEL, D_MODEL), D_MODEL),
        "g_ffn": gain(ks[9], (DEPTH, D_MODEL)),
        "w_router": nrm(ks[10], (DEPTH, D_MODEL, N_EXPERTS), D_MODEL),
        "b_router": bias(ks[11], (DEPTH, N_EXPERTS), 0.01),
        "w_gu": nrm(ks[12], (DEPTH, N_EXPERTS, D_MODEL, 2 * D_EXPERT), D_MODEL),
        "b_gu": bias(ks[13], (DEPTH, N_EXPERTS, 2 * D_EXPERT)),
        "w_down": nrm(ks[14], (DEPTH, N_EXPERTS, D_EXPERT, D_MODEL), D_EXPERT),
        "b_down": bias(ks[15], (DEPTH, N_EXPERTS, D_MODEL)),
        "g_ple": gain(ks[16], (DEPTH, D_MODEL)),
        "w_ple_gate": nrm(ks[17], (DEPTH, D_MODEL, D_MODEL), D_MODEL),
        "w_ple_proj": nrm(ks[18], (DEPTH, PLE_DIM, D_MODEL), PLE_DIM),
        "g_final": gain(ks[19], (D_MODEL,)),
    }


def reference(x, p, g_mix, w_in, w_pool_grp, pool_scale, w_pool_up, w_attn_up, w_out,
              g_ffn, w_router, b_router, w_gu, b_gu, w_down, b_down,
              g_ple, w_ple_gate, w_ple_proj, g_final):
    for i in range(DEPTH):
        h = rmsnorm(x, g_mix[i])
        x = x + hybrid_mixer(h, w_in[i], w_pool_grp[i], pool_scale[i],
                             w_pool_up[i], w_attn_up[i], w_out[i])
        h = rmsnorm(x, g_ffn[i])
        x = x + moe_ffn(h, w_router[i], b_router[i], w_gu[i], b_gu[i], w_down[i], b_down[i])
        hp = rmsnorm(x, g_ple[i])
        x = x + jax.nn.sigmoid(hp @ w_ple_gate[i]) * (p[i] @ w_ple_proj[i])
    return rmsnorm(x, g_final)
```

```cpp
#include <hip/hip_runtime.h>
#include <cstdio>
#include <cstdint>

#ifndef MK_SPLIT
#define MK_SPLIT 1
#endif

#define GAS __attribute__((address_space(1)))
#define LAS __attribute__((address_space(3)))
typedef unsigned short bf16;
typedef unsigned v4u __attribute__((ext_vector_type(4)));
typedef unsigned v2u __attribute__((ext_vector_type(2)));
typedef int v4i __attribute__((ext_vector_type(4)));
typedef float f32x2 __attribute__((ext_vector_type(2)));
typedef float f32x4 __attribute__((ext_vector_type(4)));
typedef float f32x16 __attribute__((ext_vector_type(16)));
typedef short bf16x8 __attribute__((ext_vector_type(8)));
typedef __bf16 bf16x2_t __attribute__((ext_vector_type(2)));
typedef GAS unsigned gu32;

constexpr int NB = 16, SEQ = 4096, M = NB * SEQ, D = 1024, NH = 8, HD = 64, PW = 512, AW = 512, NE = 32, TOPK = 4, DE = 1024, PLE = 256;
constexpr int NPROJ_A = 3584;
constexpr float EPS = 1e-6f;
constexpr float LOG2E = 1.4426950408889634f;
constexpr float QSCALE = 0.125f * LOG2E;
constexpr float ATT_THR = 152.0f;
constexpr int NWAVES = 8;
constexpr int NPH = 19;

constexpr size_t MiB = 1u << 20;
constexpr size_t WS_CTL = 0, CTL_ZERO_BYTES = 1 * MiB;
constexpr size_t WS_R2 = 1 * MiB;
constexpr size_t WS_R3 = WS_R2 + 256 * 1024;
constexpr size_t WS_TKE = 2 * MiB;
constexpr size_t WS_TKW = 3 * MiB;
constexpr size_t WS_TKR = 4 * MiB;
constexpr size_t WS_ROWT = 5 * MiB;
constexpr size_t WS_ROWW = 6 * MiB;
constexpr size_t WS_ROWR = 7 * MiB;
constexpr size_t WS_CNTWG = 8 * MiB;
constexpr size_t WS_SEGTOT = WS_CNTWG + 256 * 1024;
constexpr size_t WS_WRF = 9 * MiB;
constexpr size_t WS_WIN = 16 * MiB;
constexpr size_t WS_WEFF = 24 * MiB;
constexpr size_t WS_WAU = 25 * MiB;
constexpr size_t WS_WOUT = 26 * MiB;
constexpr size_t WS_WPG = 28 * MiB;
constexpr size_t WS_WPP = 30 * MiB;
constexpr size_t WS_WGU = 32 * MiB;
constexpr size_t WS_WDN = 160 * MiB;
constexpr size_t WS_A = 224 * MiB;
constexpr size_t WS_B = 352 * MiB;
constexpr size_t WS_C = 480 * MiB;
constexpr size_t WS_E = 608 * MiB;
constexpr size_t WS_PB = 736 * MiB;
constexpr size_t WS_END = 768 * MiB;
constexpr int CW_BAR = 4096;

constexpr int RING_BYTES = 131072;
constexpr int LDSCTL_OFF = RING_BYTES, MISC_OFF = LDSCTL_OFF + 320;
constexpr int LDS_TAB_OFF = MISC_OFF + 128;
constexpr int LDS_BYTES = 147456;

#define RLX_AGENT __ATOMIC_RELAXED, __HIP_MEMORY_SCOPE_AGENT
#define LDS_WAIT() asm volatile("s_waitcnt lgkmcnt(0)" ::: "memory")
#define VM_WAIT() asm volatile("s_waitcnt vmcnt(0)" ::: "memory")

__device__ __forceinline__ unsigned f2bf(float f) { unsigned u = __builtin_bit_cast(unsigned, f); return (u + 0x7fffu + ((u >> 16) & 1u)) >> 16; }
__device__ __forceinline__ unsigned pk2(float lo, float hi) { f32x2 v = {lo, hi}; bf16x2_t b = __builtin_convertvector(v, bf16x2_t); return __builtin_bit_cast(unsigned, b); }
__device__ __forceinline__ float bflo(unsigned u) { return __builtin_bit_cast(float, u << 16); }
__device__ __forceinline__ float bfhi(unsigned u) { return __builtin_bit_cast(float, u & 0xffff0000u); }
__device__ __forceinline__ float fast_sigmoid(float v) { return __builtin_amdgcn_rcpf(1.0f + __builtin_amdgcn_exp2f(-LOG2E * v)); }
__device__ __forceinline__ float wave_sum(float v) {
#pragma unroll
    for (int o = 1; o < 64; o <<= 1) v += __shfl_xor(v, o);
    return v;
}

#define XB_TMO      128
#define XB_XCNT(j)  (256  + 64 * (j))
#define XB_XSUB(j)  (1280 + 64 * (j))
#define XB_XGEN(j)  (2304 + 64 * (j))
#define XB_TOP      3328
#define XB_TOPGEN   3392
#define XCD_BAR_WORDS 3456
#define XB_SPIN_CAP (1u << 18)
__device__ __forceinline__ unsigned xb_ld(unsigned* p)              { return __hip_atomic_load(p, __ATOMIC_RELAXED, __HIP_MEMORY_SCOPE_AGENT); }
__device__ __forceinline__ unsigned xb_add(unsigned* p, unsigned v) { return __hip_atomic_fetch_add(p, v, __ATOMIC_RELAXED, __HIP_MEMORY_SCOPE_AGENT); }
__device__ __forceinline__ unsigned xb_xcc_id() { return (unsigned)__builtin_amdgcn_s_getreg((3 << 11) | 20) & 0xFu; }
#define XB_SPIN(cond, bar) do { unsigned _sp = 0; while (cond) { __builtin_amdgcn_s_sleep(1); \
    if ((++_sp & 255u) == 0u) { if (xb_ld(&(bar)[XB_TMO])) break; if (_sp > XB_SPIN_CAP) { atomicAdd(&(bar)[XB_TMO], 1u); break; } } } } while (0)
struct XcdBarrier { unsigned* bar; unsigned x; volatile LAS unsigned* st; };
__device__ __forceinline__ XcdBarrier xcd_barrier_post(unsigned* bar, volatile LAS unsigned* st) {
    XcdBarrier b; b.bar = bar; b.x = xb_xcc_id(); b.st = st;
    if (threadIdx.x == 0) (void)xb_add(&bar[XB_XCNT(b.x)], 1u);
    return b;
}
__device__ __forceinline__ void xcd_barrier_complete(unsigned* bar, unsigned x, unsigned& nloc, unsigned& nx) {
    const unsigned G = gridDim.x * gridDim.y * gridDim.z;
    unsigned sum, cnt, mine, sp = 0u;
    for (;;) {
        sum = 0u; cnt = 0u; mine = 0u;
#pragma unroll
        for (unsigned j = 0; j < 16; ++j) { const unsigned c = xb_ld(&bar[XB_XCNT(j)]); sum += c; cnt += (c > 0u) ? 1u : 0u; mine = (j == x) ? c : mine; }
        if (sum == G) break;
        __builtin_amdgcn_s_sleep(1);
        if ((++sp & 255u) == 0u) { if (xb_ld(&bar[XB_TMO])) break; if (sp > XB_SPIN_CAP) { atomicAdd(&bar[XB_TMO], 1u); break; } }
    }
    nloc = mine > 0u ? mine : 1u; nx = cnt > 0u ? cnt : 1u;
}
__device__ __forceinline__ void xcd_barrier(const XcdBarrier& b) {
    asm volatile("s_waitcnt vmcnt(0)" ::: "memory");
    __syncthreads();
    if (threadIdx.x == 0) {
        unsigned* bar = b.bar;
        __builtin_amdgcn_s_waitcnt(0);
        unsigned nloc = b.st[0], nx = b.st[1];
        if (nloc == 0u) { xcd_barrier_complete(bar, b.x, nloc, nx); b.st[0] = nloc; b.st[1] = nx; }
        const unsigned old = xb_add(&bar[XB_XSUB(b.x)], 1u);
        const unsigned gen = old / nloc;
        if (old + 1u == (gen + 1u) * nloc) {
            __builtin_amdgcn_fence(__ATOMIC_RELEASE, "agent");
            asm volatile("s_waitcnt vmcnt(0)" ::: "memory");
            const unsigned og = xb_add(&bar[XB_TOP], 1u);
            const unsigned tg = og / nx;
            if (og + 1u == (tg + 1u) * nx) xb_add(&bar[XB_TOPGEN], 1u);
            else XB_SPIN(xb_ld(&bar[XB_TOPGEN]) == tg, bar);
            __builtin_amdgcn_fence(__ATOMIC_ACQUIRE, "agent");
            xb_add(&bar[XB_XGEN(b.x)], 1u);
            asm volatile("s_waitcnt vmcnt(0)" ::: "memory");
        } else {
            XB_SPIN(xb_ld(&bar[XB_XGEN(b.x)]) == gen, bar);
            __builtin_amdgcn_fence(__ATOMIC_ACQUIRE, "agent");
            asm volatile("s_waitcnt vmcnt(0)" ::: "memory");
        }
    }
    __syncthreads();
}

namespace pg8 {
constexpr int BM = 256, BK = 64, HALF = 128, HTB = HALF * BK * 2, NXCD = 8, WGM = 8;
__host__ __device__ __forceinline__ int lds_byte(int r, int c) { const int st = (r >> 4) * 2 + (c >> 5), rr = r & 15, cc = c & 31, ob = rr * 64 + cc * 2; return st * 1024 + (ob ^ (((ob >> 9) & 1) << 5)); }
__host__ __device__ __forceinline__ void stage_rc(int b, int& R, int& C) { const int st = b / 1024, sb = b % 1024, swz = sb ^ (((sb >> 9) & 1) << 5); R = (st >> 1) * 16 + swz / 64; C = (st & 1) * 32 + (swz % 64) / 2; }
__host__ __device__ __forceinline__ int perm32(int rho) { const int n = rho >> 4, i = rho & 15; return 8 * (i >> 2) + 4 * n + (i & 3); }

struct Unit { int pm, pn, e, row0, nvalid; };
struct Gemm { const bf16* A; const bf16* Bt; int K; };

struct StaticOrder {
    int nM, nN, nwg, G, c;
    __device__ void init(int Mr, int N, int G_, int c_) { nM = Mr / BM; nN = N / BM; nwg = nM * nN; G = G_; c = c_; }
    __device__ __forceinline__ bool next(int i, Unit& u) const {
        const long L = (long)i * G + c; if (L >= nwg) return false;
        int wgid = (int)L; { const int q = nwg / NXCD, r = nwg % NXCD, xcd = wgid % NXCD, off = wgid / NXCD; wgid = (xcd < r ? xcd * (q + 1) : r * (q + 1) + (xcd - r) * q) + off; }
        const int nig = WGM * nN, gid = wgid / nig, fm = gid * WGM, gsz = (nM - fm) < WGM ? (nM - fm) : WGM;
        u.pm = fm + ((wgid % nig) % gsz); u.pn = (wgid % nig) / gsz; u.e = 0; u.row0 = u.pm * BM; u.nvalid = BM; return true;
    }
    __device__ __forceinline__ void a_off(const Unit& u, const int (&Rl)[2], const int (&Cl)[2], int K, unsigned (&va)[2][2]) const {
#pragma unroll
        for (int h = 0; h < 2; ++h)
#pragma unroll
            for (int i = 0; i < 2; ++i) va[h][i] = (unsigned)((u.pm * BM + h * HALF + Rl[i]) * K + Cl[i]) * 2u;
    }
    __device__ __forceinline__ const char* b_ptr(const Unit& u, const Gemm& g) const { return (const char*)g.Bt + (size_t)u.pn * BM * g.K * 2; }
};

template <class Epi, class Sched, bool ALIGN_EPI>
__device__ __forceinline__ void gemm_phase(LAS unsigned char* lds, const Gemm g, const Sched& S, const Epi& E) {
    const int tid = threadIdx.x, wid = __builtin_amdgcn_readfirstlane(tid >> 6), lane = tid & 63, wr = wid >> 2, wc = wid & 3, fr = lane & 15, fq = lane >> 4;
    const int K = g.K, nt = K / BK;
    int Rl[2], Cl[2]; unsigned voffB[2];
#pragma unroll
    for (int i = 0; i < 2; ++i) { int R, C; stage_rc(tid * 16 + i * 8192, R, C); const int Rb = Epi::PERM ? ((R & ~31) + perm32(R & 31)) : R;
        Rl[i] = R; Cl[i] = C; voffB[i] = (unsigned)(Rb * K + C) * 2u; }
    const size_t kstep = (size_t)(BK * 2);
    const size_t hstep = (size_t)HALF * K * 2;
    const unsigned ldsw = (unsigned)wid * 1024u;
    const int aoff = lds_byte(wr * 64 + fr, fq * 8), boff = lds_byte(wc * 32 + fr, fq * 8);
#define PG8_SA(b, h) (((b) * 2 + (h)) * HTB)
#define PG8_SB(b, h) ((4 + (b) * 2 + (h)) * HTB)
#define PG8_STAGE(bufoff, gbase, voff) do { _Pragma("unroll") for (int _i = 0; _i < 2; ++_i) \
        __builtin_amdgcn_global_load_lds((const unsigned*)((const char*)(gbase) + (voff)[_i]), (LAS unsigned*)(lds + (bufoff) + ldsw + _i * 8192), 16, 0, 0); } while (0)
#define PG8_LDA(dst, b, h) do { _Pragma("unroll") for (int m = 0; m < 4; ++m) _Pragma("unroll") for (int k = 0; k < 2; ++k) dst[m][k] = *(const LAS bf16x8*)(lds + PG8_SA(b, h) + aoff + m * 2048 + k * 1024); } while (0)
#define PG8_LDB(dst, b, h) do { _Pragma("unroll") for (int n = 0; n < 2; ++n) _Pragma("unroll") for (int k = 0; k < 2; ++k) dst[n][k] = *(const LAS bf16x8*)(lds + PG8_SB(b, h) + boff + n * 2048 + k * 1024); } while (0)
#define PG8_MMA(ai, bj, At, Bt) do { __builtin_amdgcn_s_setprio(1); _Pragma("unroll") for (int m = 0; m < 4; ++m) _Pragma("unroll") for (int n = 0; n < 2; ++n) _Pragma("unroll") for (int k = 0; k < 2; ++k) \
        acc[ai][bj][m][n] = __builtin_amdgcn_mfma_f32_16x16x32_bf16(Bt[n][k], At[m][k], acc[ai][bj][m][n], 0, 0, 0); __builtin_amdgcn_s_setprio(0); } while (0)
#define PG8_WAIT_V(n) asm volatile("s_waitcnt vmcnt(" #n ")" ::: "memory")
#define PG8_WAIT_L(n) asm volatile("s_waitcnt lgkmcnt(" #n ")" ::: "memory")
#define PG8_BAR __builtin_amdgcn_s_barrier()
#define PG8_SCHED __builtin_amdgcn_sched_barrier(0)
    Unit cur, nxt; int ui = 0;
    if (!S.next(0, cur)) return;
    f32x4 acc[2][2][4][2];
#pragma unroll
    for (int a = 0; a < 2; ++a)
#pragma unroll
        for (int b = 0; b < 2; ++b)
#pragma unroll
            for (int m = 0; m < 4; ++m)
#pragma unroll
                for (int n = 0; n < 2; ++n) acc[a][b][m][n] = (f32x4){0.f, 0.f, 0.f, 0.f};
    bf16x8 At[4][2], B0[2][2], B1[2][2];
    unsigned cva[2][2], nva[2][2];
    S.a_off(cur, Rl, Cl, K, cva);
    const char* const Ab = (const char*)g.A;
    const char* cB = S.b_ptr(cur, g);
    PG8_STAGE(PG8_SB(0, 0), cB, voffB); PG8_STAGE(PG8_SB(0, 1), cB + hstep, voffB); PG8_STAGE(PG8_SA(0, 0), Ab, cva[0]); PG8_STAGE(PG8_SA(0, 1), Ab, cva[1]);
    if (wr == 1) PG8_BAR;
    PG8_WAIT_V(2); PG8_BAR;
    PG8_STAGE(PG8_SB(1, 0), cB + kstep, voffB); PG8_STAGE(PG8_SA(1, 0), Ab + kstep, cva[0]); PG8_STAGE(PG8_SB(1, 1), cB + hstep + kstep, voffB);
    PG8_WAIT_V(6); PG8_BAR;
    for (;;) {
        const bool has_next = S.next(ui + 1, nxt);
        const char* nB = cB;
        if (has_next) { S.a_off(nxt, Rl, Cl, K, nva); nB = S.b_ptr(nxt, g); }
        else {
#pragma unroll
            for (int h = 0; h < 2; ++h)
#pragma unroll
                for (int i = 0; i < 2; ++i) nva[h][i] = cva[h][i];
        }
        for (int t = 0; t < nt; t += 2) {
            const bool last = (t == nt - 2);
            const char* a1 = Ab + (size_t)(t + 1) * kstep;
            const char* a2 = last ? Ab : Ab + (size_t)(t + 2) * kstep; const char* b2 = last ? nB : cB + (size_t)(t + 2) * kstep;
            const char* a3 = a2 + kstep; const char* b3 = b2 + kstep;
            unsigned va2[2][2];
#pragma unroll
            for (int h = 0; h < 2; ++h)
#pragma unroll
                for (int i = 0; i < 2; ++i) va2[h][i] = last ? nva[h][i] : cva[h][i];
            PG8_LDB(B0, 0, 0); PG8_LDB(B1, 0, 1); PG8_SCHED; PG8_LDA(At, 0, 0); PG8_STAGE(PG8_SA(1, 1), a1, cva[1]);
            PG8_WAIT_V(8); PG8_WAIT_L(0); PG8_BAR; PG8_MMA(0, 0, At, B0); PG8_MMA(0, 1, At, B1); PG8_BAR; PG8_SCHED;
            PG8_LDA(At, 0, 1); PG8_STAGE(PG8_SB(0, 0), b2, voffB); PG8_STAGE(PG8_SB(0, 1), b2 + hstep, voffB); PG8_STAGE(PG8_SA(0, 0), a2, va2[0]);
            PG8_WAIT_V(8); PG8_WAIT_L(0); PG8_BAR; PG8_MMA(1, 0, At, B0); PG8_MMA(1, 1, At, B1); PG8_BAR; PG8_SCHED;
            PG8_LDB(B0, 1, 0); PG8_LDB(B1, 1, 1); PG8_SCHED; PG8_LDA(At, 1, 0); PG8_STAGE(PG8_SA(0, 1), a2, va2[1]);
            PG8_WAIT_V(8); PG8_WAIT_L(0); PG8_BAR; PG8_MMA(0, 0, At, B0); PG8_MMA(0, 1, At, B1); PG8_BAR; PG8_SCHED;
            PG8_LDA(At, 1, 1); PG8_STAGE(PG8_SB(1, 0), b3, voffB); PG8_STAGE(PG8_SB(1, 1), b3 + hstep, voffB); PG8_STAGE(PG8_SA(1, 0), a3, va2[0]);
            PG8_WAIT_V(8); PG8_WAIT_L(0); PG8_BAR; PG8_MMA(1, 0, At, B0); PG8_MMA(1, 1, At, B1); PG8_BAR; PG8_SCHED;
        }
        if constexpr (ALIGN_EPI) { if (wr == 0) PG8_BAR; }
        E(acc, cur, wr, wc, fr, fq);
        if (!has_next) break;
#pragma unroll
        for (int a = 0; a < 2; ++a)
#pragma unroll
            for (int b = 0; b < 2; ++b)
#pragma unroll
                for (int m = 0; m < 4; ++m)
#pragma unroll
                    for (int n = 0; n < 2; ++n) acc[a][b][m][n] = (f32x4){0.f, 0.f, 0.f, 0.f};
        cur = nxt; cB = nB; ++ui;
#pragma unroll
        for (int h = 0; h < 2; ++h)
#pragma unroll
            for (int i = 0; i < 2; ++i) cva[h][i] = nva[h][i];
        if constexpr (ALIGN_EPI) { if (wr == 1) PG8_BAR; }
    }
    PG8_WAIT_V(0);
    if constexpr (!ALIGN_EPI) { if (wr == 0) PG8_BAR; }
    PG8_BAR;
#undef PG8_SA
#undef PG8_SB
#undef PG8_STAGE
#undef PG8_LDA
#undef PG8_LDB
#undef PG8_MMA
#undef PG8_WAIT_V
#undef PG8_WAIT_L
#undef PG8_BAR
#undef PG8_SCHED
}

__device__ __forceinline__ v4u pack8(const f32x4 a, const f32x4 b) { v4u w; w.x = pk2(a[0], a[1]); w.y = pk2(a[2], a[3]); w.z = pk2(b[0], b[1]); w.w = pk2(b[2], b[3]); return w; }
__device__ __forceinline__ void unpack8(const v4u w, f32x4& a, f32x4& b) { a = (f32x4){bflo(w.x), bfhi(w.x), bflo(w.y), bfhi(w.y)}; b = (f32x4){bflo(w.z), bfhi(w.z), bflo(w.w), bfhi(w.w)}; }

struct EpiPlain {
    static constexpr bool PERM = true;
    bf16* O; int ldc;
    __device__ __forceinline__ void operator()(const f32x4 (&acc)[2][2][4][2], const Unit& u, int wr, int wc, int fr, int fq) const {
        const int row0 = u.pm * BM + wr * 64 + fr, col0 = u.pn * BM + wc * 32 + 8 * fq;
#pragma unroll
        for (int ai = 0; ai < 2; ++ai)
#pragma unroll
            for (int m = 0; m < 4; ++m) { bf16* rowp = O + (size_t)(row0 + ai * HALF + m * 16) * ldc + col0;
#pragma unroll
                for (int bj = 0; bj < 2; ++bj) *(GAS v4u*)(rowp + bj * HALF) = pack8(acc[ai][bj][m][0], acc[ai][bj][m][1]); }
    }
};
struct EpiProj {
    static constexpr bool PERM = true;
    bf16 *U, *Q, *Kb, *GP, *GA;
    __device__ __forceinline__ void operator()(const f32x4 (&acc)[2][2][4][2], const Unit& u, int wr, int wc, int fr, int fq) const {
        const int pn = u.pn; bf16* base; int ldc, colt; float sc = 1.f; bool sig = false;
        if (pn < 2) { base = U; ldc = 512; colt = pn * 256; }
        else if (pn < 4) { base = Q; ldc = 512; colt = (pn - 2) * 256; sc = QSCALE; }
        else if (pn < 6) { base = Kb; ldc = 512; colt = (pn - 4) * 256; }
        else if (pn < 10) { base = GP; ldc = 1024; colt = (pn - 6) * 256; sig = true; }
        else { base = GA; ldc = 1024; colt = (pn - 10) * 256; sig = true; }
        const int row0 = u.pm * BM + wr * 64 + fr, col0 = colt + wc * 32 + 8 * fq;
#pragma unroll
        for (int ai = 0; ai < 2; ++ai)
#pragma unroll
            for (int m = 0; m < 4; ++m) { bf16* rowp = base + (size_t)(row0 + ai * HALF + m * 16) * ldc + col0;
#pragma unroll
                for (int bj = 0; bj < 2; ++bj) { f32x4 v0 = acc[ai][bj][m][0], v1 = acc[ai][bj][m][1];
                    if (sig) {
#pragma unroll
                        for (int j = 0; j < 4; ++j) { v0[j] = fast_sigmoid(v0[j]); v1[j] = fast_sigmoid(v1[j]); }
                    } else { v0 = v0 * sc; v1 = v1 * sc; }
                    *(GAS v4u*)(rowp + bj * HALF) = pack8(v0, v1); } }
    }
};
template <bool ADD> struct EpiGate {
    static constexpr bool PERM = true;
    bf16* O; const bf16* G;
    __device__ __forceinline__ void operator()(const f32x4 (&acc)[2][2][4][2], const Unit& u, int wr, int wc, int fr, int fq) const {
        const int row0 = u.pm * BM + wr * 64 + fr, col0 = u.pn * BM + wc * 32 + 8 * fq;
#pragma unroll
        for (int ai = 0; ai < 2; ++ai)
#pragma unroll
            for (int m = 0; m < 4; ++m) { const size_t ro = (size_t)(row0 + ai * HALF + m * 16) * 1024 + col0;
#pragma unroll
                for (int bj = 0; bj < 2; ++bj) { f32x4 g0, g1; unpack8(*(const GAS v4u*)(G + ro + bj * HALF), g0, g1);
                    f32x4 v0 = acc[ai][bj][m][0] * g0, v1 = acc[ai][bj][m][1] * g1;
                    if (ADD) { f32x4 o0, o1; unpack8(*(const GAS v4u*)(O + ro + bj * HALF), o0, o1); v0 = v0 + o0; v1 = v1 + o1; }
                    *(GAS v4u*)(O + ro + bj * HALF) = pack8(v0, v1); } }
    }
};
struct EpiResid {
    static constexpr bool PERM = true;
    bf16* O; const float* X;
    __device__ __forceinline__ void operator()(const f32x4 (&acc)[2][2][4][2], const Unit& u, int wr, int wc, int fr, int fq) const {
        const int row0 = u.pm * BM + wr * 64 + fr, col0 = u.pn * BM + wc * 32 + 8 * fq;
#pragma unroll
        for (int ai = 0; ai < 2; ++ai)
#pragma unroll
            for (int m = 0; m < 4; ++m) { const size_t ro = (size_t)(row0 + ai * HALF + m * 16) * 1024 + col0;
#pragma unroll
                for (int bj = 0; bj < 2; ++bj) { const f32x4 x0 = *(const GAS f32x4*)(X + ro + bj * HALF), x1 = *(const GAS f32x4*)(X + ro + bj * HALF + 4);
                    *(GAS v4u*)(O + ro + bj * HALF) = pack8(acc[ai][bj][m][0] + x0, acc[ai][bj][m][1] + x1); } }
    }
};
struct EpiPle {
    static constexpr bool PERM = true;
    bf16* O; const bf16* X2; const bf16* PP; const float* R3;
    __device__ __forceinline__ void operator()(const f32x4 (&acc)[2][2][4][2], const Unit& u, int wr, int wc, int fr, int fq) const {
        const int row0 = u.pm * BM + wr * 64 + fr, col0 = u.pn * BM + wc * 32 + 8 * fq;
#pragma unroll
        for (int ai = 0; ai < 2; ++ai)
#pragma unroll
            for (int m = 0; m < 4; ++m) { const int row = row0 + ai * HALF + m * 16; const size_t ro = (size_t)row * 1024 + col0; const float r = R3[row];
#pragma unroll
                for (int bj = 0; bj < 2; ++bj) { f32x4 x0, x1, p0, p1; unpack8(*(const GAS v4u*)(X2 + ro + bj * HALF), x0, x1); unpack8(*(const GAS v4u*)(PP + ro + bj * HALF), p0, p1);
                    f32x4 v0, v1;
#pragma unroll
                    for (int j = 0; j < 4; ++j) { v0[j] = x0[j] + fast_sigmoid(r * acc[ai][bj][m][0][j]) * p0[j]; v1[j] = x1[j] + fast_sigmoid(r * acc[ai][bj][m][1][j]) * p1[j]; }
                    *(GAS v4u*)(O + ro + bj * HALF) = pack8(v0, v1); } }
    }
};

struct MoeOrder {
    const LAS int* tab; const int* row_token; const bf16* W; int NT, G, c, total; bool gather; size_t wstride;
    __device__ __forceinline__ bool next(int i, Unit& u) const {
        const long L = (long)i * G + c; if (L >= total) return false;
        const int rt = (int)(L / NT); u.pn = (int)(L % NT);
        int e = 0;
#pragma unroll
        for (int j = 1; j < 32; ++j) e += (tab[j] <= rt) ? 1 : 0;
        e = __builtin_amdgcn_readfirstlane(e);
        const int lt = rt - __builtin_amdgcn_readfirstlane(tab[e]), cn = __builtin_amdgcn_readfirstlane(tab[65 + e]);
        u.e = e; u.pm = rt; u.row0 = __builtin_amdgcn_readfirstlane(tab[33 + e]) + lt * 256; u.nvalid = (cn - lt * 256) < 256 ? (cn - lt * 256) : 256; return true;
    }
    __device__ __forceinline__ void a_off(const Unit& u, const int (&Rl)[2], const int (&Cl)[2], int K, unsigned (&va)[2][2]) const {
#pragma unroll
        for (int h = 0; h < 2; ++h)
#pragma unroll
            for (int i = 0; i < 2; ++i) {
                const int rl = h * HALF + Rl[i];
                if (gather) { const int rr = rl < u.nvalid ? rl : 0; const int tok = row_token[u.row0 + rr]; va[h][i] = (unsigned)(tok * 1024 + Cl[i]) * 2u; }
                else va[h][i] = (unsigned)((u.row0 + rl) * 1024 + Cl[i]) * 2u;
            }
    }
    __device__ __forceinline__ const char* b_ptr(const Unit& u, const Gemm& g) const { return (const char*)(W + (size_t)u.e * wstride + (size_t)u.pn * 256 * 1024); }
};
struct EpiMoe1 {
    static constexpr bool PERM = true;
    bf16* act; const float* row_r; const float* bgu;
    __device__ __forceinline__ void operator()(const f32x4 (&acc)[2][2][4][2], const Unit& u, int wr, int wc, int fr, int fq) const {
        const int cl = u.pn * 128 + wc * 32 + 8 * fq;
        const float* bg = bgu + (size_t)u.e * 2048 + cl;
        const f32x4 g0b = *(const GAS f32x4*)(bg), g1b = *(const GAS f32x4*)(bg + 4), u0b = *(const GAS f32x4*)(bg + 1024), u1b = *(const GAS f32x4*)(bg + 1028);
#pragma unroll
        for (int ai = 0; ai < 2; ++ai)
#pragma unroll
            for (int m = 0; m < 4; ++m) { const int rl = ai * HALF + wr * 64 + m * 16 + fr;
                if (rl < u.nvalid) { const float r = row_r[u.row0 + rl];
                    const f32x4 ga = acc[ai][0][m][0] * r + g0b, gb = acc[ai][0][m][1] * r + g1b, ua = acc[ai][1][m][0] * r + u0b, ub = acc[ai][1][m][1] * r + u1b;
                    f32x4 o0, o1;
#pragma unroll
                    for (int j = 0; j < 4; ++j) {
                        { const float gt = fminf(ga[j], 7.0f), up = fminf(fmaxf(ua[j], -7.0f), 7.0f); o0[j] = (up + 1.0f) * gt * fast_sigmoid(1.702f * gt); }
                        { const float gt = fminf(gb[j], 7.0f), up = fminf(fmaxf(ub[j], -7.0f), 7.0f); o1[j] = (up + 1.0f) * gt * fast_sigmoid(1.702f * gt); }
                    }
                    *(GAS v4u*)(act + (size_t)(u.row0 + rl) * 1024 + cl) = pack8(o0, o1); } }
    }
};
struct EpiMoe2 {
    static constexpr bool PERM = true;
    bf16* X2; const bf16* SRC; const int* row_token; const float* row_w; const float* bdn;
    __device__ __forceinline__ void operator()(const f32x4 (&acc)[2][2][4][2], const Unit& u, int wr, int wc, int fr, int fq) const {
        const int col0 = u.pn * 256 + wc * 32 + 8 * fq;
        const float* bd = bdn + (size_t)u.e * 1024 + col0;
        f32x4 bv[2][2];
#pragma unroll
        for (int bj = 0; bj < 2; ++bj) { bv[bj][0] = *(const GAS f32x4*)(bd + bj * HALF); bv[bj][1] = *(const GAS f32x4*)(bd + bj * HALF + 4); }
#pragma unroll
        for (int ai = 0; ai < 2; ++ai)
#pragma unroll
            for (int m = 0; m < 4; ++m) { const int rl = ai * HALF + wr * 64 + m * 16 + fr;
                if (rl < u.nvalid) { const int tok = row_token[u.row0 + rl]; const float w = row_w[u.row0 + rl]; const size_t ro = (size_t)tok * 1024 + col0;
#pragma unroll
                    for (int bj = 0; bj < 2; ++bj) { f32x4 s0, s1; unpack8(*(const GAS v4u*)(SRC + ro + bj * HALF), s0, s1);
                        *(GAS v4u*)(X2 + ro + bj * HALF) = pack8(s0 + (acc[ai][bj][m][0] + bv[bj][0]) * w, s1 + (acc[ai][bj][m][1] + bv[bj][1]) * w); } } }
    }
};
}

struct Frame {
    LAS unsigned char* lds; volatile LAS unsigned* MISC; gu32* ctl;
    int tid, lane, wave, vcu, G;
};
struct Args { const float* in[20]; float* out; unsigned char* ws; int ph_lo, ph_hi; };

__device__ __forceinline__ void p0_transpose_item(const float* W, int N, int k0, int n0, bf16* WT, int Kp, int dst_row0, const float* gain, LAS float* scr, int lane) {
#pragma unroll 8
    for (int i = 0; i < 32; ++i) { const int kk = 2 * i + (lane >> 5); float v = W[(size_t)(k0 + kk) * N + n0 + (lane & 31)]; if (gain) v *= gain[k0 + kk]; scr[kk * 33 + (lane & 31)] = v; }
    LDS_WAIT(); asm volatile("" ::: "memory");
    const int c = lane & 7;
#pragma unroll
    for (int j = 0; j < 4; ++j) { const int n = (lane >> 3) + 8 * j; const LAS float* s = scr + (8 * c) * 33 + n;
        v4u o; o.x = pk2(s[0 * 33], s[1 * 33]); o.y = pk2(s[2 * 33], s[3 * 33]); o.z = pk2(s[4 * 33], s[5 * 33]); o.w = pk2(s[6 * 33], s[7 * 33]);
        *(GAS v4u*)(WT + (size_t)(dst_row0 + n) * Kp + k0 + 8 * c) = o; }
    LDS_WAIT(); asm volatile("" ::: "memory");
}
__device__ __forceinline__ void rms_row_f32_to_bf16(const float* xrow, const float* g, bf16* orow, int lane) {
    const GAS f32x4* xr = (const GAS f32x4*)xrow + lane; const GAS f32x4* gr = (const GAS f32x4*)g + lane;
    f32x4 v[4]; float s = 0.f;
#pragma unroll
    for (int j = 0; j < 4; ++j) { v[j] = xr[64 * j]; s += (v[j].x * v[j].x + v[j].y * v[j].y) + (v[j].z * v[j].z + v[j].w * v[j].w); }
    const float r = 1.0f / sqrtf(wave_sum(s) * (1.f / D) + EPS);
    GAS v2u* o8 = (GAS v2u*)orow + lane;
#pragma unroll
    for (int j = 0; j < 4; ++j) { const f32x4 gg = gr[64 * j]; v2u o; o.x = pk2(v[j].x * r * gg.x, v[j].y * r * gg.y); o.y = pk2(v[j].z * r * gg.z, v[j].w * r * gg.w); o8[64 * j] = o; }
}

#define MFMA32(a, b, c) __builtin_amdgcn_mfma_f32_32x32x16_bf16((a), (b), (c), 0, 0, 0)
__device__ __forceinline__ bf16x8 ldg16(const bf16* p) { return *(const GAS bf16x8*)p; }
__device__ __forceinline__ void attn_task(const bf16* __restrict__ Q, const bf16* __restrict__ Kp, const bf16* __restrict__ Vt, bf16* __restrict__ Y, int b, int h, int qb, int lane) {
    const int l31 = lane & 31, hl = lane >> 5;
    const int t0 = qb * 32; const size_t tb = (size_t)b * SEQ;
    bf16x8 qf[4];
    { const bf16* qrow = Q + (tb + t0 + l31) * 512 + h * 64 + 8 * hl;
#pragma unroll
      for (int kk = 0; kk < 4; ++kk) qf[kk] = ldg16(qrow + 16 * kk); }
    const int a_ = l31 >> 3, hh = (l31 >> 2) & 1, c_ = l31 & 3;
    const int pim = 16 * (a_ >> 1) + 8 * hh + 4 * (a_ & 1) + c_;
    const bf16* kbase = Kp + (tb + pim) * 512 + h * 64 + 8 * hl;
    const bf16* vbase = Vt + (size_t)(h * 64 + l31) * M + tb + 8 * hl;
    f32x16 o0, o1;
#pragma unroll
    for (int r = 0; r < 16; ++r) { o0[r] = 0.f; o1[r] = 0.f; }
    float carry = 0.f;
    int key0 = t0;
    bf16x8 kf[4], vf[4];
#pragma unroll
    for (int kk = 0; kk < 4; ++kk) kf[kk] = ldg16(kbase + (size_t)key0 * 512 + 16 * kk);
#pragma unroll
    for (int dj = 0; dj < 4; ++dj) vf[dj] = ldg16(vbase + (size_t)(dj >> 1) * 32 * M + key0 + 16 * (dj & 1));
    for (;;) {
        const int nk = key0 - 32; const bool more = nk >= 0;
        bf16x8 kn[4], vn[4];
        const int lk = more ? nk : key0;
#pragma unroll
        for (int kk = 0; kk < 4; ++kk) kn[kk] = ldg16(kbase + (size_t)lk * 512 + 16 * kk);
#pragma unroll
        for (int dj = 0; dj < 4; ++dj) vn[dj] = ldg16(vbase + (size_t)(dj >> 1) * 32 * M + lk + 16 * (dj & 1));
        f32x16 s;
#pragma unroll
        for (int r = 0; r < 16; ++r) s[r] = 0.f;
#pragma unroll
        for (int kk = 0; kk < 4; ++kk) s = MFMA32(kf[kk], qf[kk], s);
        const bool diag = (key0 == t0);
        float sp[16], ls[16];
        float lo = 0.f, hi = 0.f;
#pragma unroll
        for (int r = 0; r < 16; ++r) {
            const int ko = (r < 8) ? (8 * hl + r) : (16 + 8 * hl + (r - 8));
            const float z = s[r];
            const float e = __builtin_amdgcn_exp2f(-fabsf(z));
            const float lg = __builtin_amdgcn_logf(1.0f + e);
            float spv = fmaxf(z, 0.f) + lg;
            float lsv = fminf(z, 0.f) - lg;
            if (diag && ko >= l31) { spv = 0.f; lsv = -1.0e30f; }
            sp[r] = spv; ls[r] = lsv;
            if (r < 8) lo += spv; else hi += spv;
        }
        const float plo = __shfl_xor(lo, 32), phi = __shfl_xor(hi, 32);
        const float after_lo = (hl == 0) ? (plo + hi + phi) : (hi + phi);
        const float after_hi = (hl == 0) ? phi : 0.f;
        float w[16];
        { float run = carry + after_lo;
#pragma unroll
          for (int r = 7; r >= 0; --r) { w[r] = __builtin_amdgcn_exp2f(ls[r] - run); run += sp[r]; } }
        { float run = carry + after_hi;
#pragma unroll
          for (int r = 15; r >= 8; --r) { w[r] = __builtin_amdgcn_exp2f(ls[r] - run); run += sp[r]; } }
        carry += (lo + hi) + (plo + phi);
        v4u w0, w1;
        w0.x = pk2(w[0], w[1]); w0.y = pk2(w[2], w[3]); w0.z = pk2(w[4], w[5]); w0.w = pk2(w[6], w[7]);
        w1.x = pk2(w[8], w[9]); w1.y = pk2(w[10], w[11]); w1.z = pk2(w[12], w[13]); w1.w = pk2(w[14], w[15]);
        const bf16x8 W0 = __builtin_bit_cast(bf16x8, w0), W1 = __builtin_bit_cast(bf16x8, w1);
        o0 = MFMA32(vf[0], W0, o0); o0 = MFMA32(vf[1], W1, o0);
        o1 = MFMA32(vf[2], W0, o1); o1 = MFMA32(vf[3], W1, o1);
        if (!more) break;
        if (__all(carry >= ATT_THR)) break;
#pragma unroll
        for (int kk = 0; kk < 4; ++kk) { kf[kk] = kn[kk]; vf[kk] = vn[kk]; }
        key0 = nk;
    }
    bf16* yrow = Y + (tb + t0 + l31) * 512 + h * 64 + 4 * hl;
#pragma unroll
    for (int a = 0; a < 4; ++a) {
        v2u p0, p1; p0.x = pk2(o0[4 * a], o0[4 * a + 1]); p0.y = pk2(o0[4 * a + 2], o0[4 * a + 3]); p1.x = pk2(o1[4 * a], o1[4 * a + 1]); p1.y = pk2(o1[4 * a + 2], o1[4 * a + 3]);
        *(GAS v2u*)(yrow + 8 * a) = p0; *(GAS v2u*)(yrow + 32 + 8 * a) = p1;
    }
}

__device__ __forceinline__ void pool_row(const bf16* __restrict__ U, bf16* __restrict__ P, int tok, int lane) {
    const int t = tok & (SEQ - 1); const int w = 2 << (lane >> 4);
    float sum[8], cur[8];
#pragma unroll
    for (int j = 0; j < 8; ++j) { sum[j] = 0.f; cur[j] = 0.f; }
#pragma unroll
    for (int j = 0; j < 16; ++j) {
        if (j < w && j <= t) {
            const v4u v = *(const GAS v4u*)(U + (size_t)(tok - j) * 512 + 8 * lane);
            const float f[8] = {bflo(v.x), bfhi(v.x), bflo(v.y), bfhi(v.y), bflo(v.z), bfhi(v.z), bflo(v.w), bfhi(v.w)};
#pragma unroll
            for (int q = 0; q < 8; ++q) { sum[q] += f[q]; if (j == 0) cur[q] = f[q]; }
        }
    }
    const int cnt = (t + 1) < w ? (t + 1) : w; const float inv = 1.0f / (float)cnt;
    v4u o; o.x = pk2(sum[0] * inv - cur[0], sum[1] * inv - cur[1]); o.y = pk2(sum[2] * inv - cur[2], sum[3] * inv - cur[3]);
    o.z = pk2(sum[4] * inv - cur[4], sum[5] * inv - cur[5]); o.w = pk2(sum[6] * inv - cur[6], sum[7] * inv - cur[7]);
    *(GAS v4u*)(P + (size_t)tok * 512 + 8 * lane) = o;
}

__device__ __forceinline__ void router_task(const bf16* __restrict__ X1, const bf16* __restrict__ WrF, const float* __restrict__ b_router, int T0, int lane,
                                            float* __restrict__ R2, int* __restrict__ TKE, float* __restrict__ TKW, LAS int* lds_e  ) {
    const int l31 = lane & 31, hl = lane >> 5;
    const bf16* xr = X1 + (size_t)(T0 + l31) * 1024 + 8 * hl;
    f32x16 acc;
#pragma unroll
    for (int r = 0; r < 16; ++r) acc[r] = 0.f;
    float ssq = 0.f;
#pragma unroll 4
    for (int kk = 0; kk < 64; ++kk) {
        const v4u xv = *(const GAS v4u*)(xr + 16 * kk);
        const bf16x8 ah = ldg16(WrF + ((size_t)kk * 64 + lane) * 8), al = ldg16(WrF + 32768 + ((size_t)kk * 64 + lane) * 8);
        const float f0 = bflo(xv.x), f1 = bfhi(xv.x), f2 = bflo(xv.y), f3 = bfhi(xv.y), f4 = bflo(xv.z), f5 = bfhi(xv.z), f6 = bflo(xv.w), f7 = bfhi(xv.w);
        ssq += (f0 * f0 + f1 * f1) + (f2 * f2 + f3 * f3) + (f4 * f4 + f5 * f5) + (f6 * f6 + f7 * f7);
        const bf16x8 xb = __builtin_bit_cast(bf16x8, xv);
        acc = MFMA32(ah, xb, acc); acc = MFMA32(al, xb, acc);
    }
    ssq += __shfl_xor(ssq, 32);
    const float r = 1.0f / sqrtf(ssq * (1.f / D) + EPS);
    float v[16];
#pragma unroll
    for (int q = 0; q < 16; ++q) { const int e = 8 * (q >> 2) + 4 * hl + (q & 3); v[q] = acc[q] * r + b_router[e]; }
    float cv[8]; int ce[8];
#pragma unroll
    for (int k = 0; k < 4; ++k) {
        float best = -3.0e38f; int bi = 0;
#pragma unroll
        for (int q = 0; q < 16; ++q) { if (v[q] > best) { best = v[q]; bi = q; } }
        cv[k] = best; ce[k] = 8 * (bi >> 2) + 4 * hl + (bi & 3);
#pragma unroll
        for (int q = 0; q < 16; ++q) { if (q == bi) v[q] = -3.0e38f; }
    }
#pragma unroll
    for (int k = 0; k < 4; ++k) { cv[4 + k] = __shfl_xor(cv[k], 32); ce[4 + k] = __shfl_xor(ce[k], 32); }
    float tv[4]; int te[4];
#pragma unroll
    for (int k = 0; k < 4; ++k) {
        float best = -3.0e38f; int be = 1 << 20; int bi = 0;
#pragma unroll
        for (int q = 0; q < 8; ++q) { if (cv[q] > best || (cv[q] == best && ce[q] < be)) { best = cv[q]; be = ce[q]; bi = q; } }
        tv[k] = best; te[k] = be;
#pragma unroll
        for (int q = 0; q < 8; ++q) { if (q == bi) { cv[q] = -3.0e38f; ce[q] = 1 << 21; } }
    }
    const float p1 = __expf(tv[1] - tv[0]), p2 = __expf(tv[2] - tv[0]), p3 = __expf(tv[3] - tv[0]);
    const float inv = 1.0f / (1.0f + p1 + p2 + p3);
    if (hl == 0) {
        const int tok = T0 + l31;
        R2[tok] = r;
        *(GAS v4i*)(TKE + (size_t)tok * 4) = (v4i){te[0], te[1], te[2], te[3]};
        *(GAS f32x4*)(TKW + (size_t)tok * 4) = (f32x4){inv, p1 * inv, p2 * inv, p3 * inv};
        lds_e[l31 * 4 + 0] = te[0]; lds_e[l31 * 4 + 1] = te[1]; lds_e[l31 * 4 + 2] = te[2]; lds_e[l31 * 4 + 3] = te[3];
    }
}

__global__ void __launch_bounds__(NWAVES * 64, 2) mk_fwd(Args args) {
    extern __shared__ __attribute__((aligned(16))) unsigned char lds[];
    Frame F;
    F.lds = (LAS unsigned char*)lds;
    F.MISC = (volatile LAS unsigned*)(F.lds + MISC_OFF);
    F.tid = threadIdx.x; F.lane = F.tid & 63; F.wave = __builtin_amdgcn_readfirstlane(F.tid >> 6);
    F.G = gridDim.x; { const int bx = blockIdx.x; F.vcu = (F.G % 8 == 0) ? (bx % 8) * (F.G / 8) + bx / 8 : bx; }
    unsigned char* ws = args.ws;
    F.ctl = (gu32*)(ws + WS_CTL);
    for (int u = F.tid; u < (LDS_BYTES - LDSCTL_OFF) / 4; u += NWAVES * 64) ((LAS unsigned*)(F.lds + LDSCTL_OFF))[u] = 0u;
    __syncthreads();
    const int lo = args.ph_lo, hi = args.ph_hi;
    XcdBarrier bar; bar.bar = (unsigned*)(F.ctl + CW_BAR); bar.x = 0; bar.st = nullptr;
    if (hi - lo > 1) bar = xcd_barrier_post((unsigned*)(F.ctl + CW_BAR), F.MISC + 8);
#define IN(k) (lo <= (k) && (k) < hi)
#define BOTH(k) (IN(k) && IN((k) + 1))
#define GRID_BAR() xcd_barrier(bar)

    const float* x = args.in[0]; const float* p_in = args.in[1]; const float* g_mix = args.in[2]; const float* w_in = args.in[3]; const float* w_pool_grp = args.in[4];
    const float* pool_scale = args.in[5]; const float* w_pool_up = args.in[6]; const float* w_attn_up = args.in[7]; const float* w_out = args.in[8]; const float* g_ffn = args.in[9];
    const float* w_router = args.in[10]; const float* b_router = args.in[11]; const float* w_gu = args.in[12]; const float* b_gu = args.in[13]; const float* w_down = args.in[14];
    const float* b_down = args.in[15]; const float* g_ple = args.in[16]; const float* w_ple_gate = args.in[17]; const float* w_ple_proj = args.in[18]; const float* g_final = args.in[19];
    float* R2 = (float*)(ws + WS_R2); float* R3 = (float*)(ws + WS_R3);
    int* TKE = (int*)(ws + WS_TKE); float* TKW = (float*)(ws + WS_TKW); int* TKR = (int*)(ws + WS_TKR);
    int* ROWT = (int*)(ws + WS_ROWT); float* ROWW = (float*)(ws + WS_ROWW); float* ROWR = (float*)(ws + WS_ROWR);
    int* CNTWG = (int*)(ws + WS_CNTWG); int* SEGTOT = (int*)(ws + WS_SEGTOT);
    bf16* WRF = (bf16*)(ws + WS_WRF);
    bf16* WIN = (bf16*)(ws + WS_WIN); bf16* WEFF = (bf16*)(ws + WS_WEFF); bf16* WAU = (bf16*)(ws + WS_WAU); bf16* WOUT = (bf16*)(ws + WS_WOUT);
    bf16* WPG = (bf16*)(ws + WS_WPG); bf16* WPP = (bf16*)(ws + WS_WPP); bf16* WGU = (bf16*)(ws + WS_WGU); bf16* WDN = (bf16*)(ws + WS_WDN);
    bf16* H1 = (bf16*)(ws + WS_A); bf16* MRG = (bf16*)(ws + WS_A); bf16* PPB = (bf16*)(ws + WS_A);
    bf16* UB = (bf16*)(ws + WS_B); bf16* QB = (bf16*)(ws + WS_B + 64 * MiB); bf16* X1 = (bf16*)(ws + WS_B);
    bf16* KB = (bf16*)(ws + WS_C); bf16* VT = (bf16*)(ws + WS_C + 64 * MiB); bf16* X2 = (bf16*)(ws + WS_C);
    bf16* POOL = (bf16*)(ws + WS_E); bf16* YATT = (bf16*)(ws + WS_E + 64 * MiB); bf16* X3 = (bf16*)(ws + WS_E);
    bf16* PB = (bf16*)(ws + WS_PB);
    bf16* GPB = (bf16*)args.out; bf16* GAB = (bf16*)args.out + (size_t)M * 1024; bf16* ACT = (bf16*)args.out;
    const int gw = F.vcu * NWAVES + F.wave, NGW = F.G * NWAVES;
    LAS int* ltab = (LAS int*)(F.lds + LDS_TAB_OFF);

    if (IN(0)) {
        LAS float* scr = (LAS float*)(F.lds + F.wave * 16384);
        constexpr int I_IN = 16 * 128, I_AU = 8 * 32, I_OUT = 16 * 32, I_PG = 16 * 32, I_PP = 4 * 32, I_GU = 32 * 16 * 64, I_DN = 32 * 16 * 32;
        constexpr int NITEMS = I_IN + I_AU + I_OUT + I_PG + I_PP + I_GU + I_DN;
        for (int it = gw; it < NITEMS; it += NGW) {
            int r = it;
            if (r < I_IN) { const int kb = r / 128, nb = r % 128, n0 = nb * 32;
                const int blk = n0 / 512; const int dst = (blk < 3) ? n0 : (blk == 3 ? 3584 + (n0 - 1536) : n0 - 512);
                p0_transpose_item(w_in, 4096, kb * 64, n0, WIN, 1024, dst, nullptr, scr, F.lane); continue; } r -= I_IN;
            if (r < I_AU) { const int kb = r / 32, nb = r % 32; p0_transpose_item(w_attn_up, 1024, kb * 64, nb * 32, WAU, 512, nb * 32, nullptr, scr, F.lane); continue; } r -= I_AU;
            if (r < I_OUT) { const int kb = r / 32, nb = r % 32; p0_transpose_item(w_out, 1024, kb * 64, nb * 32, WOUT, 1024, nb * 32, nullptr, scr, F.lane); continue; } r -= I_OUT;
            if (r < I_PG) { const int kb = r / 32, nb = r % 32; p0_transpose_item(w_ple_gate, 1024, kb * 64, nb * 32, WPG, 1024, nb * 32, g_ple, scr, F.lane); continue; } r -= I_PG;
            if (r < I_PP) { const int kb = r / 32, nb = r % 32; p0_transpose_item(w_ple_proj, 1024, kb * 64, nb * 32, WPP, 256, nb * 32, nullptr, scr, F.lane); continue; } r -= I_PP;
            if (r < I_GU) { const int e = r / 1024, q = r % 1024, kb = q / 64, nb = q % 64, n0 = nb * 32;
                const int j = n0 & 1023; const int dst = 256 * (j / 128) + (j % 128) + (n0 >= 1024 ? 128 : 0);
                p0_transpose_item(w_gu + (size_t)e * 1024 * 2048, 2048, kb * 64, n0, WGU + (size_t)e * 2048 * 1024, 1024, dst, g_ffn, scr, F.lane); continue; } r -= I_GU;
            { const int e = r / 512, q = r % 512, kb = q / 32, nb = q % 32;
                p0_transpose_item(w_down + (size_t)e * 1024 * 1024, 1024, kb * 64, nb * 32, WDN + (size_t)e * 1024 * 1024, 1024, nb * 32, nullptr, scr, F.lane); }
        }
        for (int it = gw; it < 4 * 16 * 16; it += NGW) {
            const int g = it >> 8, cb = (it >> 4) & 15, db = it & 15; const int d = db * 64 + F.lane, c0 = cb * 8;
            float a8[8];
#pragma unroll
            for (int q = 0; q < 8; ++q) a8[q] = 0.f;
            for (int j = 0; j < 128; ++j) { const float wv = w_pool_up[(size_t)(g * 128 + j) * 1024 + d] * pool_scale[g * 128 + j];
#pragma unroll
                for (int q = 0; q < 8; ++q) a8[q] += w_pool_grp[(size_t)(g * 128 + c0 + q) * 128 + j] * wv; }
            v4u o; o.x = pk2(a8[0], a8[1]); o.y = pk2(a8[2], a8[3]); o.z = pk2(a8[4], a8[5]); o.w = pk2(a8[6], a8[7]);
            *(GAS v4u*)(WEFF + (size_t)d * 512 + g * 128 + c0) = o;
        }
        for (int it = gw * 64 + F.lane; it < 64 * 64; it += NGW * 64) {
            const int kk = it >> 6, l = it & 63, e = l & 31, k0 = 16 * kk + 8 * (l >> 5);
            unsigned hb[8], lb[8];
#pragma unroll
            for (int i = 0; i < 8; ++i) { const float v = g_ffn[k0 + i] * w_router[(size_t)(k0 + i) * 32 + e]; hb[i] = f2bf(v); lb[i] = f2bf(v - __builtin_bit_cast(float, hb[i] << 16)); }
            v4u oh, ol; oh.x = hb[0] | (hb[1] << 16); oh.y = hb[2] | (hb[3] << 16); oh.z = hb[4] | (hb[5] << 16); oh.w = hb[6] | (hb[7] << 16);
            ol.x = lb[0] | (lb[1] << 16); ol.y = lb[2] | (lb[3] << 16); ol.z = lb[4] | (lb[5] << 16); ol.w = lb[6] | (lb[7] << 16);
            *(GAS v4u*)(WRF + (size_t)it * 8) = oh; *(GAS v4u*)(WRF + 32768 + (size_t)it * 8) = ol;
        }
        for (int m = gw; m < M; m += NGW) rms_row_f32_to_bf16(x + (size_t)m * D, g_mix, H1 + (size_t)m * D, F.lane);
        for (size_t i = (size_t)gw * 64 + F.lane; i < (size_t)M * PLE / 8; i += (size_t)NGW * 64) {
            const f32x4 a = *(const GAS f32x4*)(p_in + i * 8), b = *(const GAS f32x4*)(p_in + i * 8 + 4);
            *(GAS v4u*)(PB + i * 8) = pg8::pack8(a, b);
        }
        if (BOTH(0)) GRID_BAR();
    }

    if (IN(1)) {
        { pg8::Gemm g{H1, WIN, D}; pg8::StaticOrder S; S.init(M, NPROJ_A, F.G, (int)blockIdx.x);
          pg8::EpiProj E{UB, QB, KB, GPB, GAB};
          pg8::gemm_phase<pg8::EpiProj, pg8::StaticOrder, true>(F.lds, g, S, E); }
        { pg8::Gemm g{WIN + (size_t)NPROJ_A * D, H1, D}; pg8::StaticOrder S; S.init(512, M, F.G, (int)blockIdx.x);
          pg8::EpiPlain E{VT, M};
          pg8::gemm_phase<pg8::EpiPlain, pg8::StaticOrder, true>(F.lds, g, S, E); }
        if (BOTH(1)) GRID_BAR();
    }

    if (IN(2)) {
        for (int T = gw; T < NB * NH * (SEQ / 32); T += NGW) {
            const int qb = T & 127, h = (T >> 7) & 7, b = T >> 10;
            attn_task(QB, KB, VT, YATT, b, h, qb, F.lane);
        }
        for (int tok = gw; tok < M; tok += NGW) pool_row(UB, POOL, tok, F.lane);
        if (BOTH(2)) GRID_BAR();
    }

    if (IN(3)) {
        pg8::Gemm g{POOL, WEFF, PW}; pg8::StaticOrder S; S.init(M, D, F.G, (int)blockIdx.x);
        pg8::EpiGate<false> E{MRG, GPB};
        pg8::gemm_phase<pg8::EpiGate<false>, pg8::StaticOrder, true>(F.lds, g, S, E);
        if (BOTH(3)) GRID_BAR();
    }
    if (IN(4)) {
        pg8::Gemm g{YATT, WAU, AW}; pg8::StaticOrder S; S.init(M, D, F.G, (int)blockIdx.x);
        pg8::EpiGate<true> E{MRG, GAB};
        pg8::gemm_phase<pg8::EpiGate<true>, pg8::StaticOrder, true>(F.lds, g, S, E);
        if (BOTH(4)) GRID_BAR();
    }
    if (IN(5)) {
        pg8::Gemm g{MRG, WOUT, D}; pg8::StaticOrder S; S.init(M, D, F.G, (int)blockIdx.x);
        pg8::EpiResid E{X1, x};
        pg8::gemm_phase<pg8::EpiResid, pg8::StaticOrder, true>(F.lds, g, S, E);
        if (BOTH(5)) GRID_BAR();
    }

    if (IN(6)) {
        LAS int* lcnt = ltab;
        LAS int* le = ltab + 128;
        for (int chunk = F.vcu; chunk < M / 256; chunk += F.G) {
            if (F.tid < 128) lcnt[F.tid] = 0;
            router_task(X1, WRF, b_router, chunk * 256 + F.wave * 32, F.lane, R2, TKE, TKW, le + F.wave * 128);
            __syncthreads();
            if (F.tid < 256) {
                const int tok = chunk * 256 + F.tid; v4i rk;
#pragma unroll
                for (int k = 0; k < 4; ++k) rk[k] = __hip_atomic_fetch_add((int*)(lcnt + k * 32 + le[F.tid * 4 + k]), 1, __ATOMIC_RELAXED, __HIP_MEMORY_SCOPE_WORKGROUP);
                *(GAS v4i*)(TKR + (size_t)tok * 4) = rk;
            }
            __syncthreads();
            if (F.tid < 128) CNTWG[chunk * 128 + F.tid] = lcnt[F.tid];
            __syncthreads();
        }
        if (BOTH(6)) GRID_BAR();
    }

    if (IN(7)) {
        LAS int* part = ltab;
        LAS int* tot = ltab + 1024;
        LAS int* below = ltab + 1152;
        LAS int* base = ltab + 1280;
        for (int chunk = F.vcu; chunk < M / 256; chunk += F.G) {
            { const int s = F.tid & 127, q = F.tid >> 7; int st = 0, sb = 0;
              for (int c2 = q * 64; c2 < q * 64 + 64; ++c2) { const int v = CNTWG[c2 * 128 + s]; st += v; sb += (c2 < chunk) ? v : 0; }
              part[(q * 128 + s) * 2] = st; part[(q * 128 + s) * 2 + 1] = sb; }
            __syncthreads();
            if (F.tid < 128) { int st = 0, sb = 0;
#pragma unroll
                for (int q = 0; q < 4; ++q) { st += part[(q * 128 + F.tid) * 2]; sb += part[(q * 128 + F.tid) * 2 + 1]; }
                tot[F.tid] = st; below[F.tid] = sb; }
            __syncthreads();
            if (F.tid < 128) { const int k = F.tid >> 5, e = F.tid & 31; int pre = 0;
                for (int e2 = 0; e2 < e; ++e2) pre += tot[k * 32 + e2];
                base[F.tid] = k * M + pre + below[F.tid];
                if (chunk == 0) SEGTOT[F.tid] = tot[F.tid]; }
            __syncthreads();
            if (F.tid < 256) { const int tok = chunk * 256 + F.tid;
                const v4i te = *(const GAS v4i*)(TKE + (size_t)tok * 4), rk = *(const GAS v4i*)(TKR + (size_t)tok * 4); const f32x4 tw = *(const GAS f32x4*)(TKW + (size_t)tok * 4); const float r = R2[tok];
#pragma unroll
                for (int k = 0; k < 4; ++k) { const int slot = base[k * 32 + te[k]] + rk[k]; ROWT[slot] = tok; ROWW[slot] = tw[k]; ROWR[slot] = r; } }
            __syncthreads();
        }
        if (BOTH(7)) GRID_BAR();
    }

    for (int k = 0; k < 4; ++k) {
        if (IN(8 + 2 * k) || IN(9 + 2 * k)) {
            __syncthreads();
            if (F.tid == 0) { int tb = 0, ss = 0;
                for (int e = 0; e < 32; ++e) { const int cn = SEGTOT[k * 32 + e]; ltab[e] = tb; ltab[33 + e] = ss; ltab[65 + e] = cn; tb += (cn + 255) >> 8; ss += cn; }
                ltab[32] = tb; }
            __syncthreads();
        }
        const int T = __builtin_amdgcn_readfirstlane(ltab[32]);
        if (IN(8 + 2 * k)) {
            pg8::Gemm g{X1, WGU, D};
            pg8::MoeOrder S{ltab, ROWT + (size_t)k * M, WGU, 8, F.G, F.vcu, T * 8, true, (size_t)2048 * 1024};
            pg8::EpiMoe1 E{ACT, ROWR + (size_t)k * M, b_gu};
            pg8::gemm_phase<pg8::EpiMoe1, pg8::MoeOrder, true>(F.lds, g, S, E);
            if (BOTH(8 + 2 * k)) GRID_BAR();
        }
        if (IN(9 + 2 * k)) {
            pg8::Gemm g{ACT, WDN, DE};
            pg8::MoeOrder S{ltab, ROWT + (size_t)k * M, WDN, 4, F.G, F.vcu, T * 4, false, (size_t)1024 * 1024};
            pg8::EpiMoe2 E{X2, k == 0 ? X1 : X2, ROWT + (size_t)k * M, ROWW + (size_t)k * M, b_down};
            pg8::gemm_phase<pg8::EpiMoe2, pg8::MoeOrder, true>(F.lds, g, S, E);
            if (BOTH(9 + 2 * k)) GRID_BAR();
        }
    }

    if (IN(16)) {
        for (int m = gw; m < M; m += NGW) {
            const GAS v4u* xr = (const GAS v4u*)(X2 + (size_t)m * D) + F.lane; float s = 0.f;
#pragma unroll
            for (int j = 0; j < 2; ++j) { const v4u v = xr[64 * j]; const float f[8] = {bflo(v.x), bfhi(v.x), bflo(v.y), bfhi(v.y), bflo(v.z), bfhi(v.z), bflo(v.w), bfhi(v.w)};
#pragma unroll
                for (int q = 0; q < 8; ++q) s += f[q] * f[q]; }
            s = wave_sum(s);
            if (F.lane == 0) R3[m] = 1.0f / sqrtf(s * (1.f / D) + EPS);
        }
        pg8::Gemm g{PB, WPP, PLE}; pg8::StaticOrder S; S.init(M, D, F.G, (int)blockIdx.x);
        pg8::EpiPlain E{PPB, D};
        pg8::gemm_phase<pg8::EpiPlain, pg8::StaticOrder, true>(F.lds, g, S, E);
        if (BOTH(16)) GRID_BAR();
    }
    if (IN(17)) {
        pg8::Gemm g{X2, WPG, D}; pg8::StaticOrder S; S.init(M, D, F.G, (int)blockIdx.x);
        pg8::EpiPle E{X3, X2, PPB, R3};
        pg8::gemm_phase<pg8::EpiPle, pg8::StaticOrder, true>(F.lds, g, S, E);
        if (BOTH(17)) GRID_BAR();
    }
    if (IN(18)) {
        for (int m = gw; m < M; m += NGW) {
            const GAS v4u* xr = (const GAS v4u*)(X3 + (size_t)m * D) + F.lane; float f[2][8]; float s = 0.f;
#pragma unroll
            for (int j = 0; j < 2; ++j) { const v4u v = xr[64 * j]; f[j][0] = bflo(v.x); f[j][1] = bfhi(v.x); f[j][2] = bflo(v.y); f[j][3] = bfhi(v.y); f[j][4] = bflo(v.z); f[j][5] = bfhi(v.z); f[j][6] = bflo(v.w); f[j][7] = bfhi(v.w);
#pragma unroll
                for (int q = 0; q < 8; ++q) s += f[j][q] * f[j][q]; }
            s = wave_sum(s);
            const float r = 1.0f / sqrtf(s * (1.f / D) + EPS);
#pragma unroll
            for (int j = 0; j < 2; ++j) { const int c0 = (64 * j + F.lane) * 8;
                const f32x4 g0 = *(const GAS f32x4*)(g_final + c0), g1 = *(const GAS f32x4*)(g_final + c0 + 4);
                f32x4 o0 = {f[j][0] * r * g0.x, f[j][1] * r * g0.y, f[j][2] * r * g0.z, f[j][3] * r * g0.w}, o1 = {f[j][4] * r * g1.x, f[j][5] * r * g1.y, f[j][6] * r * g1.z, f[j][7] * r * g1.w};
                *(GAS f32x4*)(args.out + (size_t)m * D + c0) = o0; *(GAS f32x4*)(args.out + (size_t)m * D + c0 + 4) = o1; }
        }
    }
#undef IN
#undef BOTH
#undef GRID_BAR
}

extern "C" void kernel_launch(void* const* d_in, const int* in_sizes, int n_in, void* d_out, int out_size, void* d_ws, size_t ws_size, hipStream_t stream) {
    static int grid = 0;
    if (grid == 0) {
        if (n_in != 20 || out_size != M * D || ws_size < WS_END) { fprintf(stderr, "kernel_launch: unexpected shapes (n_in %d, out %d, ws %zu); nothing launched\n", n_in, out_size, ws_size); grid = -1; return; }
        int dev = 0, cus = 0, per_cu = 0;
        if (hipGetDevice(&dev) != hipSuccess || hipDeviceGetAttribute(&cus, hipDeviceAttributeMultiprocessorCount, dev) != hipSuccess) { grid = -1; return; }
        if (hipFuncSetAttribute((const void*)mk_fwd, hipFuncAttributeMaxDynamicSharedMemorySize, LDS_BYTES) != hipSuccess) { fprintf(stderr, "kernel_launch: hipFuncSetAttribute failed\n"); grid = -1; return; }
        if (hipOccupancyMaxActiveBlocksPerMultiprocessor(&per_cu, (const void*)mk_fwd, NWAVES * 64, LDS_BYTES) != hipSuccess || per_cu < 1)
            fprintf(stderr, "kernel_launch: note: occupancy query reports %d workgroups per CU\n", per_cu);
        (void)hipGetLastError();
        grid = cus;
    }
    if (grid < 0) return;
    if (hipMemsetAsync((char*)d_ws + WS_CTL, 0, CTL_ZERO_BYTES, stream) != hipSuccess) return;
    Args a{};
    for (int i = 0; i < 20; ++i) a.in[i] = (const float*)d_in[i];
    a.out = (float*)d_out; a.ws = (unsigned char*)d_ws;
#if MK_SPLIT
    for (int ph = 0; ph < NPH; ++ph) { a.ph_lo = ph; a.ph_hi = ph + 1; hipLaunchKernelGGL(mk_fwd, dim3(grid), dim3(NWAVES * 64), LDS_BYTES, stream, a); }
#else
    a.ph_lo = 0; a.ph_hi = NPH; hipLaunchKernelGGL(mk_fwd, dim3(grid), dim3(NWAVES * 64), LDS_BYTES, stream, a);
#endif
}
```

```cpp
#include <hip/hip_runtime.h>
#include <cstdio>
#include <cstdint>

#ifndef MK_SPLIT
#define MK_SPLIT 0
#endif

#define GAS __attribute__((address_space(1)))
#define LAS __attribute__((address_space(3)))
typedef unsigned short bf16;
typedef unsigned v4u __attribute__((ext_vector_type(4)));
typedef unsigned v2u __attribute__((ext_vector_type(2)));
typedef int v4i __attribute__((ext_vector_type(4)));
typedef float f32x2 __attribute__((ext_vector_type(2)));
typedef float f32x4 __attribute__((ext_vector_type(4)));
typedef float f32x16 __attribute__((ext_vector_type(16)));
typedef short bf16x8 __attribute__((ext_vector_type(8)));
typedef __bf16 bf16x2_t __attribute__((ext_vector_type(2)));
typedef GAS unsigned gu32;

constexpr int NB = 16, SEQ = 4096, M = NB * SEQ, D = 1024, NH = 8, HD = 64, PW = 512, AW = 512, NE = 32, TOPK = 4, DE = 1024, PLE = 256;
constexpr int NPROJ_A = 3584;
constexpr float EPS = 1e-6f;
constexpr float LOG2E = 1.4426950408889634f;
constexpr float QSCALE = 0.125f * LOG2E;
constexpr float ATT_THR = 152.0f;
constexpr int NWAVES = 8;
constexpr int NPH = 19;

constexpr size_t MiB = 1u << 20;
constexpr size_t WS_CTL = 0, CTL_ZERO_BYTES = 1 * MiB;
constexpr size_t WS_R2 = 1 * MiB;
constexpr size_t WS_R3 = WS_R2 + 256 * 1024;
constexpr size_t WS_TKE = 2 * MiB;
constexpr size_t WS_TKW = 3 * MiB;
constexpr size_t WS_TKR = 4 * MiB;
constexpr size_t WS_ROWT = 5 * MiB;
constexpr size_t WS_ROWW = 6 * MiB;
constexpr size_t WS_ROWR = 7 * MiB;
constexpr size_t WS_CNTWG = 8 * MiB;
constexpr size_t WS_SEGTOT = WS_CNTWG + 256 * 1024;
constexpr size_t WS_WRF = 9 * MiB;
constexpr size_t WS_WIN = 16 * MiB;
constexpr size_t WS_WEFF = 24 * MiB;
constexpr size_t WS_WAU = 25 * MiB;
constexpr size_t WS_WOUT = 26 * MiB;
constexpr size_t WS_WPG = 28 * MiB;
constexpr size_t WS_WPP = 30 * MiB;
constexpr size_t WS_WGU = 32 * MiB;
constexpr size_t WS_WDN = 160 * MiB;
constexpr size_t WS_A = 224 * MiB;
constexpr size_t WS_B = 352 * MiB;
constexpr size_t WS_C = 480 * MiB;
constexpr size_t WS_E = 608 * MiB;
constexpr size_t WS_PB = 736 * MiB;
constexpr size_t WS_END = 768 * MiB;
constexpr int CW_BAR = 4096;

constexpr int RING_BYTES = 131072;
constexpr int LDSCTL_OFF = RING_BYTES, MISC_OFF = LDSCTL_OFF + 320;
constexpr int LDS_TAB_OFF = MISC_OFF + 128;
constexpr int LDS_BYTES = 147456;

#define RLX_AGENT __ATOMIC_RELAXED, __HIP_MEMORY_SCOPE_AGENT
#define LDS_WAIT() asm volatile("s_waitcnt lgkmcnt(0)" ::: "memory")
#define VM_WAIT() asm volatile("s_waitcnt vmcnt(0)" ::: "memory")

__device__ __forceinline__ unsigned f2bf(float f) { unsigned u = __builtin_bit_cast(unsigned, f); return (u + 0x7fffu + ((u >> 16) & 1u)) >> 16; }
__device__ __forceinline__ unsigned pk2(float lo, float hi) { f32x2 v = {lo, hi}; bf16x2_t b = __builtin_convertvector(v, bf16x2_t); return __builtin_bit_cast(unsigned, b); }
__device__ __forceinline__ float bflo(unsigned u) { return __builtin_bit_cast(float, u << 16); }
__device__ __forceinline__ float bfhi(unsigned u) { return __builtin_bit_cast(float, u & 0xffff0000u); }
__device__ __forceinline__ float fast_sigmoid(float v) { return __builtin_amdgcn_rcpf(1.0f + __builtin_amdgcn_exp2f(-LOG2E * v)); }
__device__ __forceinline__ float wave_sum(float v) {
#pragma unroll
    for (int o = 1; o < 64; o <<= 1) v += __shfl_xor(v, o);
    return v;
}

#define XB_TMO      128
#define XB_XCNT(j)  (256  + 64 * (j))
#define XB_XSUB(j)  (1280 + 64 * (j))
#define XB_XGEN(j)  (2304 + 64 * (j))
#define XB_TOP      3328
#define XB_TOPGEN   3392
#define XCD_BAR_WORDS 3456
#define XB_SPIN_CAP (1u << 18)
__device__ __forceinline__ unsigned xb_ld(unsigned* p)              { return __hip_atomic_load(p, __ATOMIC_RELAXED, __HIP_MEMORY_SCOPE_AGENT); }
__device__ __forceinline__ unsigned xb_add(unsigned* p, unsigned v) { return __hip_atomic_fetch_add(p, v, __ATOMIC_RELAXED, __HIP_MEMORY_SCOPE_AGENT); }
__device__ __forceinline__ unsigned xb_xcc_id() { return (unsigned)__builtin_amdgcn_s_getreg((3 << 11) | 20) & 0xFu; }
#define XB_SPIN(cond, bar) do { unsigned _sp = 0; while (cond) { __builtin_amdgcn_s_sleep(1); \
    if ((++_sp & 255u) == 0u) { if (xb_ld(&(bar)[XB_TMO])) break; if (_sp > XB_SPIN_CAP) { atomicAdd(&(bar)[XB_TMO], 1u); break; } } } } while (0)
struct XcdBarrier { unsigned* bar; unsigned x; volatile LAS unsigned* st; };
__device__ __forceinline__ XcdBarrier xcd_barrier_post(unsigned* bar, volatile LAS unsigned* st) {
    XcdBarrier b; b.bar = bar; b.x = xb_xcc_id(); b.st = st;
    if (threadIdx.x == 0) (void)xb_add(&bar[XB_XCNT(b.x)], 1u);
    return b;
}
__device__ __forceinline__ void xcd_barrier_complete(unsigned* bar, unsigned x, unsigned& nloc, unsigned& nx) {
    const unsigned G = gridDim.x * gridDim.y * gridDim.z;
    unsigned sum, cnt, mine, sp = 0u;
    for (;;) {
        sum = 0u; cnt = 0u; mine = 0u;
#pragma unroll
        for (unsigned j = 0; j < 16; ++j) { const unsigned c = xb_ld(&bar[XB_XCNT(j)]); sum += c; cnt += (c > 0u) ? 1u : 0u; mine = (j == x) ? c : mine; }
        if (sum == G) break;
        __builtin_amdgcn_s_sleep(1);
        if ((++sp & 255u) == 0u) { if (xb_ld(&bar[XB_TMO])) break; if (sp > XB_SPIN_CAP) { atomicAdd(&bar[XB_TMO], 1u); break; } }
    }
    nloc = mine > 0u ? mine : 1u; nx = cnt > 0u ? cnt : 1u;
}
__device__ __forceinline__ void xcd_barrier(const XcdBarrier& b) {
    asm volatile("s_waitcnt vmcnt(0)" ::: "memory");
    __syncthreads();
    if (threadIdx.x == 0) {
        unsigned* bar = b.bar;
        __builtin_amdgcn_s_waitcnt(0);
        unsigned nloc = b.st[0], nx = b.st[1];
        if (nloc == 0u) { xcd_barrier_complete(bar, b.x, nloc, nx); b.st[0] = nloc; b.st[1] = nx; }
        const unsigned old = xb_add(&bar[XB_XSUB(b.x)], 1u);
        const unsigned gen = old / nloc;
        if (old + 1u == (gen + 1u) * nloc) {
            __builtin_amdgcn_fence(__ATOMIC_RELEASE, "agent");
            asm volatile("s_waitcnt vmcnt(0)" ::: "memory");
            const unsigned og = xb_add(&bar[XB_TOP], 1u);
            const unsigned tg = og / nx;
            if (og + 1u == (tg + 1u) * nx) xb_add(&bar[XB_TOPGEN], 1u);
            else XB_SPIN(xb_ld(&bar[XB_TOPGEN]) == tg, bar);
            __builtin_amdgcn_fence(__ATOMIC_ACQUIRE, "agent");
            xb_add(&bar[XB_XGEN(b.x)], 1u);
            asm volatile("s_waitcnt vmcnt(0)" ::: "memory");
        } else {
            XB_SPIN(xb_ld(&bar[XB_XGEN(b.x)]) == gen, bar);
            __builtin_amdgcn_fence(__ATOMIC_ACQUIRE, "agent");
            asm volatile("s_waitcnt vmcnt(0)" ::: "memory");
        }
    }
    __syncthreads();
}

namespace pg8 {
constexpr int BM = 256, BK = 64, HALF = 128, HTB = HALF * BK * 2, NXCD = 8, WGM = 8;
__host__ __device__ __forceinline__ int lds_byte(int r, int c) { const int st = (r >> 4) * 2 + (c >> 5), rr = r & 15, cc = c & 31, ob = rr * 64 + cc * 2; return st * 1024 + (ob ^ (((ob >> 9) & 1) << 5)); }
__host__ __device__ __forceinline__ void stage_rc(int b, int& R, int& C) { const int st = b / 1024, sb = b % 1024, swz = sb ^ (((sb >> 9) & 1) << 5); R = (st >> 1) * 16 + swz / 64; C = (st & 1) * 32 + (swz % 64) / 2; }
__host__ __device__ __forceinline__ int perm32(int rho) { const int n = rho >> 4, i = rho & 15; return 8 * (i >> 2) + 4 * n + (i & 3); }

struct Unit { int pm, pn, e, row0, nvalid; };
struct Gemm { const bf16* A; const bf16* Bt; int K; };

struct StaticOrder {
    int nM, nN, nwg, G, c;
    __device__ void init(int Mr, int N, int G_, int c_) { nM = Mr / BM; nN = N / BM; nwg = nM * nN; G = G_; c = c_; }
    __device__ __forceinline__ bool next(int i, Unit& u) const {
        const long L = (long)i * G + c; if (L >= nwg) return false;
        int wgid = (int)L; { const int q = nwg / NXCD, r = nwg % NXCD, xcd = wgid % NXCD, off = wgid / NXCD; wgid = (xcd < r ? xcd * (q + 1) : r * (q + 1) + (xcd - r) * q) + off; }
        const int nig = WGM * nN, gid = wgid / nig, fm = gid * WGM, gsz = (nM - fm) < WGM ? (nM - fm) : WGM;
        u.pm = fm + ((wgid % nig) % gsz); u.pn = (wgid % nig) / gsz; u.e = 0; u.row0 = u.pm * BM; u.nvalid = BM; return true;
    }
    __device__ __forceinline__ void a_off(const Unit& u, const int (&Rl)[2], const int (&Cl)[2], int K, unsigned (&va)[2][2]) const {
#pragma unroll
        for (int h = 0; h < 2; ++h)
#pragma unroll
            for (int i = 0; i < 2; ++i) va[h][i] = (unsigned)((u.pm * BM + h * HALF + Rl[i]) * K + Cl[i]) * 2u;
    }
    __device__ __forceinline__ const char* b_ptr(const Unit& u, const Gemm& g) const { return (const char*)g.Bt + (size_t)u.pn * BM * g.K * 2; }
};

template <class Epi, class Sched, bool ALIGN_EPI>
__device__ __forceinline__ void gemm_phase(LAS unsigned char* lds, const Gemm g, const Sched& S, const Epi& E) {
    const int tid = threadIdx.x, wid = __builtin_amdgcn_readfirstlane(tid >> 6), lane = tid & 63, wr = wid >> 2, wc = wid & 3, fr = lane & 15, fq = lane >> 4;
    const int K = g.K, nt = K / BK;
    int Rl[2], Cl[2]; unsigned voffB[2];
#pragma unroll
    for (int i = 0; i < 2; ++i) { int R, C; stage_rc(tid * 16 + i * 8192, R, C); const int Rb = Epi::PERM ? ((R & ~31) + perm32(R & 31)) : R;
        Rl[i] = R; Cl[i] = C; voffB[i] = (unsigned)(Rb * K + C) * 2u; }
    const size_t kstep = (size_t)(BK * 2);
    const size_t hstep = (size_t)HALF * K * 2;
    const unsigned ldsw = (unsigned)wid * 1024u;
    const int aoff = lds_byte(wr * 64 + fr, fq * 8), boff = lds_byte(wc * 32 + fr, fq * 8);
#define PG8_SA(b, h) (((b) * 2 + (h)) * HTB)
#define PG8_SB(b, h) ((4 + (b) * 2 + (h)) * HTB)
#define PG8_STAGE(bufoff, gbase, voff) do { _Pragma("unroll") for (int _i = 0; _i < 2; ++_i) \
        __builtin_amdgcn_global_load_lds((const unsigned*)((const char*)(gbase) + (voff)[_i]), (LAS unsigned*)(lds + (bufoff) + ldsw + _i * 8192), 16, 0, 0); } while (0)
#define PG8_LDA(dst, b, h) do { _Pragma("unroll") for (int m = 0; m < 4; ++m) _Pragma("unroll") for (int k = 0; k < 2; ++k) dst[m][k] = *(const LAS bf16x8*)(lds + PG8_SA(b, h) + aoff + m * 2048 + k * 1024); } while (0)
#define PG8_LDB(dst, b, h) do { _Pragma("unroll") for (int n = 0; n < 2; ++n) _Pragma("unroll") for (int k = 0; k < 2; ++k) dst[n][k] = *(const LAS bf16x8*)(lds + PG8_SB(b, h) + boff + n * 2048 + k * 1024); } while (0)
#define PG8_MMA(ai, bj, At, Bt) do { __builtin_amdgcn_s_setprio(1); _Pragma("unroll") for (int m = 0; m < 4; ++m) _Pragma("unroll") for (int n = 0; n < 2; ++n) _Pragma("unroll") for (int k = 0; k < 2; ++k) \
        acc[ai][bj][m][n] = __builtin_amdgcn_mfma_f32_16x16x32_bf16(Bt[n][k], At[m][k], acc[ai][bj][m][n], 0, 0, 0); __builtin_amdgcn_s_setprio(0); } while (0)
#define PG8_WAIT_V(n) asm volatile("s_waitcnt vmcnt(" #n ")" ::: "memory")
#define PG8_WAIT_L(n) asm volatile("s_waitcnt lgkmcnt(" #n ")" ::: "memory")
#define PG8_BAR __builtin_amdgcn_s_barrier()
#define PG8_SCHED __builtin_amdgcn_sched_barrier(0)
    Unit cur, nxt; int ui = 0;
    if (!S.next(0, cur)) return;
    f32x4 acc[2][2][4][2];
#pragma unroll
    for (int a = 0; a < 2; ++a)
#pragma unroll
        for (int b = 0; b < 2; ++b)
#pragma unroll
            for (int m = 0; m < 4; ++m)
#pragma unroll
                for (int n = 0; n < 2; ++n) acc[a][b][m][n] = (f32x4){0.f, 0.f, 0.f, 0.f};
    bf16x8 At[4][2], B0[2][2], B1[2][2];
    unsigned cva[2][2], nva[2][2];
    S.a_off(cur, Rl, Cl, K, cva);
    const char* const Ab = (const char*)g.A;
    const char* cB = S.b_ptr(cur, g);
    PG8_STAGE(PG8_SB(0, 0), cB, voffB); PG8_STAGE(PG8_SB(0, 1), cB + hstep, voffB); PG8_STAGE(PG8_SA(0, 0), Ab, cva[0]); PG8_STAGE(PG8_SA(0, 1), Ab, cva[1]);
    if (wr == 1) PG8_BAR;
    PG8_WAIT_V(2); PG8_BAR;
    PG8_STAGE(PG8_SB(1, 0), cB + kstep, voffB); PG8_STAGE(PG8_SA(1, 0), Ab + kstep, cva[0]); PG8_STAGE(PG8_SB(1, 1), cB + hstep + kstep, voffB);
    PG8_WAIT_V(6); PG8_BAR;
    for (;;) {
        const bool has_next = S.next(ui + 1, nxt);
        const char* nB = cB;
        if (has_next) { S.a_off(nxt, Rl, Cl, K, nva); nB = S.b_ptr(nxt, g); }
        else {
#pragma unroll
            for (int h = 0; h < 2; ++h)
#pragma unroll
                for (int i = 0; i < 2; ++i) nva[h][i] = cva[h][i];
        }
        for (int t = 0; t < nt; t += 2) {
            const bool last = (t == nt - 2);
            const char* a1 = Ab + (size_t)(t + 1) * kstep;
            const char* a2 = last ? Ab : Ab + (size_t)(t + 2) * kstep; const char* b2 = last ? nB : cB + (size_t)(t + 2) * kstep;
            const char* a3 = a2 + kstep; const char* b3 = b2 + kstep;
            unsigned va2[2][2];
#pragma unroll
            for (int h = 0; h < 2; ++h)
#pragma unroll
                for (int i = 0; i < 2; ++i) va2[h][i] = last ? nva[h][i] : cva[h][i];
            PG8_LDB(B0, 0, 0); PG8_LDB(B1, 0, 1); PG8_SCHED; PG8_LDA(At, 0, 0); PG8_STAGE(PG8_SA(1, 1), a1, cva[1]);
            PG8_WAIT_V(8); PG8_WAIT_L(0); PG8_BAR; PG8_MMA(0, 0, At, B0); PG8_MMA(0, 1, At, B1); PG8_BAR; PG8_SCHED;
            PG8_LDA(At, 0, 1); PG8_STAGE(PG8_SB(0, 0), b2, voffB); PG8_STAGE(PG8_SB(0, 1), b2 + hstep, voffB); PG8_STAGE(PG8_SA(0, 0), a2, va2[0]);
            PG8_WAIT_V(8); PG8_WAIT_L(0); PG8_BAR; PG8_MMA(1, 0, At, B0); PG8_MMA(1, 1, At, B1); PG8_BAR; PG8_SCHED;
            PG8_LDB(B0, 1, 0); PG8_LDB(B1, 1, 1); PG8_SCHED; PG8_LDA(At, 1, 0); PG8_STAGE(PG8_SA(0, 1), a2, va2[1]);
            PG8_WAIT_V(8); PG8_WAIT_L(0); PG8_BAR; PG8_MMA(0, 0, At, B0); PG8_MMA(0, 1, At, B1); PG8_BAR; PG8_SCHED;
            PG8_LDA(At, 1, 1); PG8_STAGE(PG8_SB(1, 0), b3, voffB); PG8_STAGE(PG8_SB(1, 1), b3 + hstep, voffB); PG8_STAGE(PG8_SA(1, 0), a3, va2[0]);
            PG8_WAIT_V(8); PG8_WAIT_L(0); PG8_BAR; PG8_MMA(1, 0, At, B0); PG8_MMA(1, 1, At, B1); PG8_BAR; PG8_SCHED;
        }
        if constexpr (ALIGN_EPI) { if (wr == 0) PG8_BAR; }
        E(acc, cur, wr, wc, fr, fq);
        if (!has_next) break;
#pragma unroll
        for (int a = 0; a < 2; ++a)
#pragma unroll
            for (int b = 0; b < 2; ++b)
#pragma unroll
                for (int m = 0; m < 4; ++m)
#pragma unroll
                    for (int n = 0; n < 2; ++n) acc[a][b][m][n] = (f32x4){0.f, 0.f, 0.f, 0.f};
        cur = nxt; cB = nB; ++ui;
#pragma unroll
        for (int h = 0; h < 2; ++h)
#pragma unroll
            for (int i = 0; i < 2; ++i) cva[h][i] = nva[h][i];
        if constexpr (ALIGN_EPI) { if (wr == 1) PG8_BAR; }
    }
    PG8_WAIT_V(0);
    if constexpr (!ALIGN_EPI) { if (wr == 0) PG8_BAR; }
    PG8_BAR;
#undef PG8_SA
#undef PG8_SB
#undef PG8_STAGE
#undef PG8_LDA
#undef PG8_LDB
#undef PG8_MMA
#undef PG8_WAIT_V
#undef PG8_WAIT_L
#undef PG8_BAR
#undef PG8_SCHED
}

__device__ __forceinline__ v4u pack8(const f32x4 a, const f32x4 b) { v4u w; w.x = pk2(a[0], a[1]); w.y = pk2(a[2], a[3]); w.z = pk2(b[0], b[1]); w.w = pk2(b[2], b[3]); return w; }
__device__ __forceinline__ void unpack8(const v4u w, f32x4& a, f32x4& b) { a = (f32x4){bflo(w.x), bfhi(w.x), bflo(w.y), bfhi(w.y)}; b = (f32x4){bflo(w.z), bfhi(w.z), bflo(w.w), bfhi(w.w)}; }

struct EpiPlain {
    static constexpr bool PERM = true;
    bf16* O; int ldc;
    __device__ __forceinline__ void operator()(const f32x4 (&acc)[2][2][4][2], const Unit& u, int wr, int wc, int fr, int fq) const {
        const int row0 = u.pm * BM + wr * 64 + fr, col0 = u.pn * BM + wc * 32 + 8 * fq;
#pragma unroll
        for (int ai = 0; ai < 2; ++ai)
#pragma unroll
            for (int m = 0; m < 4; ++m) { bf16* rowp = O + (size_t)(row0 + ai * HALF + m * 16) * ldc + col0;
#pragma unroll
                for (int bj = 0; bj < 2; ++bj) *(GAS v4u*)(rowp + bj * HALF) = pack8(acc[ai][bj][m][0], acc[ai][bj][m][1]); }
    }
};
struct EpiProj {
    static constexpr bool PERM = true;
    bf16 *U, *Q, *Kb, *GP, *GA;
    __device__ __forceinline__ void operator()(const f32x4 (&acc)[2][2][4][2], const Unit& u, int wr, int wc, int fr, int fq) const {
        const int pn = u.pn; bf16* base; int ldc, colt; float sc = 1.f; bool sig = false;
        if (pn < 2) { base = U; ldc = 512; colt = pn * 256; }
        else if (pn < 4) { base = Q; ldc = 512; colt = (pn - 2) * 256; sc = QSCALE; }
        else if (pn < 6) { base = Kb; ldc = 512; colt = (pn - 4) * 256; }
        else if (pn < 10) { base = GP; ldc = 1024; colt = (pn - 6) * 256; sig = true; }
        else { base = GA; ldc = 1024; colt = (pn - 10) * 256; sig = true; }
        const int row0 = u.pm * BM + wr * 64 + fr, col0 = colt + wc * 32 + 8 * fq;
#pragma unroll
        for (int ai = 0; ai < 2; ++ai)
#pragma unroll
            for (int m = 0; m < 4; ++m) { bf16* rowp = base + (size_t)(row0 + ai * HALF + m * 16) * ldc + col0;
#pragma unroll
                for (int bj = 0; bj < 2; ++bj) { f32x4 v0 = acc[ai][bj][m][0], v1 = acc[ai][bj][m][1];
                    if (sig) {
#pragma unroll
                        for (int j = 0; j < 4; ++j) { v0[j] = fast_sigmoid(v0[j]); v1[j] = fast_sigmoid(v1[j]); }
                    } else { v0 = v0 * sc; v1 = v1 * sc; }
                    *(GAS v4u*)(rowp + bj * HALF) = pack8(v0, v1); } }
    }
};
template <bool ADD> struct EpiGate {
    static constexpr bool PERM = true;
    bf16* O; const bf16* G;
    __device__ __forceinline__ void operator()(const f32x4 (&acc)[2][2][4][2], const Unit& u, int wr, int wc, int fr, int fq) const {
        const int row0 = u.pm * BM + wr * 64 + fr, col0 = u.pn * BM + wc * 32 + 8 * fq;
#pragma unroll
        for (int ai = 0; ai < 2; ++ai)
#pragma unroll
            for (int m = 0; m < 4; ++m) { const size_t ro = (size_t)(row0 + ai * HALF + m * 16) * 1024 + col0;
#pragma unroll
                for (int bj = 0; bj < 2; ++bj) { f32x4 g0, g1; unpack8(*(const GAS v4u*)(G + ro + bj * HALF), g0, g1);
                    f32x4 v0 = acc[ai][bj][m][0] * g0, v1 = acc[ai][bj][m][1] * g1;
                    if (ADD) { f32x4 o0, o1; unpack8(*(const GAS v4u*)(O + ro + bj * HALF), o0, o1); v0 = v0 + o0; v1 = v1 + o1; }
                    *(GAS v4u*)(O + ro + bj * HALF) = pack8(v0, v1); } }
    }
};
struct EpiResid {
    static constexpr bool PERM = true;
    bf16* O; const float* X;
    __device__ __forceinline__ void operator()(const f32x4 (&acc)[2][2][4][2], const Unit& u, int wr, int wc, int fr, int fq) const {
        const int row0 = u.pm * BM + wr * 64 + fr, col0 = u.pn * BM + wc * 32 + 8 * fq;
#pragma unroll
        for (int ai = 0; ai < 2; ++ai)
#pragma unroll
            for (int m = 0; m < 4; ++m) { const size_t ro = (size_t)(row0 + ai * HALF + m * 16) * 1024 + col0;
#pragma unroll
                for (int bj = 0; bj < 2; ++bj) { const f32x4 x0 = *(const GAS f32x4*)(X + ro + bj * HALF), x1 = *(const GAS f32x4*)(X + ro + bj * HALF + 4);
                    *(GAS v4u*)(O + ro + bj * HALF) = pack8(acc[ai][bj][m][0] + x0, acc[ai][bj][m][1] + x1); } }
    }
};
struct EpiPle {
    static constexpr bool PERM = true;
    bf16* O; const bf16* X2; const bf16* PP; const float* R3;
    __device__ __forceinline__ void operator()(const f32x4 (&acc)[2][2][4][2], const Unit& u, int wr, int wc, int fr, int fq) const {
        const int row0 = u.pm * BM + wr * 64 + fr, col0 = u.pn * BM + wc * 32 + 8 * fq;
#pragma unroll
        for (int ai = 0; ai < 2; ++ai)
#pragma unroll
            for (int m = 0; m < 4; ++m) { const int row = row0 + ai * HALF + m * 16; const size_t ro = (size_t)row * 1024 + col0; const float r = R3[row];
#pragma unroll
                for (int bj = 0; bj < 2; ++bj) { f32x4 x0, x1, p0, p1; unpack8(*(const GAS v4u*)(X2 + ro + bj * HALF), x0, x1); unpack8(*(const GAS v4u*)(PP + ro + bj * HALF), p0, p1);
                    f32x4 v0, v1;
#pragma unroll
                    for (int j = 0; j < 4; ++j) { v0[j] = x0[j] + fast_sigmoid(r * acc[ai][bj][m][0][j]) * p0[j]; v1[j] = x1[j] + fast_sigmoid(r * acc[ai][bj][m][1][j]) * p1[j]; }
                    *(GAS v4u*)(O + ro + bj * HALF) = pack8(v0, v1); } }
    }
};

struct MoeOrder {
    const LAS int* tab; const int* row_token; const bf16* W; int NT, G, c, total; bool gather; size_t wstride;
    __device__ __forceinline__ bool next(int i, Unit& u) const {
        const long L = (long)i * G + c; if (L >= total) return false;
        const int rt = (int)(L / NT); u.pn = (int)(L % NT);
        int e = 0;
#pragma unroll
        for (int j = 1; j < 32; ++j) e += (tab[j] <= rt) ? 1 : 0;
        e = __builtin_amdgcn_readfirstlane(e);
        const int lt = rt - __builtin_amdgcn_readfirstlane(tab[e]), cn = __builtin_amdgcn_readfirstlane(tab[65 + e]);
        u.e = e; u.pm = rt; u.row0 = __builtin_amdgcn_readfirstlane(tab[33 + e]) + lt * 256; u.nvalid = (cn - lt * 256) < 256 ? (cn - lt * 256) : 256; return true;
    }
    __device__ __forceinline__ void a_off(const Unit& u, const int (&Rl)[2], const int (&Cl)[2], int K, unsigned (&va)[2][2]) const {
#pragma unroll
        for (int h = 0; h < 2; ++h)
#pragma unroll
            for (int i = 0; i < 2; ++i) {
                const int rl = h * HALF + Rl[i];
                if (gather) { const int rr = rl < u.nvalid ? rl : 0; const int tok = row_token[u.row0 + rr]; va[h][i] = (unsigned)(tok * 1024 + Cl[i]) * 2u; }
                else va[h][i] = (unsigned)((u.row0 + rl) * 1024 + Cl[i]) * 2u;
            }
    }
    __device__ __forceinline__ const char* b_ptr(const Unit& u, const Gemm& g) const { return (const char*)(W + (size_t)u.e * wstride + (size_t)u.pn * 256 * 1024); }
};
struct EpiMoe1 {
    static constexpr bool PERM = true;
    bf16* act; const float* row_r; const float* bgu;
    __device__ __forceinline__ void operator()(const f32x4 (&acc)[2][2][4][2], const Unit& u, int wr, int wc, int fr, int fq) const {
        const int cl = u.pn * 128 + wc * 32 + 8 * fq;
        const float* bg = bgu + (size_t)u.e * 2048 + cl;
        const f32x4 g0b = *(const GAS f32x4*)(bg), g1b = *(const GAS f32x4*)(bg + 4), u0b = *(const GAS f32x4*)(bg + 1024), u1b = *(const GAS f32x4*)(bg + 1028);
#pragma unroll
        for (int ai = 0; ai < 2; ++ai)
#pragma unroll
            for (int m = 0; m < 4; ++m) { const int rl = ai * HALF + wr * 64 + m * 16 + fr;
                if (rl < u.nvalid) { const float r = row_r[u.row0 + rl];
                    const f32x4 ga = acc[ai][0][m][0] * r + g0b, gb = acc[ai][0][m][1] * r + g1b, ua = acc[ai][1][m][0] * r + u0b, ub = acc[ai][1][m][1] * r + u1b;
                    f32x4 o0, o1;
#pragma unroll
                    for (int j = 0; j < 4; ++j) {
                        { const float gt = fminf(ga[j], 7.0f), up = fminf(fmaxf(ua[j], -7.0f), 7.0f); o0[j] = (up + 1.0f) * gt * fast_sigmoid(1.702f * gt); }
                        { const float gt = fminf(gb[j], 7.0f), up = fminf(fmaxf(ub[j], -7.0f), 7.0f); o1[j] = (up + 1.0f) * gt * fast_sigmoid(1.702f * gt); }
                    }
                    *(GAS v4u*)(act + (size_t)(u.row0 + rl) * 1024 + cl) = pack8(o0, o1); } }
    }
};
struct EpiMoe2 {
    static constexpr bool PERM = true;
    bf16* X2; const bf16* SRC; const int* row_token; const float* row_w; const float* bdn;
    __device__ __forceinline__ void operator()(const f32x4 (&acc)[2][2][4][2], const Unit& u, int wr, int wc, int fr, int fq) const {
        const int col0 = u.pn * 256 + wc * 32 + 8 * fq;
        const float* bd = bdn + (size_t)u.e * 1024 + col0;
        f32x4 bv[2][2];
#pragma unroll
        for (int bj = 0; bj < 2; ++bj) { bv[bj][0] = *(const GAS f32x4*)(bd + bj * HALF); bv[bj][1] = *(const GAS f32x4*)(bd + bj * HALF + 4); }
#pragma unroll
        for (int ai = 0; ai < 2; ++ai)
#pragma unroll
            for (int m = 0; m < 4; ++m) { const int rl = ai * HALF + wr * 64 + m * 16 + fr;
                if (rl < u.nvalid) { const int tok = row_token[u.row0 + rl]; const float w = row_w[u.row0 + rl]; const size_t ro = (size_t)tok * 1024 + col0;
#pragma unroll
                    for (int bj = 0; bj < 2; ++bj) { f32x4 s0, s1; unpack8(*(const GAS v4u*)(SRC + ro + bj * HALF), s0, s1);
                        *(GAS v4u*)(X2 + ro + bj * HALF) = pack8(s0 + (acc[ai][bj][m][0] + bv[bj][0]) * w, s1 + (acc[ai][bj][m][1] + bv[bj][1]) * w); } } }
    }
};
}

struct Frame {
    LAS unsigned char* lds; volatile LAS unsigned* MISC; gu32* ctl;
    int tid, lane, wave, vcu, G;
};
struct Args { const float* in[20]; float* out; unsigned char* ws; int ph_lo, ph_hi; };

__device__ __forceinline__ void p0_transpose_item(const float* W, int N, int k0, int n0, bf16* WT, int Kp, int dst_row0, const float* gain, LAS float* scr, int lane) {
#pragma unroll 8
    for (int i = 0; i < 32; ++i) { const int kk = 2 * i + (lane >> 5); float v = W[(size_t)(k0 + kk) * N + n0 + (lane & 31)]; if (gain) v *= gain[k0 + kk]; scr[kk * 33 + (lane & 31)] = v; }
    LDS_WAIT(); asm volatile("" ::: "memory");
    const int c = lane & 7;
#pragma unroll
    for (int j = 0; j < 4; ++j) { const int n = (lane >> 3) + 8 * j; const LAS float* s = scr + (8 * c) * 33 + n;
        v4u o; o.x = pk2(s[0 * 33], s[1 * 33]); o.y = pk2(s[2 * 33], s[3 * 33]); o.z = pk2(s[4 * 33], s[5 * 33]); o.w = pk2(s[6 * 33], s[7 * 33]);
        *(GAS v4u*)(WT + (size_t)(dst_row0 + n) * Kp + k0 + 8 * c) = o; }
    LDS_WAIT(); asm volatile("" ::: "memory");
}
__device__ __forceinline__ void rms_row_f32_to_bf16(const float* xrow, const float* g, bf16* orow, int lane) {
    const GAS f32x4* xr = (const GAS f32x4*)xrow + lane; const GAS f32x4* gr = (const GAS f32x4*)g + lane;
    f32x4 v[4]; float s = 0.f;
#pragma unroll
    for (int j = 0; j < 4; ++j) { v[j] = xr[64 * j]; s += (v[j].x * v[j].x + v[j].y * v[j].y) + (v[j].z * v[j].z + v[j].w * v[j].w); }
    const float r = 1.0f / sqrtf(wave_sum(s) * (1.f / D) + EPS);
    GAS v2u* o8 = (GAS v2u*)orow + lane;
#pragma unroll
    for (int j = 0; j < 4; ++j) { const f32x4 gg = gr[64 * j]; v2u o; o.x = pk2(v[j].x * r * gg.x, v[j].y * r * gg.y); o.y = pk2(v[j].z * r * gg.z, v[j].w * r * gg.w); o8[64 * j] = o; }
}

#define MFMA32(a, b, c) __builtin_amdgcn_mfma_f32_32x32x16_bf16((a), (b), (c), 0, 0, 0)
__device__ __forceinline__ bf16x8 ldg16(const bf16* p) { return *(const GAS bf16x8*)p; }
__device__ __forceinline__ void attn_task(const bf16* __restrict__ Q, const bf16* __restrict__ Kp, const bf16* __restrict__ Vt, bf16* __restrict__ Y, int b, int h, int qb, int lane) {
    const int l31 = lane & 31, hl = lane >> 5;
    const int t0 = qb * 32; const size_t tb = (size_t)b * SEQ;
    bf16x8 qf[4];
    { const bf16* qrow = Q + (tb + t0 + l31) * 512 + h * 64 + 8 * hl;
#pragma unroll
      for (int kk = 0; kk < 4; ++kk) qf[kk] = ldg16(qrow + 16 * kk); }
    const int a_ = l31 >> 3, hh = (l31 >> 2) & 1, c_ = l31 & 3;
    const int pim = 16 * (a_ >> 1) + 8 * hh + 4 * (a_ & 1) + c_;
    const bf16* kbase = Kp + (tb + pim) * 512 + h * 64 + 8 * hl;
    const bf16* vbase = Vt + (size_t)(h * 64 + l31) * M + tb + 8 * hl;
    f32x16 o0, o1;
#pragma unroll
    for (int r = 0; r < 16; ++r) { o0[r] = 0.f; o1[r] = 0.f; }
    float carry = 0.f;
    int key0 = t0;
    bf16x8 kf[4], vf[4];
#pragma unroll
    for (int kk = 0; kk < 4; ++kk) kf[kk] = ldg16(kbase + (size_t)key0 * 512 + 16 * kk);
#pragma unroll
    for (int dj = 0; dj < 4; ++dj) vf[dj] = ldg16(vbase + (size_t)(dj >> 1) * 32 * M + key0 + 16 * (dj & 1));
    for (;;) {
        const int nk = key0 - 32; const bool more = nk >= 0;
        bf16x8 kn[4], vn[4];
        const int lk = more ? nk : key0;
#pragma unroll
        for (int kk = 0; kk < 4; ++kk) kn[kk] = ldg16(kbase + (size_t)lk * 512 + 16 * kk);
#pragma unroll
        for (int dj = 0; dj < 4; ++dj) vn[dj] = ldg16(vbase + (size_t)(dj >> 1) * 32 * M + lk + 16 * (dj & 1));
        f32x16 s;
#pragma unroll
        for (int r = 0; r < 16; ++r) s[r] = 0.f;
#pragma unroll
        for (int kk = 0; kk < 4; ++kk) s = MFMA32(kf[kk], qf[kk], s);
        const bool diag = (key0 == t0);
        float sp[16], ls[16];
        float lo = 0.f, hi = 0.f;
#pragma unroll
        for (int r = 0; r < 16; ++r) {
            const int ko = (r < 8) ? (8 * hl + r) : (16 + 8 * hl + (r - 8));
            const float z = s[r];
            const float e = __builtin_amdgcn_exp2f(-fabsf(z));
            const float lg = __builtin_amdgcn_logf(1.0f + e);
            float spv = fmaxf(z, 0.f) + lg;
            float lsv = fminf(z, 0.f) - lg;
            if (diag && ko >= l31) { spv = 0.f; lsv = -1.0e30f; }
            sp[r] = spv; ls[r] = lsv;
            if (r < 8) lo += spv; else hi += spv;
        }
        const float plo = __shfl_xor(lo, 32), phi = __shfl_xor(hi, 32);
        const float after_lo = (hl == 0) ? (plo + hi + phi) : (hi + phi);
        const float after_hi = (hl == 0) ? phi : 0.f;
        float w[16];
        { float run = carry + after_lo;
#pragma unroll
          for (int r = 7; r >= 0; --r) { w[r] = __builtin_amdgcn_exp2f(ls[r] - run); run += sp[r]; } }
        { float run = carry + after_hi;
#pragma unroll
          for (int r = 15; r >= 8; --r) { w[r] = __builtin_amdgcn_exp2f(ls[r] - run); run += sp[r]; } }
        carry += (lo + hi) + (plo + phi);
        v4u w0, w1;
        w0.x = pk2(w[0], w[1]); w0.y = pk2(w[2], w[3]); w0.z = pk2(w[4], w[5]); w0.w = pk2(w[6], w[7]);
        w1.x = pk2(w[8], w[9]); w1.y = pk2(w[10], w[11]); w1.z = pk2(w[12], w[13]); w1.w = pk2(w[14], w[15]);
        const bf16x8 W0 = __builtin_bit_cast(bf16x8, w0), W1 = __builtin_bit_cast(bf16x8, w1);
        o0 = MFMA32(vf[0], W0, o0); o0 = MFMA32(vf[1], W1, o0);
        o1 = MFMA32(vf[2], W0, o1); o1 = MFMA32(vf[3], W1, o1);
        if (!more) break;
        if (__all(carry >= ATT_THR)) break;
#pragma unroll
        for (int kk = 0; kk < 4; ++kk) { kf[kk] = kn[kk]; vf[kk] = vn[kk]; }
        key0 = nk;
    }
    bf16* yrow = Y + (tb + t0 + l31) * 512 + h * 64 + 4 * hl;
#pragma unroll
    for (int a = 0; a < 4; ++a) {
        v2u p0, p1; p0.x = pk2(o0[4 * a], o0[4 * a + 1]); p0.y = pk2(o0[4 * a + 2], o0[4 * a + 3]); p1.x = pk2(o1[4 * a], o1[4 * a + 1]); p1.y = pk2(o1[4 * a + 2], o1[4 * a + 3]);
        *(GAS v2u*)(yrow + 8 * a) = p0; *(GAS v2u*)(yrow + 32 + 8 * a) = p1;
    }
}

__device__ __forceinline__ void pool_row(const bf16* __restrict__ U, bf16* __restrict__ P, int tok, int lane) {
    const int t = tok & (SEQ - 1); const int w = 2 << (lane >> 4);
    float sum[8], cur[8];
#pragma unroll
    for (int j = 0; j < 8; ++j) { sum[j] = 0.f; cur[j] = 0.f; }
#pragma unroll
    for (int j = 0; j < 16; ++j) {
        if (j < w && j <= t) {
            const v4u v = *(const GAS v4u*)(U + (size_t)(tok - j) * 512 + 8 * lane);
            const float f[8] = {bflo(v.x), bfhi(v.x), bflo(v.y), bfhi(v.y), bflo(v.z), bfhi(v.z), bflo(v.w), bfhi(v.w)};
#pragma unroll
            for (int q = 0; q < 8; ++q) { sum[q] += f[q]; if (j == 0) cur[q] = f[q]; }
        }
    }
    const int cnt = (t + 1) < w ? (t + 1) : w; const float inv = 1.0f / (float)cnt;
    v4u o; o.x = pk2(sum[0] * inv - cur[0], sum[1] * inv - cur[1]); o.y = pk2(sum[2] * inv - cur[2], sum[3] * inv - cur[3]);
    o.z = pk2(sum[4] * inv - cur[4], sum[5] * inv - cur[5]); o.w = pk2(sum[6] * inv - cur[6], sum[7] * inv - cur[7]);
    *(GAS v4u*)(P + (size_t)tok * 512 + 8 * lane) = o;
}

__device__ __forceinline__ void router_task(const bf16* __restrict__ X1, const bf16* __restrict__ WrF, const float* __restrict__ b_router, int T0, int lane,
                                            float* __restrict__ R2, int* __restrict__ TKE, float* __restrict__ TKW, LAS int* lds_e  ) {
    const int l31 = lane & 31, hl = lane >> 5;
    const bf16* xr = X1 + (size_t)(T0 + l31) * 1024 + 8 * hl;
    f32x16 acc;
#pragma unroll
    for (int r = 0; r < 16; ++r) acc[r] = 0.f;
    float ssq = 0.f;
#pragma unroll 4
    for (int kk = 0; kk < 64; ++kk) {
        const v4u xv = *(const GAS v4u*)(xr + 16 * kk);
        const bf16x8 ah = ldg16(WrF + ((size_t)kk * 64 + lane) * 8), al = ldg16(WrF + 32768 + ((size_t)kk * 64 + lane) * 8);
        const float f0 = bflo(xv.x), f1 = bfhi(xv.x), f2 = bflo(xv.y), f3 = bfhi(xv.y), f4 = bflo(xv.z), f5 = bfhi(xv.z), f6 = bflo(xv.w), f7 = bfhi(xv.w);
        ssq += (f0 * f0 + f1 * f1) + (f2 * f2 + f3 * f3) + (f4 * f4 + f5 * f5) + (f6 * f6 + f7 * f7);
        const bf16x8 xb = __builtin_bit_cast(bf16x8, xv);
        acc = MFMA32(ah, xb, acc); acc = MFMA32(al, xb, acc);
    }
    ssq += __shfl_xor(ssq, 32);
    const float r = 1.0f / sqrtf(ssq * (1.f / D) + EPS);
    float v[16];
#pragma unroll
    for (int q = 0; q < 16; ++q) { const int e = 8 * (q >> 2) + 4 * hl + (q & 3); v[q] = acc[q] * r + b_router[e]; }
    float cv[8]; int ce[8];
#pragma unroll
    for (int k = 0; k < 4; ++k) {
        float best = -3.0e38f; int bi = 0;
#pragma unroll
        for (int q = 0; q < 16; ++q) { if (v[q] > best) { best = v[q]; bi = q; } }
        cv[k] = best; ce[k] = 8 * (bi >> 2) + 4 * hl + (bi & 3);
#pragma unroll
        for (int q = 0; q < 16; ++q) { if (q == bi) v[q] = -3.0e38f; }
    }
#pragma unroll
    for (int k = 0; k < 4; ++k) { cv[4 + k] = __shfl_xor(cv[k], 32); ce[4 + k] = __shfl_xor(ce[k], 32); }
    float tv[4]; int te[4];
#pragma unroll
    for (int k = 0; k < 4; ++k) {
        float best = -3.0e38f; int be = 1 << 20; int bi = 0;
#pragma unroll
        for (int q = 0; q < 8; ++q) { if (cv[q] > best || (cv[q] == best && ce[q] < be)) { best = cv[q]; be = ce[q]; bi = q; } }
        tv[k] = best; te[k] = be;
#pragma unroll
        for (int q = 0; q < 8; ++q) { if (q == bi) { cv[q] = -3.0e38f; ce[q] = 1 << 21; } }
    }
    const float p1 = __expf(tv[1] - tv[0]), p2 = __expf(tv[2] - tv[0]), p3 = __expf(tv[3] - tv[0]);
    const float inv = 1.0f / (1.0f + p1 + p2 + p3);
    if (hl == 0) {
        const int tok = T0 + l31;
        R2[tok] = r;
        *(GAS v4i*)(TKE + (size_t)tok * 4) = (v4i){te[0], te[1], te[2], te[3]};
        *(GAS f32x4*)(TKW + (size_t)tok * 4) = (f32x4){inv, p1 * inv, p2 * inv, p3 * inv};
        lds_e[l31 * 4 + 0] = te[0]; lds_e[l31 * 4 + 1] = te[1]; lds_e[l31 * 4 + 2] = te[2]; lds_e[l31 * 4 + 3] = te[3];
    }
}

__global__ void __launch_bounds__(NWAVES * 64, 2) mk_fwd(Args args) {
    extern __shared__ __attribute__((aligned(16))) unsigned char lds[];
    Frame F;
    F.lds = (LAS unsigned char*)lds;
    F.MISC = (volatile LAS unsigned*)(F.lds + MISC_OFF);
    F.tid = threadIdx.x; F.lane = F.tid & 63; F.wave = __builtin_amdgcn_readfirstlane(F.tid >> 6);
    F.G = gridDim.x; { const int bx = blockIdx.x; F.vcu = (F.G % 8 == 0) ? (bx % 8) * (F.G / 8) + bx / 8 : bx; }
    unsigned char* ws = args.ws;
    F.ctl = (gu32*)(ws + WS_CTL);
    for (int u = F.tid; u < (LDS_BYTES - LDSCTL_OFF) / 4; u += NWAVES * 64) ((LAS unsigned*)(F.lds + LDSCTL_OFF))[u] = 0u;
    __syncthreads();
    const int lo = args.ph_lo, hi = args.ph_hi;
    XcdBarrier bar; bar.bar = (unsigned*)(F.ctl + CW_BAR); bar.x = 0; bar.st = nullptr;
    if (hi - lo > 1) bar = xcd_barrier_post((unsigned*)(F.ctl + CW_BAR), F.MISC + 8);
#define IN(k) (lo <= (k) && (k) < hi)
#define BOTH(k) (IN(k) && IN((k) + 1))
#define GRID_BAR() xcd_barrier(bar)

    const float* x = args.in[0]; const float* p_in = args.in[1]; const float* g_mix = args.in[2]; const float* w_in = args.in[3]; const float* w_pool_grp = args.in[4];
    const float* pool_scale = args.in[5]; const float* w_pool_up = args.in[6]; const float* w_attn_up = args.in[7]; const float* w_out = args.in[8]; const float* g_ffn = args.in[9];
    const float* w_router = args.in[10]; const float* b_router = args.in[11]; const float* w_gu = args.in[12]; const float* b_gu = args.in[13]; const float* w_down = args.in[14];
    const float* b_down = args.in[15]; const float* g_ple = args.in[16]; const float* w_ple_gate = args.in[17]; const float* w_ple_proj = args.in[18]; const float* g_final = args.in[19];
    float* R2 = (float*)(ws + WS_R2); float* R3 = (float*)(ws + WS_R3);
    int* TKE = (int*)(ws + WS_TKE); float* TKW = (float*)(ws + WS_TKW); int* TKR = (int*)(ws + WS_TKR);
    int* ROWT = (int*)(ws + WS_ROWT); float* ROWW = (float*)(ws + WS_ROWW); float* ROWR = (float*)(ws + WS_ROWR);
    int* CNTWG = (int*)(ws + WS_CNTWG); int* SEGTOT = (int*)(ws + WS_SEGTOT);
    bf16* WRF = (bf16*)(ws + WS_WRF);
    bf16* WIN = (bf16*)(ws + WS_WIN); bf16* WEFF = (bf16*)(ws + WS_WEFF); bf16* WAU = (bf16*)(ws + WS_WAU); bf16* WOUT = (bf16*)(ws + WS_WOUT);
    bf16* WPG = (bf16*)(ws + WS_WPG); bf16* WPP = (bf16*)(ws + WS_WPP); bf16* WGU = (bf16*)(ws + WS_WGU); bf16* WDN = (bf16*)(ws + WS_WDN);
    bf16* H1 = (bf16*)(ws + WS_A); bf16* MRG = (bf16*)(ws + WS_A); bf16* PPB = (bf16*)(ws + WS_A);
    bf16* UB = (bf16*)(ws + WS_B); bf16* QB = (bf16*)(ws + WS_B + 64 * MiB); bf16* X1 = (bf16*)(ws + WS_B);
    bf16* KB = (bf16*)(ws + WS_C); bf16* VT = (bf16*)(ws + WS_C + 64 * MiB); bf16* X2 = (bf16*)(ws + WS_C);
    bf16* POOL = (bf16*)(ws + WS_E); bf16* YATT = (bf16*)(ws + WS_E + 64 * MiB); bf16* X3 = (bf16*)(ws + WS_E);
    bf16* PB = (bf16*)(ws + WS_PB);
    bf16* GPB = (bf16*)args.out; bf16* GAB = (bf16*)args.out + (size_t)M * 1024; bf16* ACT = (bf16*)args.out;
    const int gw = F.vcu * NWAVES + F.wave, NGW = F.G * NWAVES;
    LAS int* ltab = (LAS int*)(F.lds + LDS_TAB_OFF);

    if (IN(0)) {
        LAS float* scr = (LAS float*)(F.lds + F.wave * 16384);
        constexpr int I_IN = 16 * 128, I_AU = 8 * 32, I_OUT = 16 * 32, I_PG = 16 * 32, I_PP = 4 * 32, I_GU = 32 * 16 * 64, I_DN = 32 * 16 * 32;
        constexpr int NITEMS = I_IN + I_AU + I_OUT + I_PG + I_PP + I_GU + I_DN;
        for (int it = gw; it < NITEMS; it += NGW) {
            int r = it;
            if (r < I_IN) { const int kb = r / 128, nb = r % 128, n0 = nb * 32;
                const int blk = n0 / 512; const int dst = (blk < 3) ? n0 : (blk == 3 ? 3584 + (n0 - 1536) : n0 - 512);
                p0_transpose_item(w_in, 4096, kb * 64, n0, WIN, 1024, dst, nullptr, scr, F.lane); continue; } r -= I_IN;
            if (r < I_AU) { const int kb = r / 32, nb = r % 32; p0_transpose_item(w_attn_up, 1024, kb * 64, nb * 32, WAU, 512, nb * 32, nullptr, scr, F.lane); continue; } r -= I_AU;
            if (r < I_OUT) { const int kb = r / 32, nb = r % 32; p0_transpose_item(w_out, 1024, kb * 64, nb * 32, WOUT, 1024, nb * 32, nullptr, scr, F.lane); continue; } r -= I_OUT;
            if (r < I_PG) { const int kb = r / 32, nb = r % 32; p0_transpose_item(w_ple_gate, 1024, kb * 64, nb * 32, WPG, 1024, nb * 32, g_ple, scr, F.lane); continue; } r -= I_PG;
            if (r < I_PP) { const int kb = r / 32, nb = r % 32; p0_transpose_item(w_ple_proj, 1024, kb * 64, nb * 32, WPP, 256, nb * 32, nullptr, scr, F.lane); continue; } r -= I_PP;
            if (r < I_GU) { const int e = r / 1024, q = r % 1024, kb = q / 64, nb = q % 64, n0 = nb * 32;
                const int j = n0 & 1023; const int dst = 256 * (j / 128) + (j % 128) + (n0 >= 1024 ? 128 : 0);
                p0_transpose_item(w_gu + (size_t)e * 1024 * 2048, 2048, kb * 64, n0, WGU + (size_t)e * 2048 * 1024, 1024, dst, g_ffn, scr, F.lane); continue; } r -= I_GU;
            { const int e = r / 512, q = r % 512, kb = q / 32, nb = q % 32;
                p0_transpose_item(w_down + (size_t)e * 1024 * 1024, 1024, kb * 64, nb * 32, WDN + (size_t)e * 1024 * 1024, 1024, nb * 32, nullptr, scr, F.lane); }
        }
        for (int it = gw; it < 4 * 16 * 16; it += NGW) {
            const int g = it >> 8, cb = (it >> 4) & 15, db = it & 15; const int d = db * 64 + F.lane, c0 = cb * 8;
            float a8[8];
#pragma unroll
            for (int q = 0; q < 8; ++q) a8[q] = 0.f;
            for (int j = 0; j < 128; ++j) { const float wv = w_pool_up[(size_t)(g * 128 + j) * 1024 + d] * pool_scale[g * 128 + j];
#pragma unroll
                for (int q = 0; q < 8; ++q) a8[q] += w_pool_grp[(size_t)(g * 128 + c0 + q) * 128 + j] * wv; }
            v4u o; o.x = pk2(a8[0], a8[1]); o.y = pk2(a8[2], a8[3]); o.z = pk2(a8[4], a8[5]); o.w = pk2(a8[6], a8[7]);
            *(GAS v4u*)(WEFF + (size_t)d * 512 + g * 128 + c0) = o;
        }
        for (int it = gw * 64 + F.lane; it < 64 * 64; it += NGW * 64) {
            const int kk = it >> 6, l = it & 63, e = l & 31, k0 = 16 * kk + 8 * (l >> 5);
            unsigned hb[8], lb[8];
#pragma unroll
            for (int i = 0; i < 8; ++i) { const float v = g_ffn[k0 + i] * w_router[(size_t)(k0 + i) * 32 + e]; hb[i] = f2bf(v); lb[i] = f2bf(v - __builtin_bit_cast(float, hb[i] << 16)); }
            v4u oh, ol; oh.x = hb[0] | (hb[1] << 16); oh.y = hb[2] | (hb[3] << 16); oh.z = hb[4] | (hb[5] << 16); oh.w = hb[6] | (hb[7] << 16);
            ol.x = lb[0] | (lb[1] << 16); ol.y = lb[2] | (lb[3] << 16); ol.z = lb[4] | (lb[5] << 16); ol.w = lb[6] | (lb[7] << 16);
            *(GAS v4u*)(WRF + (size_t)it * 8) = oh; *(GAS v4u*)(WRF + 32768 + (size_t)it * 8) = ol;
        }
        for (int m = gw; m < M; m += NGW) rms_row_f32_to_bf16(x + (size_t)m * D, g_mix, H1 + (size_t)m * D, F.lane);
        for (size_t i = (size_t)gw * 64 + F.lane; i < (size_t)M * PLE / 8; i += (size_t)NGW * 64) {
            const f32x4 a = *(const GAS f32x4*)(p_in + i * 8), b = *(const GAS f32x4*)(p_in + i * 8 + 4);
            *(GAS v4u*)(PB + i * 8) = pg8::pack8(a, b);
        }
        if (BOTH(0)) GRID_BAR();
    }

    if (IN(1)) {
        { pg8::Gemm g{H1, WIN, D}; pg8::StaticOrder S; S.init(M, NPROJ_A, F.G, (int)blockIdx.x);
          pg8::EpiProj E{UB, QB, KB, GPB, GAB};
          pg8::gemm_phase<pg8::EpiProj, pg8::StaticOrder, true>(F.lds, g, S, E); }
        { pg8::Gemm g{WIN + (size_t)NPROJ_A * D, H1, D}; pg8::StaticOrder S; S.init(512, M, F.G, (int)blockIdx.x);
          pg8::EpiPlain E{VT, M};
          pg8::gemm_phase<pg8::EpiPlain, pg8::StaticOrder, true>(F.lds, g, S, E); }
        if (BOTH(1)) GRID_BAR();
    }

    if (IN(2)) {
        for (int T = gw; T < NB * NH * (SEQ / 32); T += NGW) {
            const int qb = T & 127, h = (T >> 7) & 7, b = T >> 10;
            attn_task(QB, KB, VT, YATT, b, h, qb, F.lane);
        }
        for (int tok = gw; tok < M; tok += NGW) pool_row(UB, POOL, tok, F.lane);
        if (BOTH(2)) GRID_BAR();
    }

    if (IN(3)) {
        pg8::Gemm g{POOL, WEFF, PW}; pg8::StaticOrder S; S.init(M, D, F.G, (int)blockIdx.x);
        pg8::EpiGate<false> E{MRG, GPB};
        pg8::gemm_phase<pg8::EpiGate<false>, pg8::StaticOrder, true>(F.lds, g, S, E);
        if (BOTH(3)) GRID_BAR();
    }
    if (IN(4)) {
        pg8::Gemm g{YATT, WAU, AW}; pg8::StaticOrder S; S.init(M, D, F.G, (int)blockIdx.x);
        pg8::EpiGate<true> E{MRG, GAB};
        pg8::gemm_phase<pg8::EpiGate<true>, pg8::StaticOrder, true>(F.lds, g, S, E);
        if (BOTH(4)) GRID_BAR();
    }
    if (IN(5)) {
        pg8::Gemm g{MRG, WOUT, D}; pg8::StaticOrder S; S.init(M, D, F.G, (int)blockIdx.x);
        pg8::EpiResid E{X1, x};
        pg8::gemm_phase<pg8::EpiResid, pg8::StaticOrder, true>(F.lds, g, S, E);
        if (BOTH(5)) GRID_BAR();
    }

    if (IN(6)) {
        LAS int* lcnt = ltab;
        LAS int* le = ltab + 128;
        for (int chunk = F.vcu; chunk < M / 256; chunk += F.G) {
            if (F.tid < 128) lcnt[F.tid] = 0;
            router_task(X1, WRF, b_router, chunk * 256 + F.wave * 32, F.lane, R2, TKE, TKW, le + F.wave * 128);
            __syncthreads();
            if (F.tid < 256) {
                const int tok = chunk * 256 + F.tid; v4i rk;
#pragma unroll
                for (int k = 0; k < 4; ++k) rk[k] = __hip_atomic_fetch_add((int*)(lcnt + k * 32 + le[F.tid * 4 + k]), 1, __ATOMIC_RELAXED, __HIP_MEMORY_SCOPE_WORKGROUP);
                *(GAS v4i*)(TKR + (size_t)tok * 4) = rk;
            }
            __syncthreads();
            if (F.tid < 128) CNTWG[chunk * 128 + F.tid] = lcnt[F.tid];
            __syncthreads();
        }
        if (BOTH(6)) GRID_BAR();
    }

    if (IN(7)) {
        LAS int* part = ltab;
        LAS int* tot = ltab + 1024;
        LAS int* below = ltab + 1152;
        LAS int* base = ltab + 1280;
        for (int chunk = F.vcu; chunk < M / 256; chunk += F.G) {
            { const int s = F.tid & 127, q = F.tid >> 7; int st = 0, sb = 0;
              for (int c2 = q * 64; c2 < q * 64 + 64; ++c2) { const int v = CNTWG[c2 * 128 + s]; st += v; sb += (c2 < chunk) ? v : 0; }
              part[(q * 128 + s) * 2] = st; part[(q * 128 + s) * 2 + 1] = sb; }
            __syncthreads();
            if (F.tid < 128) { int st = 0, sb = 0;
#pragma unroll
                for (int q = 0; q < 4; ++q) { st += part[(q * 128 + F.tid) * 2]; sb += part[(q * 128 + F.tid) * 2 + 1]; }
                tot[F.tid] = st; below[F.tid] = sb; }
            __syncthreads();
            if (F.tid < 128) { const int k = F.tid >> 5, e = F.tid & 31; int pre = 0;
                for (int e2 = 0; e2 < e; ++e2) pre += tot[k * 32 + e2];
                base[F.tid] = k * M + pre + below[F.tid];
                if (chunk == 0) SEGTOT[F.tid] = tot[F.tid]; }
            __syncthreads();
            if (F.tid < 256) { const int tok = chunk * 256 + F.tid;
                const v4i te = *(const GAS v4i*)(TKE + (size_t)tok * 4), rk = *(const GAS v4i*)(TKR + (size_t)tok * 4); const f32x4 tw = *(const GAS f32x4*)(TKW + (size_t)tok * 4); const float r = R2[tok];
#pragma unroll
                for (int k = 0; k < 4; ++k) { const int slot = base[k * 32 + te[k]] + rk[k]; ROWT[slot] = tok; ROWW[slot] = tw[k]; ROWR[slot] = r; } }
            __syncthreads();
        }
        if (BOTH(7)) GRID_BAR();
    }

    for (int k = 0; k < 4; ++k) {
        if (IN(8 + 2 * k) || IN(9 + 2 * k)) {
            __syncthreads();
            if (F.tid == 0) { int tb = 0, ss = 0;
                for (int e = 0; e < 32; ++e) { const int cn = SEGTOT[k * 32 + e]; ltab[e] = tb; ltab[33 + e] = ss; ltab[65 + e] = cn; tb += (cn + 255) >> 8; ss += cn; }
                ltab[32] = tb; }
            __syncthreads();
        }
        const int T = __builtin_amdgcn_readfirstlane(ltab[32]);
        if (IN(8 + 2 * k)) {
            pg8::Gemm g{X1, WGU, D};
            pg8::MoeOrder S{ltab, ROWT + (size_t)k * M, WGU, 8, F.G, F.vcu, T * 8, true, (size_t)2048 * 1024};
            pg8::EpiMoe1 E{ACT, ROWR + (size_t)k * M, b_gu};
            pg8::gemm_phase<pg8::EpiMoe1, pg8::MoeOrder, true>(F.lds, g, S, E);
            if (BOTH(8 + 2 * k)) GRID_BAR();
        }
        if (IN(9 + 2 * k)) {
            pg8::Gemm g{ACT, WDN, DE};
            pg8::MoeOrder S{ltab, ROWT + (size_t)k * M, WDN, 4, F.G, F.vcu, T * 4, false, (size_t)1024 * 1024};
            pg8::EpiMoe2 E{X2, k == 0 ? X1 : X2, ROWT + (size_t)k * M, ROWW + (size_t)k * M, b_down};
            pg8::gemm_phase<pg8::EpiMoe2, pg8::MoeOrder, true>(F.lds, g, S, E);
            if (BOTH(9 + 2 * k)) GRID_BAR();
        }
    }

    if (IN(16)) {
        for (int m = gw; m < M; m += NGW) {
            const GAS v4u* xr = (const GAS v4u*)(X2 + (size_t)m * D) + F.lane; float s = 0.f;
#pragma unroll
            for (int j = 0; j < 2; ++j) { const v4u v = xr[64 * j]; const float f[8] = {bflo(v.x), bfhi(v.x), bflo(v.y), bfhi(v.y), bflo(v.z), bfhi(v.z), bflo(v.w), bfhi(v.w)};
#pragma unroll
                for (int q = 0; q < 8; ++q) s += f[q] * f[q]; }
            s = wave_sum(s);
            if (F.lane == 0) R3[m] = 1.0f / sqrtf(s * (1.f / D) + EPS);
        }
        pg8::Gemm g{PB, WPP, PLE}; pg8::StaticOrder S; S.init(M, D, F.G, (int)blockIdx.x);
        pg8::EpiPlain E{PPB, D};
        pg8::gemm_phase<pg8::EpiPlain, pg8::StaticOrder, true>(F.lds, g, S, E);
        if (BOTH(16)) GRID_BAR();
    }
    if (IN(17)) {
        pg8::Gemm g{X2, WPG, D}; pg8::StaticOrder S; S.init(M, D, F.G, (int)blockIdx.x);
        pg8::EpiPle E{X3, X2, PPB, R3};
        pg8::gemm_phase<pg8::EpiPle, pg8::StaticOrder, true>(F.lds, g, S, E);
        if (BOTH(17)) GRID_BAR();
    }
    if (IN(18)) {
        for (int m = gw; m < M; m += NGW) {
            const GAS v4u* xr = (const GAS v4u*)(X3 + (size_t)m * D) + F.lane; float f[2][8]; float s = 0.f;
#pragma unroll
            for (int j = 0; j < 2; ++j) { const v4u v = xr[64 * j]; f[j][0] = bflo(v.x); f[j][1] = bfhi(v.x); f[j][2] = bflo(v.y); f[j][3] = bfhi(v.y); f[j][4] = bflo(v.z); f[j][5] = bfhi(v.z); f[j][6] = bflo(v.w); f[j][7] = bfhi(v.w);
#pragma unroll
                for (int q = 0; q < 8; ++q) s += f[j][q] * f[j][q]; }
            s = wave_sum(s);
            const float r = 1.0f / sqrtf(s * (1.f / D) + EPS);
#pragma unroll
            for (int j = 0; j < 2; ++j) { const int c0 = (64 * j + F.lane) * 8;
                const f32x4 g0 = *(const GAS f32x4*)(g_final + c0), g1 = *(const GAS f32x4*)(g_final + c0 + 4);
                f32x4 o0 = {f[j][0] * r * g0.x, f[j][1] * r * g0.y, f[j][2] * r * g0.z, f[j][3] * r * g0.w}, o1 = {f[j][4] * r * g1.x, f[j][5] * r * g1.y, f[j][6] * r * g1.z, f[j][7] * r * g1.w};
                *(GAS f32x4*)(args.out + (size_t)m * D + c0) = o0; *(GAS f32x4*)(args.out + (size_t)m * D + c0 + 4) = o1; }
        }
    }
#undef IN
#undef BOTH
#undef GRID_BAR
}

extern "C" void kernel_launch(void* const* d_in, const int* in_sizes, int n_in, void* d_out, int out_size, void* d_ws, size_t ws_size, hipStream_t stream) {
    static int grid = 0;
    if (grid == 0) {
        if (n_in != 20 || out_size != M * D || ws_size < WS_END) { fprintf(stderr, "kernel_launch: unexpected shapes (n_in %d, out %d, ws %zu); nothing launched\n", n_in, out_size, ws_size); grid = -1; return; }
        int dev = 0, cus = 0, per_cu = 0;
        if (hipGetDevice(&dev) != hipSuccess || hipDeviceGetAttribute(&cus, hipDeviceAttributeMultiprocessorCount, dev) != hipSuccess) { grid = -1; return; }
        if (hipFuncSetAttribute((const void*)mk_fwd, hipFuncAttributeMaxDynamicSharedMemorySize, LDS_BYTES) != hipSuccess) { fprintf(stderr, "kernel_launch: hipFuncSetAttribute failed\n"); grid = -1; return; }
        if (hipOccupancyMaxActiveBlocksPerMultiprocessor(&per_cu, (const void*)mk_fwd, NWAVES * 64, LDS_BYTES) != hipSuccess || per_cu < 1)
            fprintf(stderr, "kernel_launch: note: occupancy query reports %d workgroups per CU\n", per_cu);
        (void)hipGetLastError();
        grid = cus;
    }
    if (grid < 0) return;
    if (hipMemsetAsync((char*)d_ws + WS_CTL, 0, CTL_ZERO_BYTES, stream) != hipSuccess) return;
    Args a{};
    for (int i = 0; i < 20; ++i) a.in[i] = (const float*)d_in[i];
    a.out = (float*)d_out; a.ws = (unsigned char*)d_ws;
#if MK_SPLIT
    for (int ph = 0; ph < NPH; ++ph) { a.ph_lo = ph; a.ph_hi = ph + 1; hipLaunchKernelGGL(mk_fwd, dim3(grid), dim3(NWAVES * 64), LDS_BYTES, stream, a); }
#else
    a.ph_lo = 0; a.ph_hi = NPH; hipLaunchKernelGGL(mk_fwd, dim3(grid), dim3(NWAVES * 64), LDS_BYTES, stream, a);
#endif
}
```

```cpp
#include <hip/hip_runtime.h>
#include <cstdio>
#include <cstdint>

#ifndef MK_SPLIT
#define MK_SPLIT 0
#endif

#ifndef MOE_ALIGN
#define MOE_ALIGN true
#endif
#ifndef REP_MASK
#define REP_MASK 0u
#endif
#define REPS(k) ((((REP_MASK) >> (k)) & 1u) ? 2 : 1)

#define GAS __attribute__((address_space(1)))
#define LAS __attribute__((address_space(3)))
typedef unsigned short bf16;
typedef unsigned v4u __attribute__((ext_vector_type(4)));
typedef unsigned v2u __attribute__((ext_vector_type(2)));
typedef int v4i __attribute__((ext_vector_type(4)));
typedef float f32x2 __attribute__((ext_vector_type(2)));
typedef float f32x4 __attribute__((ext_vector_type(4)));
typedef float f32x16 __attribute__((ext_vector_type(16)));
typedef short bf16x8 __attribute__((ext_vector_type(8)));
typedef __bf16 bf16x2_t __attribute__((ext_vector_type(2)));
typedef GAS unsigned gu32;

constexpr int NB = 16, SEQ = 4096, M = NB * SEQ, D = 1024, NH = 8, HD = 64, PW = 512, AW = 512, NE = 32, TOPK = 4, DE = 1024, PLE = 256;
constexpr int NPROJ_A = 3584;
constexpr float EPS = 1e-6f;
constexpr float LOG2E = 1.4426950408889634f;
constexpr float QSCALE = 0.125f * LOG2E;
constexpr float WSCALE = 64.0f, WSCALE_INV = 1.0f / 64.0f;
constexpr float ATT_THR = 152.0f;
constexpr int NWAVES = 8;
constexpr int NPH = 19;

constexpr size_t MiB = 1u << 20;
constexpr size_t WS_CTL = 0, CTL_ZERO_BYTES = 1 * MiB;
constexpr size_t WS_R2 = 1 * MiB;
constexpr size_t WS_R3 = WS_R2 + 256 * 1024;
constexpr size_t WS_TKE = 2 * MiB;
constexpr size_t WS_TKW = 3 * MiB;
constexpr size_t WS_TKR = 4 * MiB;
constexpr size_t WS_ROWT = 5 * MiB;
constexpr size_t WS_ROWW = 7 * MiB;
constexpr size_t WS_ROWR = 9 * MiB;
constexpr size_t WS_CNTWG = 11 * MiB;
constexpr size_t WS_SEGTOT = WS_CNTWG + 256 * 1024;
constexpr size_t WS_WRF = 12 * MiB;
constexpr size_t WS_WIN = 16 * MiB;
constexpr size_t WS_WEFF = 24 * MiB;
constexpr size_t WS_WAU = 25 * MiB;
constexpr size_t WS_WOUT = 26 * MiB;
constexpr size_t WS_WPG = 28 * MiB;
constexpr size_t WS_WPP = 30 * MiB;
constexpr size_t WS_WGU = 32 * MiB;
constexpr size_t WS_WDN = 96 * MiB;
constexpr size_t WS_X1F8 = 128 * MiB;
constexpr size_t WS_A = 224 * MiB;
constexpr size_t WS_B = 352 * MiB;
constexpr size_t WS_C = 480 * MiB;
constexpr size_t WS_E = 608 * MiB;
constexpr size_t WS_PB = 736 * MiB;
constexpr size_t WS_G = 768 * MiB;
constexpr size_t WS_END = 1024 * MiB;
constexpr int CW_BAR = 4096;

constexpr int RING_BYTES = 131072;
constexpr int LDSCTL_OFF = RING_BYTES, MISC_OFF = LDSCTL_OFF + 320;
constexpr int LDS_TAB_OFF = MISC_OFF + 128;
constexpr int LDS_BYTES = 147456;

#define RLX_AGENT __ATOMIC_RELAXED, __HIP_MEMORY_SCOPE_AGENT
#define LDS_WAIT() asm volatile("s_waitcnt lgkmcnt(0)" ::: "memory")
#define VM_WAIT() asm volatile("s_waitcnt vmcnt(0)" ::: "memory")

__device__ __forceinline__ int lane_id_v() { int l; asm volatile("v_mbcnt_lo_u32_b32 %0, -1, 0\n\tv_mbcnt_hi_u32_b32 %0, -1, %0" : "=v"(l)); return l; }
__device__ __forceinline__ unsigned f2bf(float f) { unsigned u = __builtin_bit_cast(unsigned, f); return (u + 0x7fffu + ((u >> 16) & 1u)) >> 16; }
__device__ __forceinline__ unsigned pk2(float lo, float hi) { f32x2 v = {lo, hi}; bf16x2_t b = __builtin_convertvector(v, bf16x2_t); return __builtin_bit_cast(unsigned, b); }
__device__ __forceinline__ unsigned pk4_fp8(float a, float b, float c, float d) { int r = __builtin_amdgcn_cvt_pk_fp8_f32(a, b, 0, false); r = __builtin_amdgcn_cvt_pk_fp8_f32(c, d, r, true); return (unsigned)r; }
__device__ __forceinline__ float bflo(unsigned u) { return __builtin_bit_cast(float, u << 16); }
__device__ __forceinline__ float bfhi(unsigned u) { return __builtin_bit_cast(float, u & 0xffff0000u); }
__device__ __forceinline__ float fast_sigmoid(float v) { return __builtin_amdgcn_rcpf(1.0f + __builtin_amdgcn_exp2f(-LOG2E * v)); }
__device__ __forceinline__ float wave_sum(float v) {
#pragma unroll
    for (int o = 1; o < 64; o <<= 1) v += __shfl_xor(v, o);
    return v;
}

#define XB_TMO      128
#define XB_XCNT(j)  (256  + 64 * (j))
#define XB_XSUB(j)  (1280 + 64 * (j))
#define XB_XGEN(j)  (2304 + 64 * (j))
#define XB_TOP      3328
#define XB_TOPGEN   3392
#define XCD_BAR_WORDS 3456
#define XB_SPIN_CAP (1u << 18)
__device__ __forceinline__ unsigned xb_ld(unsigned* p)              { return __hip_atomic_load(p, __ATOMIC_RELAXED, __HIP_MEMORY_SCOPE_AGENT); }
__device__ __forceinline__ unsigned xb_add(unsigned* p, unsigned v) { return __hip_atomic_fetch_add(p, v, __ATOMIC_RELAXED, __HIP_MEMORY_SCOPE_AGENT); }
__device__ __forceinline__ unsigned xb_xcc_id() { return (unsigned)__builtin_amdgcn_s_getreg((3 << 11) | 20) & 0xFu; }
#define XB_SPIN(cond, bar) do { unsigned _sp = 0; while (cond) { __builtin_amdgcn_s_sleep(1); \
    if ((++_sp & 255u) == 0u) { if (xb_ld(&(bar)[XB_TMO])) break; if (_sp > XB_SPIN_CAP) { atomicAdd(&(bar)[XB_TMO], 1u); break; } } } } while (0)
struct XcdBarrier { unsigned* bar; unsigned x; volatile LAS unsigned* st; };
__device__ __forceinline__ XcdBarrier xcd_barrier_post(unsigned* bar, volatile LAS unsigned* st, int wave) {
    XcdBarrier b; b.bar = bar; b.x = xb_xcc_id(); b.st = st;
    if (wave == 0 && lane_id_v() == 0) (void)xb_add(&bar[XB_XCNT(b.x)], 1u);
    return b;
}
__device__ __forceinline__ void xcd_barrier_complete(unsigned* bar, unsigned x, unsigned& nloc, unsigned& nx) {
    const unsigned G = gridDim.x * gridDim.y * gridDim.z;
    unsigned sum, cnt, mine, sp = 0u;
    for (;;) {
        sum = 0u; cnt = 0u; mine = 0u;
#pragma unroll
        for (unsigned j = 0; j < 16; ++j) { const unsigned c = xb_ld(&bar[XB_XCNT(j)]); sum += c; cnt += (c > 0u) ? 1u : 0u; mine = (j == x) ? c : mine; }
        if (sum == G) break;
        __builtin_amdgcn_s_sleep(1);
        if ((++sp & 255u) == 0u) { if (xb_ld(&bar[XB_TMO])) break; if (sp > XB_SPIN_CAP) { atomicAdd(&bar[XB_TMO], 1u); break; } }
    }
    nloc = mine > 0u ? mine : 1u; nx = cnt > 0u ? cnt : 1u;
}
__device__ __forceinline__ void xcd_barrier(const XcdBarrier& b, int wave) {
    asm volatile("s_waitcnt vmcnt(0)" ::: "memory");
    __syncthreads();
    if (wave == 0 && lane_id_v() == 0) {
        unsigned* bar = b.bar;
        __builtin_amdgcn_s_waitcnt(0);
        unsigned nloc = b.st[0], nx = b.st[1];
        if (nloc == 0u) { xcd_barrier_complete(bar, b.x, nloc, nx); b.st[0] = nloc; b.st[1] = nx; }
        const unsigned old = xb_add(&bar[XB_XSUB(b.x)], 1u);
        const unsigned gen = old / nloc;
        if (old + 1u == (gen + 1u) * nloc) {
            __builtin_amdgcn_fence(__ATOMIC_RELEASE, "agent");
            asm volatile("s_waitcnt vmcnt(0)" ::: "memory");
            const unsigned og = xb_add(&bar[XB_TOP], 1u);
            const unsigned tg = og / nx;
            if (og + 1u == (tg + 1u) * nx) xb_add(&bar[XB_TOPGEN], 1u);
            else XB_SPIN(xb_ld(&bar[XB_TOPGEN]) == tg, bar);
            __builtin_amdgcn_fence(__ATOMIC_ACQUIRE, "agent");
            xb_add(&bar[XB_XGEN(b.x)], 1u);
            asm volatile("s_waitcnt vmcnt(0)" ::: "memory");
        } else {
            XB_SPIN(xb_ld(&bar[XB_XGEN(b.x)]) == gen, bar);
            __builtin_amdgcn_fence(__ATOMIC_ACQUIRE, "agent");
            asm volatile("s_waitcnt vmcnt(0)" ::: "memory");
        }
    }
    __syncthreads();
}

namespace pg8 {
constexpr int BM = 256, BK = 64, HALF = 128, HTB = HALF * BK * 2, NXCD = 8, WGM = 8;
__host__ __device__ __forceinline__ int lds_byte(int r, int c) { const int st = (r >> 4) * 2 + (c >> 5), rr = r & 15, cc = c & 31, ob = rr * 64 + cc * 2; return st * 1024 + (ob ^ (((ob >> 9) & 1) << 5)); }
__host__ __device__ __forceinline__ void stage_rc(int b, int& R, int& C) { const int st = b / 1024, sb = b % 1024, swz = sb ^ (((sb >> 9) & 1) << 5); R = (st >> 1) * 16 + swz / 64; C = (st & 1) * 32 + (swz % 64) / 2; }
__host__ __device__ __forceinline__ int perm32(int rho) { const int n = rho >> 4, i = rho & 15; return 8 * (i >> 2) + 4 * n + (i & 3); }

typedef int v8i __attribute__((ext_vector_type(8)));
typedef int v4i_ __attribute__((ext_vector_type(4)));
__device__ __forceinline__ v8i cat8(const bf16x8 a, const bf16x8 b) { const v4i_ x = __builtin_bit_cast(v4i_, a), y = __builtin_bit_cast(v4i_, b); return __builtin_shufflevector(x, y, 0, 1, 2, 3, 4, 5, 6, 7); }
struct Unit { int pm, pn, e, row0, nvalid; };
struct Gemm { const void* A; const void* Bt; int K; };

struct StaticOrder {
    int nM, nN, nwg, G, c;
    __device__ void init(int Mr, int N, int G_, int c_) { nM = Mr / BM; nN = N / BM; nwg = nM * nN; G = G_; c = c_; }
    __device__ __forceinline__ bool next(int i, Unit& u) const {
        const long L = (long)i * G + c; if (L >= nwg) return false;
        int wgid = (int)L; { const int q = nwg / NXCD, r = nwg % NXCD, xcd = wgid % NXCD, off = wgid / NXCD; wgid = (xcd < r ? xcd * (q + 1) : r * (q + 1) + (xcd - r) * q) + off; }
        const int nig = WGM * nN, gid = wgid / nig, fm = gid * WGM, gsz = (nM - fm) < WGM ? (nM - fm) : WGM;
        u.pm = fm + ((wgid % nig) % gsz); u.pn = (wgid % nig) / gsz; u.e = 0; u.row0 = u.pm * BM; u.nvalid = BM; return true;
    }
    __device__ __forceinline__ void a_off(const Unit& u, int tid, int pitchB, unsigned (&va)[2][2]) const {
#pragma unroll
        for (int i = 0; i < 2; ++i) { int R, C; stage_rc(tid * 16 + i * 8192, R, C);
#pragma unroll
            for (int h = 0; h < 2; ++h) va[h][i] = (unsigned)((u.pm * BM + h * HALF + R) * pitchB + C * 2); }
    }
    __device__ __forceinline__ const char* b_ptr(const Unit& u, const Gemm& g, int pitchB) const { return (const char*)g.Bt + (size_t)u.pn * BM * pitchB; }
};

template <class Epi, class Sched, bool ALIGN_EPI, int ES = 2>
__device__ __forceinline__ void gemm_phase(LAS unsigned char* lds, const Gemm g, const Sched& S, const Epi& E, const int wid) {
    const int lane = lane_id_v(), tid = wid * 64 + lane, wr = wid >> 2, wc = wid & 3, fr = lane & 15, fq = lane >> 4;
    const int K = g.K, pitchB = K * ES; int nt = pitchB / 128;
    asm volatile("" : "+s"(nt));
    unsigned voffB[2];
#pragma unroll
    for (int i = 0; i < 2; ++i) { int R, C; stage_rc(tid * 16 + i * 8192, R, C); const int Rb = Epi::PERM ? ((R & ~31) + perm32(R & 31)) : R;
        voffB[i] = (unsigned)(Rb * pitchB + C * 2); }
    const size_t kstep = (size_t)(BK * 2);
    const size_t hstep = (size_t)HALF * pitchB;
    const unsigned ldsw = (unsigned)wid * 1024u;
    const int aoff = lds_byte(wr * 64 + fr, fq * 8), boff = lds_byte(wc * 32 + fr, fq * 8);
#define PG8_SA(b, h) (((b) * 2 + (h)) * HTB)
#define PG8_SB(b, h) ((4 + (b) * 2 + (h)) * HTB)
#define PG8_STAGE(bufoff, gbase, voff) do { _Pragma("unroll") for (int _i = 0; _i < 2; ++_i) \
        __builtin_amdgcn_global_load_lds((const unsigned*)((const char*)(gbase) + (voff)[_i]), (LAS unsigned*)(lds + (bufoff) + ldsw + _i * 8192), 16, 0, 0); } while (0)
#define PG8_LDA(dst, b, h) do { _Pragma("unroll") for (int m = 0; m < 4; ++m) _Pragma("unroll") for (int k = 0; k < 2; ++k) dst[m][k] = *(const LAS bf16x8*)(lds + PG8_SA(b, h) + aoff + m * 2048 + k * 1024); } while (0)
#define PG8_LDB(dst, b, h) do { _Pragma("unroll") for (int n = 0; n < 2; ++n) _Pragma("unroll") for (int k = 0; k < 2; ++k) dst[n][k] = *(const LAS bf16x8*)(lds + PG8_SB(b, h) + boff + n * 2048 + k * 1024); } while (0)
#define PG8_MMA(ai, bj, At, Bt) do { __builtin_amdgcn_s_setprio(1); _Pragma("unroll") for (int m = 0; m < 4; ++m) _Pragma("unroll") for (int n = 0; n < 2; ++n) { \
        if constexpr (ES == 2) { _Pragma("unroll") for (int k = 0; k < 2; ++k) acc[ai][bj][m][n] = __builtin_amdgcn_mfma_f32_16x16x32_bf16(Bt[n][k], At[m][k], acc[ai][bj][m][n], 0, 0, 0); } \
        else { const v8i a8_ = cat8(Bt[n][0], Bt[n][1]), b8_ = cat8(At[m][0], At[m][1]); \
               if (m == 0 && n == 0) asm volatile("s_nop 1\n\tv_mfma_f32_16x16x128_f8f6f4 %0, %1, %2, %0" : "+v"(acc[ai][bj][m][n]) : "v"(a8_), "v"(b8_)); \
               else asm volatile("v_mfma_f32_16x16x128_f8f6f4 %0, %1, %2, %0" : "+v"(acc[ai][bj][m][n]) : "v"(a8_), "v"(b8_)); } } \
        __builtin_amdgcn_s_setprio(0); } while (0)
#define PG8_WAIT_V(n) asm volatile("s_waitcnt vmcnt(" #n ")" ::: "memory")
#define PG8_WAIT_L(n) asm volatile("s_waitcnt lgkmcnt(" #n ")" ::: "memory")
#define PG8_BAR __builtin_amdgcn_s_barrier()
#define PG8_SCHED __builtin_amdgcn_sched_barrier(0)
    Unit cur, nxt; int ui = 0;
    if (!S.next(0, cur)) return;
    f32x4 acc[2][2][4][2];
#pragma unroll
    for (int a = 0; a < 2; ++a)
#pragma unroll
        for (int b = 0; b < 2; ++b)
#pragma unroll
            for (int m = 0; m < 4; ++m)
#pragma unroll
                for (int n = 0; n < 2; ++n) acc[a][b][m][n] = (f32x4){0.f, 0.f, 0.f, 0.f};
    bf16x8 At[4][2], B0[2][2], B1[2][2];
    unsigned cva[2][2], nva[2][2];
    S.a_off(cur, tid, pitchB, cva);
    const char* const Ab = (const char*)g.A;
    const char* cB = S.b_ptr(cur, g, pitchB);
    PG8_STAGE(PG8_SB(0, 0), cB, voffB); PG8_STAGE(PG8_SB(0, 1), cB + hstep, voffB); PG8_STAGE(PG8_SA(0, 0), Ab, cva[0]); PG8_STAGE(PG8_SA(0, 1), Ab, cva[1]);
    if (wr == 1) PG8_BAR;
    PG8_WAIT_V(2); PG8_BAR;
    PG8_STAGE(PG8_SB(1, 0), cB + kstep, voffB); PG8_STAGE(PG8_SA(1, 0), Ab + kstep, cva[0]); PG8_STAGE(PG8_SB(1, 1), cB + hstep + kstep, voffB);
    PG8_WAIT_V(6); PG8_BAR;
    for (;;) {
        const bool has_next = S.next(ui + 1, nxt);
        const char* nB = cB;
        if (has_next) { S.a_off(nxt, tid, pitchB, nva); nB = S.b_ptr(nxt, g, pitchB); }
        else {
#pragma unroll
            for (int h = 0; h < 2; ++h)
#pragma unroll
                for (int i = 0; i < 2; ++i) nva[h][i] = cva[h][i];
        }
#pragma nounroll
        for (int t = 0; t < nt; t += 2) {
            const bool last = (t == nt - 2);
            const char* Abt = Ab; asm volatile("" : "+s"(Abt));
            const char* a1 = Abt + (size_t)(t + 1) * kstep;
            const char* a2 = last ? Abt : Abt + (size_t)(t + 2) * kstep; const char* b2 = last ? nB : cB + (size_t)(t + 2) * kstep;
            const char* a3 = a2 + kstep; const char* b3 = b2 + kstep;
            unsigned va2[2][2];
#pragma unroll
            for (int h = 0; h < 2; ++h)
#pragma unroll
                for (int i = 0; i < 2; ++i) va2[h][i] = last ? nva[h][i] : cva[h][i];
            PG8_LDB(B0, 0, 0); PG8_LDB(B1, 0, 1); PG8_SCHED; PG8_LDA(At, 0, 0); PG8_STAGE(PG8_SA(1, 1), a1, cva[1]);
            PG8_WAIT_V(8); PG8_WAIT_L(0); PG8_BAR; PG8_MMA(0, 0, At, B0); PG8_MMA(0, 1, At, B1); PG8_BAR; PG8_SCHED;
            PG8_LDA(At, 0, 1); PG8_STAGE(PG8_SB(0, 0), b2, voffB); PG8_STAGE(PG8_SB(0, 1), b2 + hstep, voffB); PG8_STAGE(PG8_SA(0, 0), a2, va2[0]);
            PG8_WAIT_V(8); PG8_WAIT_L(0); PG8_BAR; PG8_MMA(1, 0, At, B0); PG8_MMA(1, 1, At, B1); PG8_BAR; PG8_SCHED;
            PG8_LDB(B0, 1, 0); PG8_LDB(B1, 1, 1); PG8_SCHED; PG8_LDA(At, 1, 0); PG8_STAGE(PG8_SA(0, 1), a2, va2[1]);
            PG8_WAIT_V(8); PG8_WAIT_L(0); PG8_BAR; PG8_MMA(0, 0, At, B0); PG8_MMA(0, 1, At, B1); PG8_BAR; PG8_SCHED;
            PG8_LDA(At, 1, 1); PG8_STAGE(PG8_SB(1, 0), b3, voffB); PG8_STAGE(PG8_SB(1, 1), b3 + hstep, voffB); PG8_STAGE(PG8_SA(1, 0), a3, va2[0]);
            PG8_WAIT_V(8); PG8_WAIT_L(0); PG8_BAR; PG8_MMA(1, 0, At, B0); PG8_MMA(1, 1, At, B1); PG8_BAR; PG8_SCHED;
        }
        if constexpr (ALIGN_EPI) { if (wr == 0) PG8_BAR; }
        if constexpr (ES == 1) asm volatile("s_nop 11");
        E(acc, cur, wr, wc, fr, fq);
        if (!has_next) break;
#pragma unroll
        for (int a = 0; a < 2; ++a)
#pragma unroll
            for (int b = 0; b < 2; ++b)
#pragma unroll
                for (int m = 0; m < 4; ++m)
#pragma unroll
                    for (int n = 0; n < 2; ++n) acc[a][b][m][n] = (f32x4){0.f, 0.f, 0.f, 0.f};
        cur = nxt; cB = nB; ++ui;
#pragma unroll
        for (int h = 0; h < 2; ++h)
#pragma unroll
            for (int i = 0; i < 2; ++i) cva[h][i] = nva[h][i];
        if constexpr (ALIGN_EPI) { if (wr == 1) PG8_BAR; }
    }
    PG8_WAIT_V(0);
    if constexpr (!ALIGN_EPI) { if (wr == 0) PG8_BAR; }
    PG8_BAR;
#undef PG8_SA
#undef PG8_SB
#undef PG8_STAGE
#undef PG8_LDA
#undef PG8_LDB
#undef PG8_MMA
#undef PG8_WAIT_V
#undef PG8_WAIT_L
#undef PG8_BAR
#undef PG8_SCHED
}

__device__ __forceinline__ v4u pack8(const f32x4 a, const f32x4 b) { v4u w; w.x = pk2(a[0], a[1]); w.y = pk2(a[2], a[3]); w.z = pk2(b[0], b[1]); w.w = pk2(b[2], b[3]); return w; }
__device__ __forceinline__ void unpack8(const v4u w, f32x4& a, f32x4& b) { a = (f32x4){bflo(w.x), bfhi(w.x), bflo(w.y), bfhi(w.y)}; b = (f32x4){bflo(w.z), bfhi(w.z), bflo(w.w), bfhi(w.w)}; }

struct EpiPlain {
    static constexpr bool PERM = true;
    bf16* O; int ldc;
    __device__ __forceinline__ void operator()(const f32x4 (&acc)[2][2][4][2], const Unit& u, int wr, int wc, int fr, int fq) const {
        const int row0 = u.pm * BM + wr * 64 + fr, col0 = u.pn * BM + wc * 32 + 8 * fq;
#pragma unroll
        for (int ai = 0; ai < 2; ++ai)
#pragma unroll
            for (int m = 0; m < 4; ++m) { bf16* rowp = O + (size_t)(row0 + ai * HALF + m * 16) * ldc + col0;
#pragma unroll
                for (int bj = 0; bj < 2; ++bj) *(GAS v4u*)(rowp + bj * HALF) = pack8(acc[ai][bj][m][0], acc[ai][bj][m][1]); }
    }
};
struct EpiProj {
    static constexpr bool PERM = true;
    bf16 *U, *Q, *Kb, *GP, *GA;
    __device__ __forceinline__ void operator()(const f32x4 (&acc)[2][2][4][2], const Unit& u, int wr, int wc, int fr, int fq) const {
        const int pn = u.pn; bf16* base; int ldc, colt; float sc = 1.f; bool sig = false;
        if (pn < 2) { base = U; ldc = 512; colt = pn * 256; }
        else if (pn < 4) { base = Q; ldc = 512; colt = (pn - 2) * 256; sc = QSCALE; }
        else if (pn < 6) { base = Kb; ldc = 512; colt = (pn - 4) * 256; }
        else if (pn < 10) { base = GP; ldc = 1024; colt = (pn - 6) * 256; sig = true; }
        else { base = GA; ldc = 1024; colt = (pn - 10) * 256; sig = true; }
        const int row0 = u.pm * BM + wr * 64 + fr, col0 = colt + wc * 32 + 8 * fq;
#pragma unroll
        for (int ai = 0; ai < 2; ++ai)
#pragma unroll
            for (int m = 0; m < 4; ++m) { bf16* rowp = base + (size_t)(row0 + ai * HALF + m * 16) * ldc + col0;
#pragma unroll
                for (int bj = 0; bj < 2; ++bj) { f32x4 v0 = acc[ai][bj][m][0], v1 = acc[ai][bj][m][1];
                    if (sig) {
#pragma unroll
                        for (int j = 0; j < 4; ++j) { v0[j] = fast_sigmoid(v0[j]); v1[j] = fast_sigmoid(v1[j]); }
                    } else { v0 = v0 * sc; v1 = v1 * sc; }
                    *(GAS v4u*)(rowp + bj * HALF) = pack8(v0, v1); } }
    }
};
template <bool ADD> struct EpiGate {
    static constexpr bool PERM = true;
    bf16* O; const bf16* G;
    __device__ __forceinline__ void operator()(const f32x4 (&acc)[2][2][4][2], const Unit& u, int wr, int wc, int fr, int fq) const {
        const int row0 = u.pm * BM + wr * 64 + fr, col0 = u.pn * BM + wc * 32 + 8 * fq;
#pragma unroll
        for (int ai = 0; ai < 2; ++ai)
#pragma unroll
            for (int m = 0; m < 4; ++m) { const size_t ro = (size_t)(row0 + ai * HALF + m * 16) * 1024 + col0;
#pragma unroll
                for (int bj = 0; bj < 2; ++bj) { f32x4 g0, g1; unpack8(*(const GAS v4u*)(G + ro + bj * HALF), g0, g1);
                    f32x4 v0 = acc[ai][bj][m][0] * g0, v1 = acc[ai][bj][m][1] * g1;
                    if (ADD) { f32x4 o0, o1; unpack8(*(const GAS v4u*)(O + ro + bj * HALF), o0, o1); v0 = v0 + o0; v1 = v1 + o1; }
                    *(GAS v4u*)(O + ro + bj * HALF) = pack8(v0, v1); } }
    }
};
struct EpiResid {
    static constexpr bool PERM = true;
    bf16* O; unsigned char* O8; const float* X;
    __device__ __forceinline__ void operator()(const f32x4 (&acc)[2][2][4][2], const Unit& u, int wr, int wc, int fr, int fq) const {
        const int row0 = u.pm * BM + wr * 64 + fr, col0 = u.pn * BM + wc * 32 + 8 * fq;
#pragma unroll
        for (int ai = 0; ai < 2; ++ai)
#pragma unroll
            for (int m = 0; m < 4; ++m) { const size_t ro = (size_t)(row0 + ai * HALF + m * 16) * 1024 + col0;
#pragma unroll
                for (int bj = 0; bj < 2; ++bj) { const f32x4 x0 = *(const GAS f32x4*)(X + ro + bj * HALF), x1 = *(const GAS f32x4*)(X + ro + bj * HALF + 4);
                    const f32x4 y0 = acc[ai][bj][m][0] + x0, y1 = acc[ai][bj][m][1] + x1;
                    *(GAS v4u*)(O + ro + bj * HALF) = pack8(y0, y1);
                    v2u o8; o8.x = pk4_fp8(y0[0], y0[1], y0[2], y0[3]); o8.y = pk4_fp8(y1[0], y1[1], y1[2], y1[3]); *(GAS v2u*)(O8 + ro + bj * HALF) = o8; } }
    }
};
struct EpiPle {
    static constexpr bool PERM = true;
    bf16* O; const bf16* X2; const bf16* PP; const float* R3;
    __device__ __forceinline__ void operator()(const f32x4 (&acc)[2][2][4][2], const Unit& u, int wr, int wc, int fr, int fq) const {
        const int row0 = u.pm * BM + wr * 64 + fr, col0 = u.pn * BM + wc * 32 + 8 * fq;
#pragma unroll
        for (int ai = 0; ai < 2; ++ai)
#pragma unroll
            for (int m = 0; m < 4; ++m) { const int row = row0 + ai * HALF + m * 16; const size_t ro = (size_t)row * 1024 + col0; const float r = R3[row];
#pragma unroll
                for (int bj = 0; bj < 2; ++bj) { f32x4 x0, x1, p0, p1; unpack8(*(const GAS v4u*)(X2 + ro + bj * HALF), x0, x1); unpack8(*(const GAS v4u*)(PP + ro + bj * HALF), p0, p1);
                    f32x4 v0, v1;
#pragma unroll
                    for (int j = 0; j < 4; ++j) { v0[j] = x0[j] + fast_sigmoid(r * acc[ai][bj][m][0][j]) * p0[j]; v1[j] = x1[j] + fast_sigmoid(r * acc[ai][bj][m][1][j]) * p1[j]; }
                    *(GAS v4u*)(O + ro + bj * HALF) = pack8(v0, v1); } }
    }
};

template <bool GATHER> struct MoeOrder {
    const LAS int* tab; const int* row_token; const unsigned char* W; int NT, G, c, total; size_t wstride;
    __device__ __forceinline__ bool next(int i, Unit& u) const {
        const long L = (long)i * G + c; if (L >= total) return false;
        const int rt = (int)(L / NT); u.pn = (int)(L % NT);
        int e = 0;
#pragma unroll
        for (int j = 1; j < 32; ++j) e += (tab[j] <= rt) ? 1 : 0;
        e = __builtin_amdgcn_readfirstlane(e);
        const int lt = rt - __builtin_amdgcn_readfirstlane(tab[e]), cn = __builtin_amdgcn_readfirstlane(tab[65 + e]);
        u.e = e; u.pm = rt; u.row0 = __builtin_amdgcn_readfirstlane(tab[33 + e]) + lt * 256; u.nvalid = (cn - lt * 256) < 256 ? (cn - lt * 256) : 256; return true;
    }
    __device__ __forceinline__ void a_off(const Unit& u, int tid, int pitchB, unsigned (&va)[2][2]) const {
        int R[2], C[2];
#pragma unroll
        for (int i = 0; i < 2; ++i) stage_rc(tid * 16 + i * 8192, R[i], C[i]);
        if constexpr (GATHER) {
            int tok[2][2];
#pragma unroll
            for (int i = 0; i < 2; ++i)
#pragma unroll
                for (int h = 0; h < 2; ++h) { const int rl = h * HALF + R[i]; tok[h][i] = row_token[u.row0 + (rl < u.nvalid ? rl : 0)]; }
#pragma unroll
            for (int i = 0; i < 2; ++i)
#pragma unroll
                for (int h = 0; h < 2; ++h) va[h][i] = (unsigned)(tok[h][i] * pitchB + C[i] * 2);
        } else {
#pragma unroll
            for (int i = 0; i < 2; ++i)
#pragma unroll
                for (int h = 0; h < 2; ++h) va[h][i] = (unsigned)((u.row0 + h * HALF + R[i]) * pitchB + C[i] * 2);
        }
    }
    __device__ __forceinline__ const char* b_ptr(const Unit& u, const Gemm& g, int pitchB) const { return (const char*)(W + (size_t)u.e * wstride + (size_t)u.pn * 256 * pitchB); }
};
struct EpiMoe1 {
    static constexpr bool PERM = true;
    unsigned char* act; const float* row_r; const float* bgu;
    __device__ __forceinline__ void operator()(const f32x4 (&acc)[2][2][4][2], const Unit& u, int wr, int wc, int fr, int fq) const {
        const int cl = u.pn * 128 + wc * 32 + 8 * fq;
        const float* bg = bgu + (size_t)u.e * 2048 + cl;
        const f32x4 g0b = *(const GAS f32x4*)(bg), g1b = *(const GAS f32x4*)(bg + 4), u0b = *(const GAS f32x4*)(bg + 1024), u1b = *(const GAS f32x4*)(bg + 1028);
        float rr[2][4];
#pragma unroll
        for (int ai = 0; ai < 2; ++ai)
#pragma unroll
            for (int m = 0; m < 4; ++m) { const int rl = ai * HALF + wr * 64 + m * 16 + fr; rr[ai][m] = row_r[u.row0 + (rl < u.nvalid ? rl : u.nvalid - 1)] * WSCALE_INV; }
#pragma unroll
        for (int ai = 0; ai < 2; ++ai)
#pragma unroll
            for (int m = 0; m < 4; ++m) { const int rl = ai * HALF + wr * 64 + m * 16 + fr; const float r = rr[ai][m];
                const f32x4 ga = acc[ai][0][m][0] * r + g0b, gb = acc[ai][0][m][1] * r + g1b, ua = acc[ai][1][m][0] * r + u0b, ub = acc[ai][1][m][1] * r + u1b;
                f32x4 o0, o1;
#pragma unroll
                for (int j = 0; j < 4; ++j) {
                    { const float gt = fminf(ga[j], 7.0f), up = fminf(fmaxf(ua[j], -7.0f), 7.0f); o0[j] = (up + 1.0f) * gt * fast_sigmoid(1.702f * gt); }
                    { const float gt = fminf(gb[j], 7.0f), up = fminf(fmaxf(ub[j], -7.0f), 7.0f); o1[j] = (up + 1.0f) * gt * fast_sigmoid(1.702f * gt); }
                }
                const int orow = rl < u.nvalid ? u.row0 + rl : M + rl;
                v2u o8; o8.x = pk4_fp8(o0[0], o0[1], o0[2], o0[3]); o8.y = pk4_fp8(o1[0], o1[1], o1[2], o1[3]);
                *(GAS v2u*)(act + (size_t)orow * 1024 + cl) = o8; }
    }
};
struct EpiMoe2 {
    static constexpr bool PERM = true;
    bf16* X2; const bf16* SRC; const int* row_token; const float* row_w; const float* bdn; int dummy;
    __device__ __forceinline__ void operator()(const f32x4 (&acc)[2][2][4][2], const Unit& u, int wr, int wc, int fr, int fq) const {
        const int col0 = u.pn * 256 + wc * 32 + 8 * fq;
        const float* bd = bdn + (size_t)u.e * 1024 + col0;
        f32x4 bv[2][2];
#pragma unroll
        for (int bj = 0; bj < 2; ++bj) { bv[bj][0] = *(const GAS f32x4*)(bd + bj * HALF); bv[bj][1] = *(const GAS f32x4*)(bd + bj * HALF + 4); }
        int tk[2][4]; float ww[2][4];
#pragma unroll
        for (int ai = 0; ai < 2; ++ai)
#pragma unroll
            for (int m = 0; m < 4; ++m) { const int rl = ai * HALF + wr * 64 + m * 16 + fr; const int rc = rl < u.nvalid ? u.row0 + rl : dummy; tk[ai][m] = row_token[rc]; ww[ai][m] = row_w[rc]; }
#pragma unroll
        for (int ai = 0; ai < 2; ++ai) {
            asm volatile("" ::: "memory");
            v4u sv[4][2];
#pragma unroll
            for (int m = 0; m < 4; ++m)
#pragma unroll
                for (int bj = 0; bj < 2; ++bj) sv[m][bj] = *(const GAS v4u*)(SRC + (size_t)tk[ai][m] * 1024 + col0 + bj * HALF);
#pragma unroll
            for (int m = 0; m < 4; ++m) { const float w = ww[ai][m];
#pragma unroll
                for (int bj = 0; bj < 2; ++bj) { f32x4 s0, s1; unpack8(sv[m][bj], s0, s1);
                    *(GAS v4u*)(X2 + (size_t)tk[ai][m] * 1024 + col0 + bj * HALF) = pack8(s0 + (acc[ai][bj][m][0] * WSCALE_INV + bv[bj][0]) * w, s1 + (acc[ai][bj][m][1] * WSCALE_INV + bv[bj][1]) * w); } }
        }
    }
};
}

struct Frame {
    LAS unsigned char* lds; volatile LAS unsigned* MISC; gu32* ctl;
    int wave, vcu, G;
};
struct Args { const float* in[20]; float* out; unsigned char* ws; int ph_lo, ph_hi; };

template <bool F8>
__device__ __forceinline__ void p0_transpose_item(const float* W, int N, int k0, int n0, void* WT, int Kp, int dst_row0, const float* gain, float scale, LAS float* scr, int lane) {
    f32x4 v[8]; float gs[8];
    const int kq = lane >> 3, n4 = 4 * (lane & 7);
#pragma unroll
    for (int i = 0; i < 8; ++i) v[i] = *(const GAS f32x4*)(W + (size_t)(k0 + kq + 8 * i) * N + n0 + n4);
#pragma unroll
    for (int i = 0; i < 8; ++i) gs[i] = gain ? gain[k0 + kq + 8 * i] * scale : scale;
#pragma unroll
    for (int i = 0; i < 8; ++i) { LAS float* s = scr + (kq + 8 * i) * 33 + n4; s[0] = v[i].x * gs[i]; s[1] = v[i].y * gs[i]; s[2] = v[i].z * gs[i]; s[3] = v[i].w * gs[i]; }
    LDS_WAIT(); asm volatile("" ::: "memory");
    if constexpr (!F8) {
        const int c = lane & 7;
#pragma unroll
        for (int j = 0; j < 4; ++j) { const int n = (lane >> 3) + 8 * j; const LAS float* s = scr + (8 * c) * 33 + n;
            v4u o; o.x = pk2(s[0 * 33], s[1 * 33]); o.y = pk2(s[2 * 33], s[3 * 33]); o.z = pk2(s[4 * 33], s[5 * 33]); o.w = pk2(s[6 * 33], s[7 * 33]);
            *(GAS v4u*)((bf16*)WT + (size_t)(dst_row0 + n) * Kp + k0 + 8 * c) = o; }
    } else {
        const int c = lane & 3;
#pragma unroll
        for (int j = 0; j < 2; ++j) { const int n = (lane >> 2) + 16 * j; const LAS float* s = scr + (16 * c) * 33 + n;
            v4u o; o.x = pk4_fp8(s[0 * 33], s[1 * 33], s[2 * 33], s[3 * 33]); o.y = pk4_fp8(s[4 * 33], s[5 * 33], s[6 * 33], s[7 * 33]);
            o.z = pk4_fp8(s[8 * 33], s[9 * 33], s[10 * 33], s[11 * 33]); o.w = pk4_fp8(s[12 * 33], s[13 * 33], s[14 * 33], s[15 * 33]);
            *(GAS v4u*)((unsigned char*)WT + (size_t)(dst_row0 + n) * Kp + k0 + 16 * c) = o; }
    }
    LDS_WAIT(); asm volatile("" ::: "memory");
}
__device__ __forceinline__ void rms_row_f32_to_bf16(const float* xrow, const float* g, bf16* orow, int lane) {
    const GAS f32x4* xr = (const GAS f32x4*)xrow + lane; const GAS f32x4* gr = (const GAS f32x4*)g + lane;
    f32x4 v[4]; float s = 0.f;
#pragma unroll
    for (int j = 0; j < 4; ++j) { v[j] = xr[64 * j]; s += (v[j].x * v[j].x + v[j].y * v[j].y) + (v[j].z * v[j].z + v[j].w * v[j].w); }
    const float r = 1.0f / sqrtf(wave_sum(s) * (1.f / D) + EPS);
    GAS v2u* o8 = (GAS v2u*)orow + lane;
#pragma unroll
    for (int j = 0; j < 4; ++j) { const f32x4 gg = gr[64 * j]; v2u o; o.x = pk2(v[j].x * r * gg.x, v[j].y * r * gg.y); o.y = pk2(v[j].z * r * gg.z, v[j].w * r * gg.w); o8[64 * j] = o; }
}

#define MFMA32(a, b, c) __builtin_amdgcn_mfma_f32_32x32x16_bf16((a), (b), (c), 0, 0, 0)
__device__ __forceinline__ bf16x8 ldg16(const bf16* p) { return *(const GAS bf16x8*)p; }
__device__ __forceinline__ void attn_task(const bf16* __restrict__ Q, const bf16* __restrict__ Kp, const bf16* __restrict__ Vt, bf16* __restrict__ Y, int b, int h, int qb, int lane) {
    const int l31 = lane & 31, hl = lane >> 5;
    const int t0 = qb * 32; const size_t tb = (size_t)b * SEQ;
    bf16x8 qf[4];
    { const bf16* qrow = Q + (tb + t0 + l31) * 512 + h * 64 + 8 * hl;
#pragma unroll
      for (int kk = 0; kk < 4; ++kk) qf[kk] = ldg16(qrow + 16 * kk); }
    const int a_ = l31 >> 3, hh = (l31 >> 2) & 1, c_ = l31 & 3;
    const int pim = 16 * (a_ >> 1) + 8 * hh + 4 * (a_ & 1) + c_;
    const bf16* kbase = Kp + (tb + pim) * 512 + h * 64 + 8 * hl;
    const bf16* vbase = Vt + (size_t)(h * 64 + l31) * M + tb + 8 * hl;
    f32x16 o0, o1;
#pragma unroll
    for (int r = 0; r < 16; ++r) { o0[r] = 0.f; o1[r] = 0.f; }
    float carry = 0.f;
    int key0 = t0;
    bf16x8 kf[4], vf[4];
#pragma unroll
    for (int kk = 0; kk < 4; ++kk) kf[kk] = ldg16(kbase + (size_t)key0 * 512 + 16 * kk);
#pragma unroll
    for (int dj = 0; dj < 4; ++dj) vf[dj] = ldg16(vbase + (size_t)(dj >> 1) * 32 * M + key0 + 16 * (dj & 1));
    for (;;) {
        const int nk = key0 - 32; const bool more = nk >= 0;
        bf16x8 kn[4], vn[4];
        const int lk = more ? nk : key0;
#pragma unroll
        for (int kk = 0; kk < 4; ++kk) kn[kk] = ldg16(kbase + (size_t)lk * 512 + 16 * kk);
#pragma unroll
        for (int dj = 0; dj < 4; ++dj) vn[dj] = ldg16(vbase + (size_t)(dj >> 1) * 32 * M + lk + 16 * (dj & 1));
        f32x16 s;
#pragma unroll
        for (int r = 0; r < 16; ++r) s[r] = 0.f;
#pragma unroll
        for (int kk = 0; kk < 4; ++kk) s = MFMA32(kf[kk], qf[kk], s);
        const bool diag = (key0 == t0);
        float sp[16], ls[16];
        float lo = 0.f, hi = 0.f;
#pragma unroll
        for (int r = 0; r < 16; ++r) {
            const int ko = (r < 8) ? (8 * hl + r) : (16 + 8 * hl + (r - 8));
            const float z = s[r];
            const float e = __builtin_amdgcn_exp2f(-fabsf(z));
            const float lg = __builtin_amdgcn_logf(1.0f + e);
            float spv = fmaxf(z, 0.f) + lg;
            float lsv = fminf(z, 0.f) - lg;
            if (diag && ko >= l31) { spv = 0.f; lsv = -1.0e30f; }
            sp[r] = spv; ls[r] = lsv;
            if (r < 8) lo += spv; else hi += spv;
        }
        const float plo = __shfl_xor(lo, 32), phi = __shfl_xor(hi, 32);
        const float after_lo = (hl == 0) ? (plo + hi + phi) : (hi + phi);
        const float after_hi = (hl == 0) ? phi : 0.f;
        float w[16];
        { float run = carry + after_lo;
#pragma unroll
          for (int r = 7; r >= 0; --r) { w[r] = __builtin_amdgcn_exp2f(ls[r] - run); run += sp[r]; } }
        { float run = carry + after_hi;
#pragma unroll
          for (int r = 15; r >= 8; --r) { w[r] = __builtin_amdgcn_exp2f(ls[r] - run); run += sp[r]; } }
        carry += (lo + hi) + (plo + phi);
        v4u w0, w1;
        w0.x = pk2(w[0], w[1]); w0.y = pk2(w[2], w[3]); w0.z = pk2(w[4], w[5]); w0.w = pk2(w[6], w[7]);
        w1.x = pk2(w[8], w[9]); w1.y = pk2(w[10], w[11]); w1.z = pk2(w[12], w[13]); w1.w = pk2(w[14], w[15]);
        const bf16x8 W0 = __builtin_bit_cast(bf16x8, w0), W1 = __builtin_bit_cast(bf16x8, w1);
        o0 = MFMA32(vf[0], W0, o0); o0 = MFMA32(vf[1], W1, o0);
        o1 = MFMA32(vf[2], W0, o1); o1 = MFMA32(vf[3], W1, o1);
        if (!more) break;
        if (__all(carry >= ATT_THR)) break;
#pragma unroll
        for (int kk = 0; kk < 4; ++kk) { kf[kk] = kn[kk]; vf[kk] = vn[kk]; }
        key0 = nk;
    }
    bf16* yrow = Y + (tb + t0 + l31) * 512 + h * 64 + 4 * hl;
#pragma unroll
    for (int a = 0; a < 4; ++a) {
        v2u p0, p1; p0.x = pk2(o0[4 * a], o0[4 * a + 1]); p0.y = pk2(o0[4 * a + 2], o0[4 * a + 3]); p1.x = pk2(o1[4 * a], o1[4 * a + 1]); p1.y = pk2(o1[4 * a + 2], o1[4 * a + 3]);
        *(GAS v2u*)(yrow + 8 * a) = p0; *(GAS v2u*)(yrow + 32 + 8 * a) = p1;
    }
}

__device__ __forceinline__ void pool_row(const bf16* __restrict__ U, bf16* __restrict__ P, int tok, int lane) {
    const int t = tok & (SEQ - 1); const int w = 2 << (lane >> 4);
    float sum[8], cur[8];
#pragma unroll
    for (int j = 0; j < 8; ++j) { sum[j] = 0.f; cur[j] = 0.f; }
#pragma unroll
    for (int j = 0; j < 16; ++j) {
        if (j < w && j <= t) {
            const v4u v = *(const GAS v4u*)(U + (size_t)(tok - j) * 512 + 8 * lane);
            const float f[8] = {bflo(v.x), bfhi(v.x), bflo(v.y), bfhi(v.y), bflo(v.z), bfhi(v.z), bflo(v.w), bfhi(v.w)};
#pragma unroll
            for (int q = 0; q < 8; ++q) { sum[q] += f[q]; if (j == 0) cur[q] = f[q]; }
        }
    }
    const int cnt = (t + 1) < w ? (t + 1) : w; const float inv = 1.0f / (float)cnt;
    v4u o; o.x = pk2(sum[0] * inv - cur[0], sum[1] * inv - cur[1]); o.y = pk2(sum[2] * inv - cur[2], sum[3] * inv - cur[3]);
    o.z = pk2(sum[4] * inv - cur[4], sum[5] * inv - cur[5]); o.w = pk2(sum[6] * inv - cur[6], sum[7] * inv - cur[7]);
    *(GAS v4u*)(P + (size_t)tok * 512 + 8 * lane) = o;
}

__device__ __forceinline__ void router_task(const bf16* __restrict__ X1, const bf16* __restrict__ WrF, const float* __restrict__ b_router, int T0, int lane,
                                            float* __restrict__ R2, int* __restrict__ TKE, float* __restrict__ TKW, LAS int* lds_e  ) {
    const int l31 = lane & 31, hl = lane >> 5;
    const bf16* xr = X1 + (size_t)(T0 + l31) * 1024 + 8 * hl;
    f32x16 acc;
#pragma unroll
    for (int r = 0; r < 16; ++r) acc[r] = 0.f;
    float ssq = 0.f;
#pragma unroll 4
    for (int kk = 0; kk < 64; ++kk) {
        const v4u xv = *(const GAS v4u*)(xr + 16 * kk);
        const bf16x8 ah = ldg16(WrF + ((size_t)kk * 64 + lane) * 8), al = ldg16(WrF + 32768 + ((size_t)kk * 64 + lane) * 8);
        const float f0 = bflo(xv.x), f1 = bfhi(xv.x), f2 = bflo(xv.y), f3 = bfhi(xv.y), f4 = bflo(xv.z), f5 = bfhi(xv.z), f6 = bflo(xv.w), f7 = bfhi(xv.w);
        ssq += (f0 * f0 + f1 * f1) + (f2 * f2 + f3 * f3) + (f4 * f4 + f5 * f5) + (f6 * f6 + f7 * f7);
        const bf16x8 xb = __builtin_bit_cast(bf16x8, xv);
        acc = MFMA32(ah, xb, acc); acc = MFMA32(al, xb, acc);
    }
    ssq += __shfl_xor(ssq, 32);
    const float r = 1.0f / sqrtf(ssq * (1.f / D) + EPS);
    float v[16];
#pragma unroll
    for (int q = 0; q < 16; ++q) { const int e = 8 * (q >> 2) + 4 * hl + (q & 3); v[q] = acc[q] * r + b_router[e]; }
    float cv[8]; int ce[8];
#pragma unroll
    for (int k = 0; k < 4; ++k) {
        float best = -3.0e38f; int bi = 0;
#pragma unroll
        for (int q = 0; q < 16; ++q) { if (v[q] > best) { best = v[q]; bi = q; } }
        cv[k] = best; ce[k] = 8 * (bi >> 2) + 4 * hl + (bi & 3);
#pragma unroll
        for (int q = 0; q < 16; ++q) { if (q == bi) v[q] = -3.0e38f; }
    }
#pragma unroll
    for (int k = 0; k < 4; ++k) { cv[4 + k] = __shfl_xor(cv[k], 32); ce[4 + k] = __shfl_xor(ce[k], 32); }
    float tv[4]; int te[4];
#pragma unroll
    for (int k = 0; k < 4; ++k) {
        float best = -3.0e38f; int be = 1 << 20; int bi = 0;
#pragma unroll
        for (int q = 0; q < 8; ++q) { if (cv[q] > best || (cv[q] == best && ce[q] < be)) { best = cv[q]; be = ce[q]; bi = q; } }
        tv[k] = best; te[k] = be;
#pragma unroll
        for (int q = 0; q < 8; ++q) { if (q == bi) { cv[q] = -3.0e38f; ce[q] = 1 << 21; } }
    }
    const float p1 = __expf(tv[1] - tv[0]), p2 = __expf(tv[2] - tv[0]), p3 = __expf(tv[3] - tv[0]);
    const float inv = 1.0f / (1.0f + p1 + p2 + p3);
    if (hl == 0) {
        const int tok = T0 + l31;
        R2[tok] = r;
        *(GAS v4i*)(TKE + (size_t)tok * 4) = (v4i){te[0], te[1], te[2], te[3]};
        *(GAS f32x4*)(TKW + (size_t)tok * 4) = (f32x4){inv, p1 * inv, p2 * inv, p3 * inv};
        lds_e[l31 * 4 + 0] = te[0]; lds_e[l31 * 4 + 1] = te[1]; lds_e[l31 * 4 + 2] = te[2]; lds_e[l31 * 4 + 3] = te[3];
    }
}


#define IN_(i) (args.in[i])
#define x_ IN_(0)
#define p_in IN_(1)
#define g_mix IN_(2)
#define w_in IN_(3)
#define w_pool_grp IN_(4)
#define pool_scale IN_(5)
#define w_pool_up IN_(6)
#define w_attn_up IN_(7)
#define w_out IN_(8)
#define g_ffn IN_(9)
#define w_router IN_(10)
#define b_router IN_(11)
#define w_gu IN_(12)
#define b_gu IN_(13)
#define w_down IN_(14)
#define b_down IN_(15)
#define g_ple IN_(16)
#define w_ple_gate IN_(17)
#define w_ple_proj IN_(18)
#define g_final IN_(19)
#define WSP(T, off) ((T*)(args.ws + (off)))
#define R2 WSP(float, WS_R2)
#define R3 WSP(float, WS_R3)
#define TKE WSP(int, WS_TKE)
#define TKW WSP(float, WS_TKW)
#define TKR WSP(int, WS_TKR)
#define ROWT WSP(int, WS_ROWT)
#define ROWW WSP(float, WS_ROWW)
#define ROWR WSP(float, WS_ROWR)
#define CNTWG WSP(int, WS_CNTWG)
#define SEGTOT WSP(int, WS_SEGTOT)
#define WRF WSP(bf16, WS_WRF)
#define WIN WSP(bf16, WS_WIN)
#define WEFF WSP(bf16, WS_WEFF)
#define WAU WSP(bf16, WS_WAU)
#define WOUT WSP(bf16, WS_WOUT)
#define WPG WSP(bf16, WS_WPG)
#define WPP WSP(bf16, WS_WPP)
#define WGU WSP(unsigned char, WS_WGU)
#define WDN WSP(unsigned char, WS_WDN)
#define X1F8 WSP(unsigned char, WS_X1F8)
#define H1 WSP(bf16, WS_A)
#define MRG WSP(bf16, WS_A)
#define PPB WSP(bf16, WS_A)
#define UB WSP(bf16, WS_B)
#define QB WSP(bf16, WS_B + 64 * MiB)
#define X1 WSP(bf16, WS_B)
#define KB WSP(bf16, WS_C)
#define VT WSP(bf16, WS_C + 64 * MiB)
#define X2 WSP(bf16, WS_C)
#define POOL WSP(bf16, WS_E)
#define YATT WSP(bf16, WS_E + 64 * MiB)
#define X3 WSP(bf16, WS_E)
#define PB WSP(bf16, WS_PB)
#define GPB WSP(bf16, WS_G)
#define GAB WSP(bf16, WS_G + 128 * MiB)
#define ACT WSP(unsigned char, WS_G)

__global__ void __launch_bounds__(NWAVES * 64, 2) mk_fwd(Args args) {
    extern __shared__ __attribute__((aligned(16))) unsigned char lds[];
    Frame F;
    F.lds = (LAS unsigned char*)lds;
    F.MISC = (volatile LAS unsigned*)(F.lds + MISC_OFF);
    F.wave = __builtin_amdgcn_readfirstlane((int)threadIdx.x >> 6);
    F.G = gridDim.x; { const int bx = blockIdx.x; F.vcu = (F.G % 8 == 0) ? (bx % 8) * (F.G / 8) + bx / 8 : bx; }
    unsigned char* ws = args.ws;
    F.ctl = (gu32*)(ws + WS_CTL);
    for (int u = (int)threadIdx.x; u < (LDS_BYTES - LDSCTL_OFF) / 4; u += NWAVES * 64) ((LAS unsigned*)(F.lds + LDSCTL_OFF))[u] = 0u;
    __syncthreads();
    const int lo = args.ph_lo, hi = args.ph_hi;
    XcdBarrier bar; bar.bar = (unsigned*)(F.ctl + CW_BAR); bar.x = 0; bar.st = nullptr;
    if (hi - lo > 1) bar = xcd_barrier_post((unsigned*)(F.ctl + CW_BAR), F.MISC + 8, F.wave);
#define IN(k) (lo <= (k) && (k) < hi)
#define BOTH(k) (IN(k) && IN((k) + 1))
#define GRID_BAR() xcd_barrier(bar, F.wave)

    const int gw = F.vcu * NWAVES + F.wave, NGW = F.G * NWAVES;
    LAS int* ltab = (LAS int*)(F.lds + LDS_TAB_OFF);

    if (IN(0)) { for (int rep_ = 0; rep_ < REPS(0); ++rep_) {
        const int lane_ = lane_id_v(), tid_ = F.wave * 64 + lane_;
        LAS float* scr = (LAS float*)(F.lds + F.wave * 16384);
        constexpr int I_IN = 16 * 128, I_AU = 8 * 32, I_OUT = 16 * 32, I_PG = 16 * 32, I_PP = 4 * 32, I_GU = 32 * 16 * 64, I_DN = 32 * 16 * 32;
        constexpr int NITEMS = I_IN + I_AU + I_OUT + I_PG + I_PP + I_GU + I_DN;
        for (int it = gw; it < NITEMS; it += NGW) {
            int r = it;
            if (r < I_IN) { const int kb = r / 128, nb = r % 128, n0 = nb * 32;
                const int blk = n0 / 512; const int dst = (blk < 3) ? n0 : (blk == 3 ? 3584 + (n0 - 1536) : n0 - 512);
                p0_transpose_item<false>(w_in, 4096, kb * 64, n0, WIN, 1024, dst, nullptr, 1.0f, scr, lane_); continue; } r -= I_IN;
            if (r < I_AU) { const int kb = r / 32, nb = r % 32; p0_transpose_item<false>(w_attn_up, 1024, kb * 64, nb * 32, WAU, 512, nb * 32, nullptr, 1.0f, scr, lane_); continue; } r -= I_AU;
            if (r < I_OUT) { const int kb = r / 32, nb = r % 32; p0_transpose_item<false>(w_out, 1024, kb * 64, nb * 32, WOUT, 1024, nb * 32, nullptr, 1.0f, scr, lane_); continue; } r -= I_OUT;
            if (r < I_PG) { const int kb = r / 32, nb = r % 32; p0_transpose_item<false>(w_ple_gate, 1024, kb * 64, nb * 32, WPG, 1024, nb * 32, g_ple, 1.0f, scr, lane_); continue; } r -= I_PG;
            if (r < I_PP) { const int kb = r / 32, nb = r % 32; p0_transpose_item<false>(w_ple_proj, 1024, kb * 64, nb * 32, WPP, 256, nb * 32, nullptr, 1.0f, scr, lane_); continue; } r -= I_PP;
            if (r < I_GU) { const int e = r / 1024, q = r % 1024, kb = q / 64, nb = q % 64, n0 = nb * 32;
                const int j = n0 & 1023; const int dst = 256 * (j / 128) + (j % 128) + (n0 >= 1024 ? 128 : 0);
                p0_transpose_item<true>(w_gu + (size_t)e * 1024 * 2048, 2048, kb * 64, n0, WGU + (size_t)e * 2048 * 1024, 1024, dst, g_ffn, WSCALE, scr, lane_); continue; } r -= I_GU;
            { const int e = r / 512, q = r % 512, kb = q / 32, nb = q % 32;
                p0_transpose_item<true>(w_down + (size_t)e * 1024 * 1024, 1024, kb * 64, nb * 32, WDN + (size_t)e * 1024 * 1024, 1024, nb * 32, nullptr, WSCALE, scr, lane_); }
        }
        for (int it = gw; it < 4 * 16 * 16; it += NGW) {
            const int g = it >> 8, cb = (it >> 4) & 15, db = it & 15; const int d = db * 64 + lane_, c0 = cb * 8;
            float a8[8];
#pragma unroll
            for (int q = 0; q < 8; ++q) a8[q] = 0.f;
            for (int j = 0; j < 128; ++j) { const float wv = w_pool_up[(size_t)(g * 128 + j) * 1024 + d] * pool_scale[g * 128 + j];
#pragma unroll
                for (int q = 0; q < 8; ++q) a8[q] += w_pool_grp[(size_t)(g * 128 + c0 + q) * 128 + j] * wv; }
            v4u o; o.x = pk2(a8[0], a8[1]); o.y = pk2(a8[2], a8[3]); o.z = pk2(a8[4], a8[5]); o.w = pk2(a8[6], a8[7]);
            *(GAS v4u*)(WEFF + (size_t)d * 512 + g * 128 + c0) = o;
        }
        for (int it = gw * 64 + lane_; it < 64 * 64; it += NGW * 64) {
            const int kk = it >> 6, l = it & 63, e = l & 31, k0 = 16 * kk + 8 * (l >> 5);
            unsigned hb[8], lb[8];
#pragma unroll
            for (int i = 0; i < 8; ++i) { const float v = g_ffn[k0 + i] * w_router[(size_t)(k0 + i) * 32 + e]; hb[i] = f2bf(v); lb[i] = f2bf(v - __builtin_bit_cast(float, hb[i] << 16)); }
            v4u oh, ol; oh.x = hb[0] | (hb[1] << 16); oh.y = hb[2] | (hb[3] << 16); oh.z = hb[4] | (hb[5] << 16); oh.w = hb[6] | (hb[7] << 16);
            ol.x = lb[0] | (lb[1] << 16); ol.y = lb[2] | (lb[3] << 16); ol.z = lb[4] | (lb[5] << 16); ol.w = lb[6] | (lb[7] << 16);
            *(GAS v4u*)(WRF + (size_t)it * 8) = oh; *(GAS v4u*)(WRF + 32768 + (size_t)it * 8) = ol;
        }
        for (int m = gw; m < M; m += NGW) rms_row_f32_to_bf16(x_ + (size_t)m * D, g_mix, H1 + (size_t)m * D, lane_);
        for (size_t i = (size_t)gw * 64 + lane_; i < (size_t)M * PLE / 8; i += (size_t)NGW * 64) {
            const f32x4 a = *(const GAS f32x4*)(p_in + i * 8), b = *(const GAS f32x4*)(p_in + i * 8 + 4);
            *(GAS v4u*)(PB + i * 8) = pg8::pack8(a, b);
        }
        if (BOTH(0) || rep_ + 1 < REPS(0)) GRID_BAR();
    } }

    if (IN(1)) { for (int rep_ = 0; rep_ < REPS(1); ++rep_) {
        { pg8::Gemm g{H1, WIN, D}; pg8::StaticOrder S; S.init(M, NPROJ_A, F.G, (int)blockIdx.x);
          pg8::EpiProj E{UB, QB, KB, GPB, GAB};
          pg8::gemm_phase<pg8::EpiProj, pg8::StaticOrder, true>(F.lds, g, S, E, F.wave); }
        { pg8::Gemm g{WIN + (size_t)NPROJ_A * D, H1, D}; pg8::StaticOrder S; S.init(512, M, F.G, (int)blockIdx.x);
          pg8::EpiPlain E{VT, M};
          pg8::gemm_phase<pg8::EpiPlain, pg8::StaticOrder, true>(F.lds, g, S, E, F.wave); }
        if (BOTH(1) || rep_ + 1 < REPS(1)) GRID_BAR();
    } }

    if (IN(2)) { for (int rep_ = 0; rep_ < REPS(2); ++rep_) {
        const int lane_ = lane_id_v(), tid_ = F.wave * 64 + lane_;
        for (int T = gw; T < NB * NH * (SEQ / 32); T += NGW) {
            const int qb = T & 127, h = (T >> 7) & 7, b = T >> 10;
            attn_task(QB, KB, VT, YATT, b, h, qb, lane_);
        }
        for (int tok = gw; tok < M; tok += NGW) pool_row(UB, POOL, tok, lane_);
        if (BOTH(2) || rep_ + 1 < REPS(2)) GRID_BAR();
    } }

    if (IN(3)) { for (int rep_ = 0; rep_ < REPS(3); ++rep_) {
        pg8::Gemm g{POOL, WEFF, PW}; pg8::StaticOrder S; S.init(M, D, F.G, (int)blockIdx.x);
        pg8::EpiGate<false> E{MRG, GPB};
        pg8::gemm_phase<pg8::EpiGate<false>, pg8::StaticOrder, true>(F.lds, g, S, E, F.wave);
        if (BOTH(3) || rep_ + 1 < REPS(3)) GRID_BAR();
    } }
    if (IN(4)) {
        pg8::Gemm g{YATT, WAU, AW}; pg8::StaticOrder S; S.init(M, D, F.G, (int)blockIdx.x);
        pg8::EpiGate<true> E{MRG, GAB};
        pg8::gemm_phase<pg8::EpiGate<true>, pg8::StaticOrder, true>(F.lds, g, S, E, F.wave);
        if (BOTH(4)) GRID_BAR();
    }
    if (IN(5)) { for (int rep_ = 0; rep_ < REPS(5); ++rep_) {
        pg8::Gemm g{MRG, WOUT, D}; pg8::StaticOrder S; S.init(M, D, F.G, (int)blockIdx.x);
        pg8::EpiResid E{X1, X1F8, x_};
        pg8::gemm_phase<pg8::EpiResid, pg8::StaticOrder, true>(F.lds, g, S, E, F.wave);
        if (BOTH(5) || rep_ + 1 < REPS(5)) GRID_BAR();
    } }

    if (IN(6)) { for (int rep_ = 0; rep_ < REPS(6); ++rep_) {
        const int lane_ = lane_id_v(), tid_ = F.wave * 64 + lane_;
        LAS int* lcnt = ltab;
        LAS int* le = ltab + 128;
        for (int chunk = F.vcu; chunk < M / 256; chunk += F.G) {
            if (tid_ < 128) lcnt[tid_] = 0;
            router_task(X1, WRF, b_router, chunk * 256 + F.wave * 32, lane_, R2, TKE, TKW, le + F.wave * 128);
            __syncthreads();
            if (tid_ < 256) {
                const int tok = chunk * 256 + tid_; v4i rk;
#pragma unroll
                for (int k = 0; k < 4; ++k) rk[k] = __hip_atomic_fetch_add((int*)(lcnt + k * 32 + le[tid_ * 4 + k]), 1, __ATOMIC_RELAXED, __HIP_MEMORY_SCOPE_WORKGROUP);
                *(GAS v4i*)(TKR + (size_t)tok * 4) = rk;
            }
            __syncthreads();
            if (tid_ < 128) CNTWG[chunk * 128 + tid_] = lcnt[tid_];
            __syncthreads();
        }
        if (BOTH(6) || rep_ + 1 < REPS(6)) GRID_BAR();
    } }

    if (IN(7)) { for (int rep_ = 0; rep_ < REPS(7); ++rep_) {
        const int lane_ = lane_id_v(), tid_ = F.wave * 64 + lane_;
        LAS int* part = ltab;
        LAS int* tot = ltab + 1024;
        LAS int* below = ltab + 1152;
        LAS int* base = ltab + 1280;
        for (int chunk = F.vcu; chunk < M / 256; chunk += F.G) {
            { const int s = tid_ & 127, q = tid_ >> 7; int st = 0, sb = 0;
              for (int c2 = q * 64; c2 < q * 64 + 64; ++c2) { const int v = CNTWG[c2 * 128 + s]; st += v; sb += (c2 < chunk) ? v : 0; }
              part[(q * 128 + s) * 2] = st; part[(q * 128 + s) * 2 + 1] = sb; }
            __syncthreads();
            if (tid_ < 128) { int st = 0, sb = 0;
#pragma unroll
                for (int q = 0; q < 4; ++q) { st += part[(q * 128 + tid_) * 2]; sb += part[(q * 128 + tid_) * 2 + 1]; }
                tot[tid_] = st; below[tid_] = sb; }
            __syncthreads();
            if (tid_ < 128) { const int k = tid_ >> 5, e = tid_ & 31; int pre = 0;
                for (int e2 = 0; e2 < e; ++e2) pre += tot[k * 32 + e2];
                base[tid_] = k * M + pre + below[tid_];
                if (chunk == 0) { SEGTOT[tid_] = tot[tid_]; if (tid_ == 0) { ROWT[4 * M] = M; ROWW[4 * M] = 0.f; } } }
            __syncthreads();
            if (tid_ < 256) { const int tok = chunk * 256 + tid_;
                const v4i te = *(const GAS v4i*)(TKE + (size_t)tok * 4), rk = *(const GAS v4i*)(TKR + (size_t)tok * 4); const f32x4 tw = *(const GAS f32x4*)(TKW + (size_t)tok * 4); const float r = R2[tok];
#pragma unroll
                for (int k = 0; k < 4; ++k) { const int slot = base[k * 32 + te[k]] + rk[k]; ROWT[slot] = tok; ROWW[slot] = tw[k]; ROWR[slot] = r; } }
            __syncthreads();
        }
        if (BOTH(7) || rep_ + 1 < REPS(7)) GRID_BAR();
    } }

    for (int k = 0; k < 4; ++k) {
        if (IN(8 + 2 * k) || IN(9 + 2 * k)) {
            const int tid_ = F.wave * 64 + lane_id_v();
            __syncthreads();
            if (tid_ < 32) {
                const int cn = SEGTOT[k * 32 + tid_]; int nt_ = (cn + 255) >> 8, pt = nt_, ps = cn;
#pragma unroll
                for (int o = 1; o < 32; o <<= 1) { const int a = __shfl_up(pt, o), b = __shfl_up(ps, o); if (tid_ >= o) { pt += a; ps += b; } }
                ltab[tid_] = pt - nt_; ltab[33 + tid_] = ps - cn; ltab[65 + tid_] = cn; if (tid_ == 31) ltab[32] = pt; }
            __syncthreads();
        }
        const int T = __builtin_amdgcn_readfirstlane(ltab[32]);
        if (IN(8 + 2 * k)) { for (int rep_ = 0; rep_ < REPS(8 + 2 * k); ++rep_) {
            pg8::Gemm g{X1F8, WGU, D};
            pg8::MoeOrder<true> S{ltab, ROWT + (size_t)k * M, WGU, 8, F.G, F.vcu, T * 8, (size_t)2048 * 1024};
            pg8::EpiMoe1 E{ACT, ROWR + (size_t)k * M, b_gu};
            pg8::gemm_phase<pg8::EpiMoe1, pg8::MoeOrder<true>, MOE_ALIGN, 1>(F.lds, g, S, E, F.wave);
            if (BOTH(8 + 2 * k) || rep_ + 1 < REPS(8 + 2 * k)) GRID_BAR();
        } }
        if (IN(9 + 2 * k)) { for (int rep_ = 0; rep_ < REPS(9 + 2 * k); ++rep_) {
            pg8::Gemm g{ACT, WDN, DE};
            pg8::MoeOrder<false> S{ltab, ROWT + (size_t)k * M, WDN, 4, F.G, F.vcu, T * 4, (size_t)1024 * 1024};
            pg8::EpiMoe2 E{X2, k == 0 ? X1 : X2, ROWT + (size_t)k * M, ROWW + (size_t)k * M, b_down, (4 - k) * M};
            pg8::gemm_phase<pg8::EpiMoe2, pg8::MoeOrder<false>, MOE_ALIGN, 1>(F.lds, g, S, E, F.wave);
            if (BOTH(9 + 2 * k) || rep_ + 1 < REPS(9 + 2 * k)) GRID_BAR();
        } }
    }

    if (IN(16)) { for (int rep_ = 0; rep_ < REPS(16); ++rep_) {
        const int lane_ = lane_id_v(), tid_ = F.wave * 64 + lane_;
        for (int m = gw; m < M; m += NGW) {
            const GAS v4u* xr = (const GAS v4u*)(X2 + (size_t)m * D) + lane_; float s = 0.f;
#pragma unroll
            for (int j = 0; j < 2; ++j) { const v4u v = xr[64 * j]; const float f[8] = {bflo(v.x), bfhi(v.x), bflo(v.y), bfhi(v.y), bflo(v.z), bfhi(v.z), bflo(v.w), bfhi(v.w)};
#pragma unroll
                for (int q = 0; q < 8; ++q) s += f[q] * f[q]; }
            s = wave_sum(s);
            if (lane_ == 0) R3[m] = 1.0f / sqrtf(s * (1.f / D) + EPS);
        }
        pg8::Gemm g{PB, WPP, PLE}; pg8::StaticOrder S; S.init(M, D, F.G, (int)blockIdx.x);
        pg8::EpiPlain E{PPB, D};
        pg8::gemm_phase<pg8::EpiPlain, pg8::StaticOrder, true>(F.lds, g, S, E, F.wave);
        if (BOTH(16) || rep_ + 1 < REPS(16)) GRID_BAR();
    } }
    if (IN(17)) { for (int rep_ = 0; rep_ < REPS(17); ++rep_) {
        pg8::Gemm g{X2, WPG, D}; pg8::StaticOrder S; S.init(M, D, F.G, (int)blockIdx.x);
        pg8::EpiPle E{X3, X2, PPB, R3};
        pg8::gemm_phase<pg8::EpiPle, pg8::StaticOrder, true>(F.lds, g, S, E, F.wave);
        if (BOTH(17) || rep_ + 1 < REPS(17)) GRID_BAR();
    } }
    if (IN(18)) { for (int rep_ = 0; rep_ < REPS(18); ++rep_) {
        const int lane_ = lane_id_v(), tid_ = F.wave * 64 + lane_;
        for (int m = gw; m < M; m += NGW) {
            const GAS v4u* xr = (const GAS v4u*)(X3 + (size_t)m * D) + lane_; float f[2][8]; float s = 0.f;
#pragma unroll
            for (int j = 0; j < 2; ++j) { const v4u v = xr[64 * j]; f[j][0] = bflo(v.x); f[j][1] = bfhi(v.x); f[j][2] = bflo(v.y); f[j][3] = bfhi(v.y); f[j][4] = bflo(v.z); f[j][5] = bfhi(v.z); f[j][6] = bflo(v.w); f[j][7] = bfhi(v.w);
#pragma unroll
                for (int q = 0; q < 8; ++q) s += f[j][q] * f[j][q]; }
            s = wave_sum(s);
            const float r = 1.0f / sqrtf(s * (1.f / D) + EPS);
#pragma unroll
            for (int j = 0; j < 2; ++j) { const int c0 = (64 * j + lane_) * 8;
                const f32x4 g0 = *(const GAS f32x4*)(g_final + c0), g1 = *(const GAS f32x4*)(g_final + c0 + 4);
                f32x4 o0 = {f[j][0] * r * g0.x, f[j][1] * r * g0.y, f[j][2] * r * g0.z, f[j][3] * r * g0.w}, o1 = {f[j][4] * r * g1.x, f[j][5] * r * g1.y, f[j][6] * r * g1.z, f[j][7] * r * g1.w};
                *(GAS f32x4*)(args.out + (size_t)m * D + c0) = o0; *(GAS f32x4*)(args.out + (size_t)m * D + c0 + 4) = o1; }
        }
    } }
#undef IN
#undef BOTH
#undef GRID_BAR
}

extern "C" void kernel_launch(void* const* d_in, const int* in_sizes, int n_in, void* d_out, int out_size, void* d_ws, size_t ws_size, hipStream_t stream) {
    static int grid = 0;
    if (grid == 0) {
        if (n_in != 20 || out_size != M * D || ws_size < WS_END) { fprintf(stderr, "kernel_launch: unexpected shapes (n_in %d, out %d, ws %zu); nothing launched\n", n_in, out_size, ws_size); grid = -1; return; }
        int dev = 0, cus = 0, per_cu = 0;
        if (hipGetDevice(&dev) != hipSuccess || hipDeviceGetAttribute(&cus, hipDeviceAttributeMultiprocessorCount, dev) != hipSuccess) { grid = -1; return; }
        if (hipFuncSetAttribute((const void*)mk_fwd, hipFuncAttributeMaxDynamicSharedMemorySize, LDS_BYTES) != hipSuccess) { fprintf(stderr, "kernel_launch: hipFuncSetAttribute failed\n"); grid = -1; return; }
        if (hipOccupancyMaxActiveBlocksPerMultiprocessor(&per_cu, (const void*)mk_fwd, NWAVES * 64, LDS_BYTES) != hipSuccess || per_cu < 1)
            fprintf(stderr, "kernel_launch: note: occupancy query reports %d workgroups per CU\n", per_cu);
        (void)hipGetLastError();
        grid = cus;
    }
    if (grid < 0) return;
    if (hipMemsetAsync((char*)d_ws + WS_CTL, 0, CTL_ZERO_BYTES, stream) != hipSuccess) return;
    Args a{};
    for (int i = 0; i < 20; ++i) a.in[i] = (const float*)d_in[i];
    a.out = (float*)d_out; a.ws = (unsigned char*)d_ws;
#if MK_SPLIT
    for (int ph = 0; ph < NPH; ++ph) { a.ph_lo = ph; a.ph_hi = ph + 1; hipLaunchKernelGGL(mk_fwd, dim3(grid), dim3(NWAVES * 64), LDS_BYTES, stream, a); }
#else
    a.ph_lo = 0; a.ph_hi = NPH; hipLaunchKernelGGL(mk_fwd, dim3(grid), dim3(NWAVES * 64), LDS_BYTES, stream, a);
#endif
}
```

```cpp
#include <hip/hip_runtime.h>
#include <cstdio>
#include <cstdint>

#ifndef MK_SPLIT
#define MK_SPLIT 0
#endif

#ifndef MOE_ALIGN
#define MOE_ALIGN true
#endif
#ifndef REP_MASK
#define REP_MASK 0u
#endif
#define REPS(k) ((((REP_MASK) >> (k)) & 1u) ? 2 : 1)

#define GAS __attribute__((address_space(1)))
#define LAS __attribute__((address_space(3)))
typedef unsigned short bf16;
typedef unsigned v4u __attribute__((ext_vector_type(4)));
typedef unsigned v2u __attribute__((ext_vector_type(2)));
typedef int v4i __attribute__((ext_vector_type(4)));
typedef float f32x2 __attribute__((ext_vector_type(2)));
typedef float f32x4 __attribute__((ext_vector_type(4)));
typedef float f32x16 __attribute__((ext_vector_type(16)));
typedef short bf16x8 __attribute__((ext_vector_type(8)));
typedef __bf16 bf16x2_t __attribute__((ext_vector_type(2)));
typedef GAS unsigned gu32;

constexpr int NB = 16, SEQ = 4096, M = NB * SEQ, D = 1024, NH = 8, HD = 64, PW = 512, AW = 512, NE = 32, TOPK = 4, DE = 1024, PLE = 256;
constexpr int NPROJ_A = 3584;
constexpr float EPS = 1e-6f;
constexpr float LOG2E = 1.4426950408889634f;
constexpr float QSCALE = 0.125f * LOG2E;
constexpr float WSCALE = 64.0f, WSCALE_INV = 1.0f / 64.0f;
constexpr float ATT_THR = 152.0f;
constexpr int NWAVES = 8;
constexpr int NPH = 20;

constexpr size_t MiB = 1u << 20;
constexpr size_t WS_CTL = 0, CTL_ZERO_BYTES = 1 * MiB;
constexpr size_t WS_R2 = 1 * MiB;
constexpr size_t WS_R3 = WS_R2 + 256 * 1024;
constexpr size_t WS_TKE = 2 * MiB;
constexpr size_t WS_TKW = 3 * MiB;
constexpr size_t WS_TKR = 4 * MiB;
constexpr size_t WS_TKS = 13 * MiB;
constexpr size_t WS_ROWT = 5 * MiB;
constexpr size_t WS_CNTWG = 11 * MiB;
constexpr size_t WS_SEGTOT = WS_CNTWG + 256 * 1024;
constexpr size_t WS_WRF = 12 * MiB;
constexpr size_t WS_WIN = 16 * MiB;
constexpr size_t WS_WEFF = 24 * MiB;
constexpr size_t WS_WAU = 25 * MiB;
constexpr size_t WS_WOUT = 26 * MiB;
constexpr size_t WS_WPG = 28 * MiB;
constexpr size_t WS_WPP = 30 * MiB;
constexpr size_t WS_WGU = 32 * MiB;
constexpr size_t WS_WDN = 96 * MiB;
constexpr size_t WS_H2F8 = 128 * MiB;
constexpr size_t WS_A = 224 * MiB;
constexpr size_t WS_B = 352 * MiB;
constexpr size_t WS_C = 480 * MiB;
constexpr size_t WS_E = 608 * MiB;
constexpr size_t WS_PB = 736 * MiB;
constexpr size_t WS_G = 768 * MiB;
constexpr size_t WS_Y3 = 896 * MiB;
constexpr size_t WS_END = 1024 * MiB;
constexpr int CW_BAR = 4096;

constexpr int RING_BYTES = 131072;
constexpr int LDSCTL_OFF = RING_BYTES, MISC_OFF = LDSCTL_OFF + 320;
constexpr int LDS_TAB_OFF = MISC_OFF + 128;
constexpr int LDS_BYTES = 147456;

#define RLX_AGENT __ATOMIC_RELAXED, __HIP_MEMORY_SCOPE_AGENT
#define LDS_WAIT() asm volatile("s_waitcnt lgkmcnt(0)" ::: "memory")
#define VM_WAIT() asm volatile("s_waitcnt vmcnt(0)" ::: "memory")

__device__ __forceinline__ int lane_id_v() { int l; asm volatile("v_mbcnt_lo_u32_b32 %0, -1, 0\n\tv_mbcnt_hi_u32_b32 %0, -1, %0" : "=v"(l)); return l; }
__device__ __forceinline__ unsigned f2bf(float f) { unsigned u = __builtin_bit_cast(unsigned, f); return (u + 0x7fffu + ((u >> 16) & 1u)) >> 16; }
__device__ __forceinline__ unsigned pk2(float lo, float hi) { f32x2 v = {lo, hi}; bf16x2_t b = __builtin_convertvector(v, bf16x2_t); return __builtin_bit_cast(unsigned, b); }
__device__ __forceinline__ unsigned pk4_fp8(float a, float b, float c, float d) { int r = __builtin_amdgcn_cvt_pk_fp8_f32(a, b, 0, false); r = __builtin_amdgcn_cvt_pk_fp8_f32(c, d, r, true); return (unsigned)r; }
__device__ __forceinline__ float bflo(unsigned u) { return __builtin_bit_cast(float, u << 16); }
__device__ __forceinline__ float bfhi(unsigned u) { return __builtin_bit_cast(float, u & 0xffff0000u); }
__device__ __forceinline__ float fast_sigmoid(float v) { return __builtin_amdgcn_rcpf(1.0f + __builtin_amdgcn_exp2f(-LOG2E * v)); }
__device__ __forceinline__ float wave_sum(float v) {
#pragma unroll
    for (int o = 1; o < 64; o <<= 1) v += __shfl_xor(v, o);
    return v;
}

#define XB_TMO      128
#define XB_XCNT(j)  (256  + 64 * (j))
#define XB_XSUB(j)  (1280 + 64 * (j))
#define XB_XGEN(j)  (2304 + 64 * (j))
#define XB_TOP      3328
#define XB_TOPGEN   3392
#define XCD_BAR_WORDS 3456
#define XB_SPIN_CAP (1u << 18)
__device__ __forceinline__ unsigned xb_ld(unsigned* p)              { return __hip_atomic_load(p, __ATOMIC_RELAXED, __HIP_MEMORY_SCOPE_AGENT); }
__device__ __forceinline__ unsigned xb_add(unsigned* p, unsigned v) { return __hip_atomic_fetch_add(p, v, __ATOMIC_RELAXED, __HIP_MEMORY_SCOPE_AGENT); }
__device__ __forceinline__ unsigned xb_xcc_id() { return (unsigned)__builtin_amdgcn_s_getreg((3 << 11) | 20) & 0xFu; }
#define XB_SPIN(cond, bar) do { unsigned _sp = 0; while (cond) { __builtin_amdgcn_s_sleep(1); \
    if ((++_sp & 255u) == 0u) { if (xb_ld(&(bar)[XB_TMO])) break; if (_sp > XB_SPIN_CAP) { atomicAdd(&(bar)[XB_TMO], 1u); break; } } } } while (0)
struct XcdBarrier { unsigned* bar; unsigned x; volatile LAS unsigned* st; };
__device__ __forceinline__ XcdBarrier xcd_barrier_post(unsigned* bar, volatile LAS unsigned* st, int wave) {
    XcdBarrier b; b.bar = bar; b.x = xb_xcc_id(); b.st = st;
    if (wave == 0 && lane_id_v() == 0) (void)xb_add(&bar[XB_XCNT(b.x)], 1u);
    return b;
}
__device__ __forceinline__ void xcd_barrier_complete(unsigned* bar, unsigned x, unsigned& nloc, unsigned& nx) {
    const unsigned G = gridDim.x * gridDim.y * gridDim.z;
    unsigned sum, cnt, mine, sp = 0u;
    for (;;) {
        sum = 0u; cnt = 0u; mine = 0u;
#pragma unroll
        for (unsigned j = 0; j < 16; ++j) { const unsigned c = xb_ld(&bar[XB_XCNT(j)]); sum += c; cnt += (c > 0u) ? 1u : 0u; mine = (j == x) ? c : mine; }
        if (sum == G) break;
        __builtin_amdgcn_s_sleep(1);
        if ((++sp & 255u) == 0u) { if (xb_ld(&bar[XB_TMO])) break; if (sp > XB_SPIN_CAP) { atomicAdd(&bar[XB_TMO], 1u); break; } }
    }
    nloc = mine > 0u ? mine : 1u; nx = cnt > 0u ? cnt : 1u;
}
__device__ __forceinline__ void xcd_barrier(const XcdBarrier& b, int wave) {
    asm volatile("s_waitcnt vmcnt(0)" ::: "memory");
    __syncthreads();
    if (wave == 0 && lane_id_v() == 0) {
        unsigned* bar = b.bar;
        __builtin_amdgcn_s_waitcnt(0);
        unsigned nloc = b.st[0], nx = b.st[1];
        if (nloc == 0u) { xcd_barrier_complete(bar, b.x, nloc, nx); b.st[0] = nloc; b.st[1] = nx; }
        const unsigned old = xb_add(&bar[XB_XSUB(b.x)], 1u);
        const unsigned gen = old / nloc;
        if (old + 1u == (gen + 1u) * nloc) {
            __builtin_amdgcn_fence(__ATOMIC_RELEASE, "agent");
            asm volatile("s_waitcnt vmcnt(0)" ::: "memory");
            const unsigned og = xb_add(&bar[XB_TOP], 1u);
            const unsigned tg = og / nx;
            if (og + 1u == (tg + 1u) * nx) xb_add(&bar[XB_TOPGEN], 1u);
            else XB_SPIN(xb_ld(&bar[XB_TOPGEN]) == tg, bar);
            __builtin_amdgcn_fence(__ATOMIC_ACQUIRE, "agent");
            xb_add(&bar[XB_XGEN(b.x)], 1u);
            asm volatile("s_waitcnt vmcnt(0)" ::: "memory");
        } else {
            XB_SPIN(xb_ld(&bar[XB_XGEN(b.x)]) == gen, bar);
            __builtin_amdgcn_fence(__ATOMIC_ACQUIRE, "agent");
            asm volatile("s_waitcnt vmcnt(0)" ::: "memory");
        }
    }
    __syncthreads();
}

namespace pg8 {
constexpr int BM = 256, BK = 64, HALF = 128, HTB = HALF * BK * 2, NXCD = 8, WGM = 8;
__host__ __device__ __forceinline__ int lds_byte(int r, int c) { const int st = (r >> 4) * 2 + (c >> 5), rr = r & 15, cc = c & 31, ob = rr * 64 + cc * 2; return st * 1024 + (ob ^ (((ob >> 9) & 1) << 5)); }
__host__ __device__ __forceinline__ void stage_rc(int b, int& R, int& C) { const int st = b / 1024, sb = b % 1024, swz = sb ^ (((sb >> 9) & 1) << 5); R = (st >> 1) * 16 + swz / 64; C = (st & 1) * 32 + (swz % 64) / 2; }
__host__ __device__ __forceinline__ int perm32(int rho) { const int n = rho >> 4, i = rho & 15; return 8 * (i >> 2) + 4 * n + (i & 3); }

typedef int v8i __attribute__((ext_vector_type(8)));
typedef int v4i_ __attribute__((ext_vector_type(4)));
__device__ __forceinline__ v8i cat8(const bf16x8 a, const bf16x8 b) { const v4i_ x = __builtin_bit_cast(v4i_, a), y = __builtin_bit_cast(v4i_, b); return __builtin_shufflevector(x, y, 0, 1, 2, 3, 4, 5, 6, 7); }
struct Unit { int pm, pn, e, row0, nvalid; };
struct Gemm { const void* A; const void* Bt; int K; };

struct StaticOrder {
    int nM, nN, nwg, G, c;
    __device__ void init(int Mr, int N, int G_, int c_) { nM = Mr / BM; nN = N / BM; nwg = nM * nN; G = G_; c = c_; }
    __device__ __forceinline__ bool next(int i, Unit& u) const {
        const long L = (long)i * G + c; if (L >= nwg) return false;
        int wgid = (int)L; { const int q = nwg / NXCD, r = nwg % NXCD, xcd = wgid % NXCD, off = wgid / NXCD; wgid = (xcd < r ? xcd * (q + 1) : r * (q + 1) + (xcd - r) * q) + off; }
        const int nig = WGM * nN, gid = wgid / nig, fm = gid * WGM, gsz = (nM - fm) < WGM ? (nM - fm) : WGM;
        u.pm = fm + ((wgid % nig) % gsz); u.pn = (wgid % nig) / gsz; u.e = 0; u.row0 = u.pm * BM; u.nvalid = BM; return true;
    }
    __device__ __forceinline__ void a_off(const Unit& u, int tid, int pitchB, unsigned (&va)[2][2]) const {
#pragma unroll
        for (int i = 0; i < 2; ++i) { int R, C; stage_rc(tid * 16 + i * 8192, R, C);
#pragma unroll
            for (int h = 0; h < 2; ++h) va[h][i] = (unsigned)((u.pm * BM + h * HALF + R) * pitchB + C * 2); }
    }
    __device__ __forceinline__ const char* b_ptr(const Unit& u, const Gemm& g, int pitchB) const { return (const char*)g.Bt + (size_t)u.pn * BM * pitchB; }
};

template <class Epi, class Sched, bool ALIGN_EPI, int ES = 2>
__device__ __forceinline__ void gemm_phase(LAS unsigned char* lds, const Gemm g, const Sched& S, const Epi& E, const int wid) {
    const int lane = lane_id_v(), tid = wid * 64 + lane, wr = wid >> 2, wc = wid & 3, fr = lane & 15, fq = lane >> 4;
    const int K = g.K, pitchB = K * ES; int nt = pitchB / 128;
    asm volatile("" : "+s"(nt));
    unsigned voffB[2];
#pragma unroll
    for (int i = 0; i < 2; ++i) { int R, C; stage_rc(tid * 16 + i * 8192, R, C); const int Rb = Epi::PERM ? ((R & ~31) + perm32(R & 31)) : R;
        voffB[i] = (unsigned)(Rb * pitchB + C * 2); }
    const size_t kstep = (size_t)(BK * 2);
    const size_t hstep = (size_t)HALF * pitchB;
    const unsigned ldsw = (unsigned)wid * 1024u;
    const int aoff = lds_byte(wr * 64 + fr, fq * 8), boff = lds_byte(wc * 32 + fr, fq * 8);
#define PG8_SA(b, h) (((b) * 2 + (h)) * HTB)
#define PG8_SB(b, h) ((4 + (b) * 2 + (h)) * HTB)
#define PG8_STAGE(bufoff, gbase, voff) do { _Pragma("unroll") for (int _i = 0; _i < 2; ++_i) \
        __builtin_amdgcn_global_load_lds((const unsigned*)((const char*)(gbase) + (voff)[_i]), (LAS unsigned*)(lds + (bufoff) + ldsw + _i * 8192), 16, 0, 0); } while (0)
#define PG8_LDA(dst, b, h) do { _Pragma("unroll") for (int m = 0; m < 4; ++m) _Pragma("unroll") for (int k = 0; k < 2; ++k) dst[m][k] = *(const LAS bf16x8*)(lds + PG8_SA(b, h) + aoff + m * 2048 + k * 1024); } while (0)
#define PG8_LDB(dst, b, h) do { _Pragma("unroll") for (int n = 0; n < 2; ++n) _Pragma("unroll") for (int k = 0; k < 2; ++k) dst[n][k] = *(const LAS bf16x8*)(lds + PG8_SB(b, h) + boff + n * 2048 + k * 1024); } while (0)
#define PG8_MMA(ai, bj, At, Bt) do { __builtin_amdgcn_s_setprio(1); _Pragma("unroll") for (int m = 0; m < 4; ++m) _Pragma("unroll") for (int n = 0; n < 2; ++n) { \
        if constexpr (ES == 2) { _Pragma("unroll") for (int k = 0; k < 2; ++k) acc[ai][bj][m][n] = __builtin_amdgcn_mfma_f32_16x16x32_bf16(Bt[n][k], At[m][k], acc[ai][bj][m][n], 0, 0, 0); } \
        else { const v8i a8_ = cat8(Bt[n][0], Bt[n][1]), b8_ = cat8(At[m][0], At[m][1]); \
               if (m == 0 && n == 0) asm volatile("s_nop 1\n\tv_mfma_f32_16x16x128_f8f6f4 %0, %1, %2, %0" : "+v"(acc[ai][bj][m][n]) : "v"(a8_), "v"(b8_)); \
               else asm volatile("v_mfma_f32_16x16x128_f8f6f4 %0, %1, %2, %0" : "+v"(acc[ai][bj][m][n]) : "v"(a8_), "v"(b8_)); } } \
        __builtin_amdgcn_s_setprio(0); } while (0)
#define PG8_WAIT_V(n) asm volatile("s_waitcnt vmcnt(" #n ")" ::: "memory")
#define PG8_WAIT_L(n) asm volatile("s_waitcnt lgkmcnt(" #n ")" ::: "memory")
#define PG8_BAR __builtin_amdgcn_s_barrier()
#define PG8_SCHED __builtin_amdgcn_sched_barrier(0)
    Unit cur, nxt; int ui = 0;
    if (!S.next(0, cur)) return;
    f32x4 acc[2][2][4][2];
#pragma unroll
    for (int a = 0; a < 2; ++a)
#pragma unroll
        for (int b = 0; b < 2; ++b)
#pragma unroll
            for (int m = 0; m < 4; ++m)
#pragma unroll
                for (int n = 0; n < 2; ++n) acc[a][b][m][n] = (f32x4){0.f, 0.f, 0.f, 0.f};
    bf16x8 At[4][2], B0[2][2], B1[2][2];
    unsigned cva[2][2], nva[2][2];
    S.a_off(cur, tid, pitchB, cva);
    const char* const Ab = (const char*)g.A;
    const char* cB = S.b_ptr(cur, g, pitchB);
    PG8_STAGE(PG8_SB(0, 0), cB, voffB); PG8_STAGE(PG8_SB(0, 1), cB + hstep, voffB); PG8_STAGE(PG8_SA(0, 0), Ab, cva[0]); PG8_STAGE(PG8_SA(0, 1), Ab, cva[1]);
    if (wr == 1) PG8_BAR;
    PG8_WAIT_V(2); PG8_BAR;
    PG8_STAGE(PG8_SB(1, 0), cB + kstep, voffB); PG8_STAGE(PG8_SA(1, 0), Ab + kstep, cva[0]); PG8_STAGE(PG8_SB(1, 1), cB + hstep + kstep, voffB);
    PG8_WAIT_V(6); PG8_BAR;
    for (;;) {
        const bool has_next = S.next(ui + 1, nxt);
        const char* nB = cB;
        if (has_next) { S.a_off(nxt, tid, pitchB, nva); nB = S.b_ptr(nxt, g, pitchB); }
        else {
#pragma unroll
            for (int h = 0; h < 2; ++h)
#pragma unroll
                for (int i = 0; i < 2; ++i) nva[h][i] = cva[h][i];
        }
#pragma nounroll
        for (int t = 0; t < nt; t += 2) {
            const bool last = (t == nt - 2);
            const char* Abt = Ab; asm volatile("" : "+s"(Abt));
            const char* a1 = Abt + (size_t)(t + 1) * kstep;
            const char* a2 = last ? Abt : Abt + (size_t)(t + 2) * kstep; const char* b2 = last ? nB : cB + (size_t)(t + 2) * kstep;
            const char* a3 = a2 + kstep; const char* b3 = b2 + kstep;
            unsigned va2[2][2];
#pragma unroll
            for (int h = 0; h < 2; ++h)
#pragma unroll
                for (int i = 0; i < 2; ++i) va2[h][i] = last ? nva[h][i] : cva[h][i];
            PG8_LDB(B0, 0, 0); PG8_LDB(B1, 0, 1); PG8_SCHED; PG8_LDA(At, 0, 0); PG8_STAGE(PG8_SA(1, 1), a1, cva[1]);
            PG8_WAIT_V(8); PG8_WAIT_L(0); PG8_BAR; PG8_MMA(0, 0, At, B0); PG8_MMA(0, 1, At, B1); PG8_BAR; PG8_SCHED;
            PG8_LDA(At, 0, 1); PG8_STAGE(PG8_SB(0, 0), b2, voffB); PG8_STAGE(PG8_SB(0, 1), b2 + hstep, voffB); PG8_STAGE(PG8_SA(0, 0), a2, va2[0]);
            PG8_WAIT_V(8); PG8_WAIT_L(0); PG8_BAR; PG8_MMA(1, 0, At, B0); PG8_MMA(1, 1, At, B1); PG8_BAR; PG8_SCHED;
            PG8_LDB(B0, 1, 0); PG8_LDB(B1, 1, 1); PG8_SCHED; PG8_LDA(At, 1, 0); PG8_STAGE(PG8_SA(0, 1), a2, va2[1]);
            PG8_WAIT_V(8); PG8_WAIT_L(0); PG8_BAR; PG8_MMA(0, 0, At, B0); PG8_MMA(0, 1, At, B1); PG8_BAR; PG8_SCHED;
            PG8_LDA(At, 1, 1); PG8_STAGE(PG8_SB(1, 0), b3, voffB); PG8_STAGE(PG8_SB(1, 1), b3 + hstep, voffB); PG8_STAGE(PG8_SA(1, 0), a3, va2[0]);
            PG8_WAIT_V(8); PG8_WAIT_L(0); PG8_BAR; PG8_MMA(1, 0, At, B0); PG8_MMA(1, 1, At, B1); PG8_BAR; PG8_SCHED;
        }
        if constexpr (ALIGN_EPI) { if (wr == 0) PG8_BAR; }
        if constexpr (ES == 1) asm volatile("s_nop 11");
        E(acc, cur, wr, wc, fr, fq);
        if (!has_next) break;
#pragma unroll
        for (int a = 0; a < 2; ++a)
#pragma unroll
            for (int b = 0; b < 2; ++b)
#pragma unroll
                for (int m = 0; m < 4; ++m)
#pragma unroll
                    for (int n = 0; n < 2; ++n) acc[a][b][m][n] = (f32x4){0.f, 0.f, 0.f, 0.f};
        cur = nxt; cB = nB; ++ui;
#pragma unroll
        for (int h = 0; h < 2; ++h)
#pragma unroll
            for (int i = 0; i < 2; ++i) cva[h][i] = nva[h][i];
        if constexpr (ALIGN_EPI) { if (wr == 1) PG8_BAR; }
    }
    PG8_WAIT_V(0);
    if constexpr (!ALIGN_EPI) { if (wr == 0) PG8_BAR; }
    PG8_BAR;
#undef PG8_SA
#undef PG8_SB
#undef PG8_STAGE
#undef PG8_LDA
#undef PG8_LDB
#undef PG8_MMA
#undef PG8_WAIT_V
#undef PG8_WAIT_L
#undef PG8_BAR
#undef PG8_SCHED
}

__device__ __forceinline__ v4u pack8(const f32x4 a, const f32x4 b) { v4u w; w.x = pk2(a[0], a[1]); w.y = pk2(a[2], a[3]); w.z = pk2(b[0], b[1]); w.w = pk2(b[2], b[3]); return w; }
__device__ __forceinline__ void unpack8(const v4u w, f32x4& a, f32x4& b) { a = (f32x4){bflo(w.x), bfhi(w.x), bflo(w.y), bfhi(w.y)}; b = (f32x4){bflo(w.z), bfhi(w.z), bflo(w.w), bfhi(w.w)}; }

struct EpiPlain {
    static constexpr bool PERM = true;
    bf16* O; int ldc;
    __device__ __forceinline__ void operator()(const f32x4 (&acc)[2][2][4][2], const Unit& u, int wr, int wc, int fr, int fq) const {
        const int row0 = u.pm * BM + wr * 64 + fr, col0 = u.pn * BM + wc * 32 + 8 * fq;
#pragma unroll
        for (int ai = 0; ai < 2; ++ai)
#pragma unroll
            for (int m = 0; m < 4; ++m) { bf16* rowp = O + (size_t)(row0 + ai * HALF + m * 16) * ldc + col0;
#pragma unroll
                for (int bj = 0; bj < 2; ++bj) *(GAS v4u*)(rowp + bj * HALF) = pack8(acc[ai][bj][m][0], acc[ai][bj][m][1]); }
    }
};
struct EpiProj {
    static constexpr bool PERM = true;
    bf16 *U, *Q, *Kb, *GP, *GA;
    __device__ __forceinline__ void operator()(const f32x4 (&acc)[2][2][4][2], const Unit& u, int wr, int wc, int fr, int fq) const {
        const int pn = u.pn; bf16* base; int ldc, colt; float sc = 1.f; bool sig = false;
        if (pn < 2) { base = U; ldc = 512; colt = pn * 256; }
        else if (pn < 4) { base = Q; ldc = 512; colt = (pn - 2) * 256; sc = QSCALE; }
        else if (pn < 6) { base = Kb; ldc = 512; colt = (pn - 4) * 256; }
        else if (pn < 10) { base = GP; ldc = 1024; colt = (pn - 6) * 256; sig = true; }
        else { base = GA; ldc = 1024; colt = (pn - 10) * 256; sig = true; }
        const int row0 = u.pm * BM + wr * 64 + fr, col0 = colt + wc * 32 + 8 * fq;
#pragma unroll
        for (int ai = 0; ai < 2; ++ai)
#pragma unroll
            for (int m = 0; m < 4; ++m) { bf16* rowp = base + (size_t)(row0 + ai * HALF + m * 16) * ldc + col0;
#pragma unroll
                for (int bj = 0; bj < 2; ++bj) { f32x4 v0 = acc[ai][bj][m][0], v1 = acc[ai][bj][m][1];
                    if (sig) {
#pragma unroll
                        for (int j = 0; j < 4; ++j) { v0[j] = fast_sigmoid(v0[j]); v1[j] = fast_sigmoid(v1[j]); }
                    } else { v0 = v0 * sc; v1 = v1 * sc; }
                    *(GAS v4u*)(rowp + bj * HALF) = pack8(v0, v1); } }
    }
};
template <bool ADD> struct EpiGate {
    static constexpr bool PERM = true;
    bf16* O; const bf16* G;
    __device__ __forceinline__ void operator()(const f32x4 (&acc)[2][2][4][2], const Unit& u, int wr, int wc, int fr, int fq) const {
        const int row0 = u.pm * BM + wr * 64 + fr, col0 = u.pn * BM + wc * 32 + 8 * fq;
#pragma unroll
        for (int ai = 0; ai < 2; ++ai)
#pragma unroll
            for (int m = 0; m < 4; ++m) { const size_t ro = (size_t)(row0 + ai * HALF + m * 16) * 1024 + col0;
#pragma unroll
                for (int bj = 0; bj < 2; ++bj) { f32x4 g0, g1; unpack8(*(const GAS v4u*)(G + ro + bj * HALF), g0, g1);
                    f32x4 v0 = acc[ai][bj][m][0] * g0, v1 = acc[ai][bj][m][1] * g1;
                    if (ADD) { f32x4 o0, o1; unpack8(*(const GAS v4u*)(O + ro + bj * HALF), o0, o1); v0 = v0 + o0; v1 = v1 + o1; }
                    *(GAS v4u*)(O + ro + bj * HALF) = pack8(v0, v1); } }
    }
};
struct EpiResid {
    static constexpr bool PERM = true;
    bf16* O; const float* X;
    __device__ __forceinline__ void operator()(const f32x4 (&acc)[2][2][4][2], const Unit& u, int wr, int wc, int fr, int fq) const {
        const int row0 = u.pm * BM + wr * 64 + fr, col0 = u.pn * BM + wc * 32 + 8 * fq;
#pragma unroll
        for (int ai = 0; ai < 2; ++ai)
#pragma unroll
            for (int m = 0; m < 4; ++m) { const size_t ro = (size_t)(row0 + ai * HALF + m * 16) * 1024 + col0;
#pragma unroll
                for (int bj = 0; bj < 2; ++bj) { const f32x4 x0 = *(const GAS f32x4*)(X + ro + bj * HALF), x1 = *(const GAS f32x4*)(X + ro + bj * HALF + 4);
                    *(GAS v4u*)(O + ro + bj * HALF) = pack8(acc[ai][bj][m][0] + x0, acc[ai][bj][m][1] + x1); } }
    }
};
struct EpiPle {
    static constexpr bool PERM = true;
    bf16* O; const bf16* X2; const bf16* PP; const float* R3;
    __device__ __forceinline__ void operator()(const f32x4 (&acc)[2][2][4][2], const Unit& u, int wr, int wc, int fr, int fq) const {
        const int row0 = u.pm * BM + wr * 64 + fr, col0 = u.pn * BM + wc * 32 + 8 * fq;
#pragma unroll
        for (int ai = 0; ai < 2; ++ai)
#pragma unroll
            for (int m = 0; m < 4; ++m) { const int row = row0 + ai * HALF + m * 16; const size_t ro = (size_t)row * 1024 + col0; const float r = R3[row];
#pragma unroll
                for (int bj = 0; bj < 2; ++bj) { f32x4 x0, x1, p0, p1; unpack8(*(const GAS v4u*)(X2 + ro + bj * HALF), x0, x1); unpack8(*(const GAS v4u*)(PP + ro + bj * HALF), p0, p1);
                    f32x4 v0, v1;
#pragma unroll
                    for (int j = 0; j < 4; ++j) { v0[j] = x0[j] + fast_sigmoid(r * acc[ai][bj][m][0][j]) * p0[j]; v1[j] = x1[j] + fast_sigmoid(r * acc[ai][bj][m][1][j]) * p1[j]; }
                    *(GAS v4u*)(O + ro + bj * HALF) = pack8(v0, v1); } }
    }
};

template <bool GATHER> struct MoeOrder {
    const LAS int* tab; const int* row_token; const unsigned char* W; int NT, G, c, total; size_t wstride;
    __device__ __forceinline__ bool next(int i, Unit& u) const {
        const long L = (long)i * G + c; if (L >= total) return false;
        const int rt = (int)(L / NT); u.pn = (int)(L % NT);
        int e = 0;
#pragma unroll
        for (int j = 1; j < 32; ++j) e += (tab[j] <= rt) ? 1 : 0;
        e = __builtin_amdgcn_readfirstlane(e);
        const int lt = rt - __builtin_amdgcn_readfirstlane(tab[e]), cn = __builtin_amdgcn_readfirstlane(tab[65 + e]);
        u.e = e; u.pm = rt; u.row0 = __builtin_amdgcn_readfirstlane(tab[33 + e]) + lt * 256; u.nvalid = (cn - lt * 256) < 256 ? (cn - lt * 256) : 256; return true;
    }
    __device__ __forceinline__ void a_off(const Unit& u, int tid, int pitchB, unsigned (&va)[2][2]) const {
        int R[2], C[2];
#pragma unroll
        for (int i = 0; i < 2; ++i) stage_rc(tid * 16 + i * 8192, R[i], C[i]);
        if constexpr (GATHER) {
            int tok[2][2];
#pragma unroll
            for (int i = 0; i < 2; ++i)
#pragma unroll
                for (int h = 0; h < 2; ++h) { const int rl = h * HALF + R[i]; tok[h][i] = row_token[u.row0 + (rl < u.nvalid ? rl : 0)]; }
#pragma unroll
            for (int i = 0; i < 2; ++i)
#pragma unroll
                for (int h = 0; h < 2; ++h) va[h][i] = (unsigned)(tok[h][i] * pitchB + C[i] * 2);
        } else {
#pragma unroll
            for (int i = 0; i < 2; ++i)
#pragma unroll
                for (int h = 0; h < 2; ++h) va[h][i] = (unsigned)((u.row0 + h * HALF + R[i]) * pitchB + C[i] * 2);
        }
    }
    __device__ __forceinline__ const char* b_ptr(const Unit& u, const Gemm& g, int pitchB) const { return (const char*)(W + (size_t)u.e * wstride + (size_t)u.pn * 256 * pitchB); }
};
struct EpiMoe1 {
    static constexpr bool PERM = true;
    unsigned char* act; const float* bgu;
    __device__ __forceinline__ void operator()(const f32x4 (&acc)[2][2][4][2], const Unit& u, int wr, int wc, int fr, int fq) const {
        const int cl = u.pn * 128 + wc * 32 + 8 * fq;
        const float* bg = bgu + (size_t)u.e * 2048 + cl;
        const f32x4 g0b = *(const GAS f32x4*)(bg), g1b = *(const GAS f32x4*)(bg + 4), u0b = *(const GAS f32x4*)(bg + 1024), u1b = *(const GAS f32x4*)(bg + 1028);
#pragma unroll
        for (int ai = 0; ai < 2; ++ai)
#pragma unroll
            for (int m = 0; m < 4; ++m) { const int rl = ai * HALF + wr * 64 + m * 16 + fr;
                const f32x4 ga = acc[ai][0][m][0] * WSCALE_INV + g0b, gb = acc[ai][0][m][1] * WSCALE_INV + g1b, ua = acc[ai][1][m][0] * WSCALE_INV + u0b, ub = acc[ai][1][m][1] * WSCALE_INV + u1b;
                f32x4 o0, o1;
#pragma unroll
                for (int j = 0; j < 4; ++j) {
                    { const float gt = fminf(ga[j], 7.0f), up = fminf(fmaxf(ua[j], -7.0f), 7.0f); o0[j] = (up + 1.0f) * gt * fast_sigmoid(1.702f * gt); }
                    { const float gt = fminf(gb[j], 7.0f), up = fminf(fmaxf(ub[j], -7.0f), 7.0f); o1[j] = (up + 1.0f) * gt * fast_sigmoid(1.702f * gt); }
                }
                const int orow = rl < u.nvalid ? u.row0 + rl : M + rl;
                v2u o8; o8.x = pk4_fp8(o0[0], o0[1], o0[2], o0[3]); o8.y = pk4_fp8(o1[0], o1[1], o1[2], o1[3]);
                *(GAS v2u*)(act + (size_t)orow * 1024 + cl) = o8; }
    }
};
struct EpiMoe2 {
    static constexpr bool PERM = true;
    bf16* Y; const float* bdn;
    __device__ __forceinline__ void operator()(const f32x4 (&acc)[2][2][4][2], const Unit& u, int wr, int wc, int fr, int fq) const {
        const int col0 = u.pn * 256 + wc * 32 + 8 * fq;
        const float* bd = bdn + (size_t)u.e * 1024 + col0;
        f32x4 bv[2][2];
#pragma unroll
        for (int bj = 0; bj < 2; ++bj) { bv[bj][0] = *(const GAS f32x4*)(bd + bj * HALF); bv[bj][1] = *(const GAS f32x4*)(bd + bj * HALF + 4); }
#pragma unroll
        for (int ai = 0; ai < 2; ++ai)
#pragma unroll
            for (int m = 0; m < 4; ++m) { const int rl = ai * HALF + wr * 64 + m * 16 + fr;
                if (rl < u.nvalid) { bf16* rowp = Y + (size_t)(u.row0 + rl) * 1024 + col0;
#pragma unroll
                    for (int bj = 0; bj < 2; ++bj) *(GAS v4u*)(rowp + bj * HALF) = pack8(acc[ai][bj][m][0] * WSCALE_INV + bv[bj][0], acc[ai][bj][m][1] * WSCALE_INV + bv[bj][1]); } }
    }
};
}

struct Frame {
    LAS unsigned char* lds; volatile LAS unsigned* MISC; gu32* ctl;
    int wave, vcu, G;
};
struct Args { const float* in[20]; float* out; unsigned char* ws; int ph_lo, ph_hi; };

template <bool F8>
__device__ __forceinline__ void p0_transpose_item(const float* W, int N, int k0, int n0, void* WT, int Kp, int dst_row0, const float* gain, float scale, LAS float* scr, int lane) {
    f32x4 v[8]; float gs[8];
    const int kq = lane >> 3, n4 = 4 * (lane & 7);
#pragma unroll
    for (int i = 0; i < 8; ++i) v[i] = *(const GAS f32x4*)(W + (size_t)(k0 + kq + 8 * i) * N + n0 + n4);
#pragma unroll
    for (int i = 0; i < 8; ++i) gs[i] = gain ? gain[k0 + kq + 8 * i] * scale : scale;
#pragma unroll
    for (int i = 0; i < 8; ++i) { LAS float* s = scr + (kq + 8 * i) * 33 + n4; s[0] = v[i].x * gs[i]; s[1] = v[i].y * gs[i]; s[2] = v[i].z * gs[i]; s[3] = v[i].w * gs[i]; }
    LDS_WAIT(); asm volatile("" ::: "memory");
    if constexpr (!F8) {
        const int c = lane & 7;
#pragma unroll
        for (int j = 0; j < 4; ++j) { const int n = (lane >> 3) + 8 * j; const LAS float* s = scr + (8 * c) * 33 + n;
            v4u o; o.x = pk2(s[0 * 33], s[1 * 33]); o.y = pk2(s[2 * 33], s[3 * 33]); o.z = pk2(s[4 * 33], s[5 * 33]); o.w = pk2(s[6 * 33], s[7 * 33]);
            *(GAS v4u*)((bf16*)WT + (size_t)(dst_row0 + n) * Kp + k0 + 8 * c) = o; }
    } else {
        const int c = lane & 3;
#pragma unroll
        for (int j = 0; j < 2; ++j) { const int n = (lane >> 2) + 16 * j; const LAS float* s = scr + (16 * c) * 33 + n;
            v4u o; o.x = pk4_fp8(s[0 * 33], s[1 * 33], s[2 * 33], s[3 * 33]); o.y = pk4_fp8(s[4 * 33], s[5 * 33], s[6 * 33], s[7 * 33]);
            o.z = pk4_fp8(s[8 * 33], s[9 * 33], s[10 * 33], s[11 * 33]); o.w = pk4_fp8(s[12 * 33], s[13 * 33], s[14 * 33], s[15 * 33]);
            *(GAS v4u*)((unsigned char*)WT + (size_t)(dst_row0 + n) * Kp + k0 + 16 * c) = o; }
    }
    LDS_WAIT(); asm volatile("" ::: "memory");
}
__device__ __forceinline__ void rms_row_f32_to_bf16(const float* xrow, const float* g, bf16* orow, int lane) {
    const GAS f32x4* xr = (const GAS f32x4*)xrow + lane; const GAS f32x4* gr = (const GAS f32x4*)g + lane;
    f32x4 v[4]; float s = 0.f;
#pragma unroll
    for (int j = 0; j < 4; ++j) { v[j] = xr[64 * j]; s += (v[j].x * v[j].x + v[j].y * v[j].y) + (v[j].z * v[j].z + v[j].w * v[j].w); }
    const float r = 1.0f / sqrtf(wave_sum(s) * (1.f / D) + EPS);
    GAS v2u* o8 = (GAS v2u*)orow + lane;
#pragma unroll
    for (int j = 0; j < 4; ++j) { const f32x4 gg = gr[64 * j]; v2u o; o.x = pk2(v[j].x * r * gg.x, v[j].y * r * gg.y); o.y = pk2(v[j].z * r * gg.z, v[j].w * r * gg.w); o8[64 * j] = o; }
}

#define MFMA32(a, b, c) __builtin_amdgcn_mfma_f32_32x32x16_bf16((a), (b), (c), 0, 0, 0)
__device__ __forceinline__ bf16x8 ldg16(const bf16* p) { return *(const GAS bf16x8*)p; }
__device__ __forceinline__ void attn_task(const bf16* __restrict__ Q, const bf16* __restrict__ Kp, const bf16* __restrict__ Vt, bf16* __restrict__ Y, int b, int h, int qb, int lane) {
    const int l31 = lane & 31, hl = lane >> 5;
    const int t0 = qb * 32; const size_t tb = (size_t)b * SEQ;
    bf16x8 qf[4];
    { const bf16* qrow = Q + (tb + t0 + l31) * 512 + h * 64 + 8 * hl;
#pragma unroll
      for (int kk = 0; kk < 4; ++kk) qf[kk] = ldg16(qrow + 16 * kk); }
    const int a_ = l31 >> 3, hh = (l31 >> 2) & 1, c_ = l31 & 3;
    const int pim = 16 * (a_ >> 1) + 8 * hh + 4 * (a_ & 1) + c_;
    const bf16* kbase = Kp + (tb + pim) * 512 + h * 64 + 8 * hl;
    const bf16* vbase = Vt + (size_t)(h * 64 + l31) * M + tb + 8 * hl;
    f32x16 o0, o1;
#pragma unroll
    for (int r = 0; r < 16; ++r) { o0[r] = 0.f; o1[r] = 0.f; }
    float carry = 0.f;
    int key0 = t0;
    bf16x8 kf[4], vf[4];
#pragma unroll
    for (int kk = 0; kk < 4; ++kk) kf[kk] = ldg16(kbase + (size_t)key0 * 512 + 16 * kk);
#pragma unroll
    for (int dj = 0; dj < 4; ++dj) vf[dj] = ldg16(vbase + (size_t)(dj >> 1) * 32 * M + key0 + 16 * (dj & 1));
    for (;;) {
        const int nk = key0 - 32; const bool more = nk >= 0;
        bf16x8 kn[4], vn[4];
        const int lk = more ? nk : key0;
#pragma unroll
        for (int kk = 0; kk < 4; ++kk) kn[kk] = ldg16(kbase + (size_t)lk * 512 + 16 * kk);
#pragma unroll
        for (int dj = 0; dj < 4; ++dj) vn[dj] = ldg16(vbase + (size_t)(dj >> 1) * 32 * M + lk + 16 * (dj & 1));
        f32x16 s;
#pragma unroll
        for (int r = 0; r < 16; ++r) s[r] = 0.f;
#pragma unroll
        for (int kk = 0; kk < 4; ++kk) s = MFMA32(kf[kk], qf[kk], s);
        const bool diag = (key0 == t0);
        float sp[16], ls[16];
        float lo = 0.f, hi = 0.f;
#pragma unroll
        for (int r = 0; r < 16; ++r) {
            const int ko = (r < 8) ? (8 * hl + r) : (16 + 8 * hl + (r - 8));
            const float z = s[r];
            const float e = __builtin_amdgcn_exp2f(-fabsf(z));
            const float lg = __builtin_amdgcn_logf(1.0f + e);
            float spv = fmaxf(z, 0.f) + lg;
            float lsv = fminf(z, 0.f) - lg;
            if (diag && ko >= l31) { spv = 0.f; lsv = -1.0e30f; }
            sp[r] = spv; ls[r] = lsv;
            if (r < 8) lo += spv; else hi += spv;
        }
        const float plo = __shfl_xor(lo, 32), phi = __shfl_xor(hi, 32);
        const float after_lo = (hl == 0) ? (plo + hi + phi) : (hi + phi);
        const float after_hi = (hl == 0) ? phi : 0.f;
        float w[16];
        { float run = carry + after_lo;
#pragma unroll
          for (int r = 7; r >= 0; --r) { w[r] = __builtin_amdgcn_exp2f(ls[r] - run); run += sp[r]; } }
        { float run = carry + after_hi;
#pragma unroll
          for (int r = 15; r >= 8; --r) { w[r] = __builtin_amdgcn_exp2f(ls[r] - run); run += sp[r]; } }
        carry += (lo + hi) + (plo + phi);
        v4u w0, w1;
        w0.x = pk2(w[0], w[1]); w0.y = pk2(w[2], w[3]); w0.z = pk2(w[4], w[5]); w0.w = pk2(w[6], w[7]);
        w1.x = pk2(w[8], w[9]); w1.y = pk2(w[10], w[11]); w1.z = pk2(w[12], w[13]); w1.w = pk2(w[14], w[15]);
        const bf16x8 W0 = __builtin_bit_cast(bf16x8, w0), W1 = __builtin_bit_cast(bf16x8, w1);
        o0 = MFMA32(vf[0], W0, o0); o0 = MFMA32(vf[1], W1, o0);
        o1 = MFMA32(vf[2], W0, o1); o1 = MFMA32(vf[3], W1, o1);
        if (!more) break;
        if (__all(carry >= ATT_THR)) break;
#pragma unroll
        for (int kk = 0; kk < 4; ++kk) { kf[kk] = kn[kk]; vf[kk] = vn[kk]; }
        key0 = nk;
    }
    bf16* yrow = Y + (tb + t0 + l31) * 512 + h * 64 + 4 * hl;
#pragma unroll
    for (int a = 0; a < 4; ++a) {
        v2u p0, p1; p0.x = pk2(o0[4 * a], o0[4 * a + 1]); p0.y = pk2(o0[4 * a + 2], o0[4 * a + 3]); p1.x = pk2(o1[4 * a], o1[4 * a + 1]); p1.y = pk2(o1[4 * a + 2], o1[4 * a + 3]);
        *(GAS v2u*)(yrow + 8 * a) = p0; *(GAS v2u*)(yrow + 32 + 8 * a) = p1;
    }
}

__device__ __forceinline__ void pool_row(const bf16* __restrict__ U, bf16* __restrict__ P, int tok, int lane) {
    const int t = tok & (SEQ - 1); const int w = 2 << (lane >> 4);
    float sum[8], cur[8];
#pragma unroll
    for (int j = 0; j < 8; ++j) { sum[j] = 0.f; cur[j] = 0.f; }
#pragma unroll
    for (int j = 0; j < 16; ++j) {
        if (j < w && j <= t) {
            const v4u v = *(const GAS v4u*)(U + (size_t)(tok - j) * 512 + 8 * lane);
            const float f[8] = {bflo(v.x), bfhi(v.x), bflo(v.y), bfhi(v.y), bflo(v.z), bfhi(v.z), bflo(v.w), bfhi(v.w)};
#pragma unroll
            for (int q = 0; q < 8; ++q) { sum[q] += f[q]; if (j == 0) cur[q] = f[q]; }
        }
    }
    const int cnt = (t + 1) < w ? (t + 1) : w; const float inv = 1.0f / (float)cnt;
    v4u o; o.x = pk2(sum[0] * inv - cur[0], sum[1] * inv - cur[1]); o.y = pk2(sum[2] * inv - cur[2], sum[3] * inv - cur[3]);
    o.z = pk2(sum[4] * inv - cur[4], sum[5] * inv - cur[5]); o.w = pk2(sum[6] * inv - cur[6], sum[7] * inv - cur[7]);
    *(GAS v4u*)(P + (size_t)tok * 512 + 8 * lane) = o;
}

__device__ __forceinline__ void router_task(const bf16* __restrict__ X1, const bf16* __restrict__ WrF, const float* __restrict__ b_router, int T0, int lane,
                                            float* __restrict__ R2_, unsigned char* __restrict__ H2, int* __restrict__ TKE_, float* __restrict__ TKW_, LAS int* lds_e  ) {
    const int l31 = lane & 31, hl = lane >> 5;
    const bf16* xr = X1 + (size_t)(T0 + l31) * 1024 + 8 * hl;
    f32x16 acc;
#pragma unroll
    for (int r = 0; r < 16; ++r) acc[r] = 0.f;
    float ssq = 0.f;
#pragma unroll 8
    for (int kk = 0; kk < 64; ++kk) {
        const v4u xv = *(const GAS v4u*)(xr + 16 * kk);
        const bf16x8 ah = ldg16(WrF + ((size_t)kk * 64 + lane) * 8), al = ldg16(WrF + 32768 + ((size_t)kk * 64 + lane) * 8);
        const float f0 = bflo(xv.x), f1 = bfhi(xv.x), f2 = bflo(xv.y), f3 = bfhi(xv.y), f4 = bflo(xv.z), f5 = bfhi(xv.z), f6 = bflo(xv.w), f7 = bfhi(xv.w);
        ssq += (f0 * f0 + f1 * f1) + (f2 * f2 + f3 * f3) + (f4 * f4 + f5 * f5) + (f6 * f6 + f7 * f7);
        const bf16x8 xb = __builtin_bit_cast(bf16x8, xv);
        acc = MFMA32(ah, xb, acc); acc = MFMA32(al, xb, acc);
    }
    ssq += __shfl_xor(ssq, 32);
    const float r = 1.0f / sqrtf(ssq * (1.f / D) + EPS);
    {
        unsigned char* hr = H2 + (size_t)(T0 + l31) * 1024 + 8 * hl;
#pragma unroll 8
        for (int kk = 0; kk < 64; ++kk) { const v4u xv = *(const GAS v4u*)(xr + 16 * kk);
            v2u o; o.x = pk4_fp8(bflo(xv.x) * r, bfhi(xv.x) * r, bflo(xv.y) * r, bfhi(xv.y) * r); o.y = pk4_fp8(bflo(xv.z) * r, bfhi(xv.z) * r, bflo(xv.w) * r, bfhi(xv.w) * r);
            *(GAS v2u*)(hr + 16 * kk) = o; }
    }
    float v[16];
#pragma unroll
    for (int q = 0; q < 16; ++q) { const int e = 8 * (q >> 2) + 4 * hl + (q & 3); v[q] = acc[q] * r + b_router[e]; }
    float cv[8]; int ce[8];
#pragma unroll
    for (int k = 0; k < 4; ++k) {
        float best = -3.0e38f; int bi = 0;
#pragma unroll
        for (int q = 0; q < 16; ++q) { if (v[q] > best) { best = v[q]; bi = q; } }
        cv[k] = best; ce[k] = 8 * (bi >> 2) + 4 * hl + (bi & 3);
#pragma unroll
        for (int q = 0; q < 16; ++q) { if (q == bi) v[q] = -3.0e38f; }
    }
#pragma unroll
    for (int k = 0; k < 4; ++k) { cv[4 + k] = __shfl_xor(cv[k], 32); ce[4 + k] = __shfl_xor(ce[k], 32); }
    float tv[4]; int te[4];
#pragma unroll
    for (int k = 0; k < 4; ++k) {
        float best = -3.0e38f; int be = 1 << 20; int bi = 0;
#pragma unroll
        for (int q = 0; q < 8; ++q) { if (cv[q] > best || (cv[q] == best && ce[q] < be)) { best = cv[q]; be = ce[q]; bi = q; } }
        tv[k] = best; te[k] = be;
#pragma unroll
        for (int q = 0; q < 8; ++q) { if (q == bi) { cv[q] = -3.0e38f; ce[q] = 1 << 21; } }
    }
    const float p1 = __expf(tv[1] - tv[0]), p2 = __expf(tv[2] - tv[0]), p3 = __expf(tv[3] - tv[0]);
    const float inv = 1.0f / (1.0f + p1 + p2 + p3);
    if (hl == 0) {
        const int tok = T0 + l31;
        R2_[tok] = r;
        *(GAS v4i*)(TKE_ + (size_t)tok * 4) = (v4i){te[0], te[1], te[2], te[3]};
        *(GAS f32x4*)(TKW_ + (size_t)tok * 4) = (f32x4){inv, p1 * inv, p2 * inv, p3 * inv};
        lds_e[l31 * 4 + 0] = te[0]; lds_e[l31 * 4 + 1] = te[1]; lds_e[l31 * 4 + 2] = te[2]; lds_e[l31 * 4 + 3] = te[3];
    }
}


#define IN_(i) (args.in[i])
#define x_ IN_(0)
#define p_in IN_(1)
#define g_mix IN_(2)
#define w_in IN_(3)
#define w_pool_grp IN_(4)
#define pool_scale IN_(5)
#define w_pool_up IN_(6)
#define w_attn_up IN_(7)
#define w_out IN_(8)
#define g_ffn IN_(9)
#define w_router IN_(10)
#define b_router IN_(11)
#define w_gu IN_(12)
#define b_gu IN_(13)
#define w_down IN_(14)
#define b_down IN_(15)
#define g_ple IN_(16)
#define w_ple_gate IN_(17)
#define w_ple_proj IN_(18)
#define g_final IN_(19)
#define WSP(T, off) ((T*)(args.ws + (off)))
#define R2 WSP(float, WS_R2)
#define R3 WSP(float, WS_R3)
#define TKE WSP(int, WS_TKE)
#define TKW WSP(float, WS_TKW)
#define TKR WSP(int, WS_TKR)
#define ROWT WSP(int, WS_ROWT)
#define CNTWG WSP(int, WS_CNTWG)
#define SEGTOT WSP(int, WS_SEGTOT)
#define WRF WSP(bf16, WS_WRF)
#define WIN WSP(bf16, WS_WIN)
#define WEFF WSP(bf16, WS_WEFF)
#define WAU WSP(bf16, WS_WAU)
#define WOUT WSP(bf16, WS_WOUT)
#define WPG WSP(bf16, WS_WPG)
#define WPP WSP(bf16, WS_WPP)
#define WGU WSP(unsigned char, WS_WGU)
#define WDN WSP(unsigned char, WS_WDN)
#define H2F8 WSP(unsigned char, WS_H2F8)
#define TKS WSP(int, WS_TKS)
#define H1 WSP(bf16, WS_A)
#define MRG WSP(bf16, WS_A)
#define PPB WSP(bf16, WS_A)
#define UB WSP(bf16, WS_B)
#define QB WSP(bf16, WS_B + 64 * MiB)
#define X1 WSP(bf16, WS_B)
#define KB WSP(bf16, WS_C)
#define VT WSP(bf16, WS_C + 64 * MiB)
#define X2 WSP(bf16, WS_B)
#define POOL WSP(bf16, WS_E)
#define YATT WSP(bf16, WS_E + 64 * MiB)
#define X3 WSP(bf16, WS_E)
#define PB WSP(bf16, WS_PB)
#define GPB WSP(bf16, WS_G)
#define GAB WSP(bf16, WS_G + 128 * MiB)
#define ACT WSP(unsigned char, WS_G)

__global__ void __launch_bounds__(NWAVES * 64, 2) mk_fwd(Args args) {
    extern __shared__ __attribute__((aligned(16))) unsigned char lds[];
    Frame F;
    F.lds = (LAS unsigned char*)lds;
    F.MISC = (volatile LAS unsigned*)(F.lds + MISC_OFF);
    F.wave = __builtin_amdgcn_readfirstlane((int)threadIdx.x >> 6);
    F.G = gridDim.x; { const int bx = blockIdx.x; F.vcu = (F.G % 8 == 0) ? (bx % 8) * (F.G / 8) + bx / 8 : bx; }
    unsigned char* ws = args.ws;
    F.ctl = (gu32*)(ws + WS_CTL);
    for (int u = (int)threadIdx.x; u < (LDS_BYTES - LDSCTL_OFF) / 4; u += NWAVES * 64) ((LAS unsigned*)(F.lds + LDSCTL_OFF))[u] = 0u;
    __syncthreads();
    const int lo = args.ph_lo, hi = args.ph_hi;
    XcdBarrier bar; bar.bar = (unsigned*)(F.ctl + CW_BAR); bar.x = 0; bar.st = nullptr;
    if (hi - lo > 1) bar = xcd_barrier_post((unsigned*)(F.ctl + CW_BAR), F.MISC + 8, F.wave);
#define IN(k) (lo <= (k) && (k) < hi)
#define BOTH(k) (IN(k) && IN((k) + 1))
#define GRID_BAR() xcd_barrier(bar, F.wave)

    const int gw = F.vcu * NWAVES + F.wave, NGW = F.G * NWAVES;
    LAS int* ltab = (LAS int*)(F.lds + LDS_TAB_OFF);

    if (IN(0)) { for (int rep_ = 0; rep_ < REPS(0); ++rep_) {
        const int lane_ = lane_id_v(), tid_ = F.wave * 64 + lane_;
        LAS float* scr = (LAS float*)(F.lds + F.wave * 16384);
        constexpr int I_IN = 16 * 128, I_AU = 8 * 32, I_OUT = 16 * 32, I_PG = 16 * 32, I_PP = 4 * 32, I_GU = 32 * 16 * 64, I_DN = 32 * 16 * 32;
        constexpr int NITEMS = I_IN + I_AU + I_OUT + I_PG + I_PP + I_GU + I_DN;
        for (int it = gw; it < NITEMS; it += NGW) {
            int r = it;
            if (r < I_IN) { const int kb = r / 128, nb = r % 128, n0 = nb * 32;
                const int blk = n0 / 512; const int dst = (blk < 3) ? n0 : (blk == 3 ? 3584 + (n0 - 1536) : n0 - 512);
                p0_transpose_item<false>(w_in, 4096, kb * 64, n0, WIN, 1024, dst, nullptr, 1.0f, scr, lane_); continue; } r -= I_IN;
            if (r < I_AU) { const int kb = r / 32, nb = r % 32; p0_transpose_item<false>(w_attn_up, 1024, kb * 64, nb * 32, WAU, 512, nb * 32, nullptr, 1.0f, scr, lane_); continue; } r -= I_AU;
            if (r < I_OUT) { const int kb = r / 32, nb = r % 32; p0_transpose_item<false>(w_out, 1024, kb * 64, nb * 32, WOUT, 1024, nb * 32, nullptr, 1.0f, scr, lane_); continue; } r -= I_OUT;
            if (r < I_PG) { const int kb = r / 32, nb = r % 32; p0_transpose_item<false>(w_ple_gate, 1024, kb * 64, nb * 32, WPG, 1024, nb * 32, g_ple, 1.0f, scr, lane_); continue; } r -= I_PG;
            if (r < I_PP) { const int kb = r / 32, nb = r % 32; p0_transpose_item<false>(w_ple_proj, 1024, kb * 64, nb * 32, WPP, 256, nb * 32, nullptr, 1.0f, scr, lane_); continue; } r -= I_PP;
            if (r < I_GU) { const int e = r / 1024, q = r % 1024, kb = q / 64, nb = q % 64, n0 = nb * 32;
                const int j = n0 & 1023; const int dst = 256 * (j / 128) + (j % 128) + (n0 >= 1024 ? 128 : 0);
                p0_transpose_item<true>(w_gu + (size_t)e * 1024 * 2048, 2048, kb * 64, n0, WGU + (size_t)e * 2048 * 1024, 1024, dst, g_ffn, WSCALE, scr, lane_); continue; } r -= I_GU;
            { const int e = r / 512, q = r % 512, kb = q / 32, nb = q % 32;
                p0_transpose_item<true>(w_down + (size_t)e * 1024 * 1024, 1024, kb * 64, nb * 32, WDN + (size_t)e * 1024 * 1024, 1024, nb * 32, nullptr, WSCALE, scr, lane_); }
        }
        for (int it = gw; it < 4 * 16 * 16; it += NGW) {
            const int g = it >> 8, cb = (it >> 4) & 15, db = it & 15; const int d = db * 64 + lane_, c0 = cb * 8;
            float a8[8];
#pragma unroll
            for (int q = 0; q < 8; ++q) a8[q] = 0.f;
            for (int j = 0; j < 128; ++j) { const float wv = w_pool_up[(size_t)(g * 128 + j) * 1024 + d] * pool_scale[g * 128 + j];
#pragma unroll
                for (int q = 0; q < 8; ++q) a8[q] += w_pool_grp[(size_t)(g * 128 + c0 + q) * 128 + j] * wv; }
            v4u o; o.x = pk2(a8[0], a8[1]); o.y = pk2(a8[2], a8[3]); o.z = pk2(a8[4], a8[5]); o.w = pk2(a8[6], a8[7]);
            *(GAS v4u*)(WEFF + (size_t)d * 512 + g * 128 + c0) = o;
        }
        for (int it = gw * 64 + lane_; it < 64 * 64; it += NGW * 64) {
            const int kk = it >> 6, l = it & 63, e = l & 31, k0 = 16 * kk + 8 * (l >> 5);
            unsigned hb[8], lb[8];
#pragma unroll
            for (int i = 0; i < 8; ++i) { const float v = g_ffn[k0 + i] * w_router[(size_t)(k0 + i) * 32 + e]; hb[i] = f2bf(v); lb[i] = f2bf(v - __builtin_bit_cast(float, hb[i] << 16)); }
            v4u oh, ol; oh.x = hb[0] | (hb[1] << 16); oh.y = hb[2] | (hb[3] << 16); oh.z = hb[4] | (hb[5] << 16); oh.w = hb[6] | (hb[7] << 16);
            ol.x = lb[0] | (lb[1] << 16); ol.y = lb[2] | (lb[3] << 16); ol.z = lb[4] | (lb[5] << 16); ol.w = lb[6] | (lb[7] << 16);
            *(GAS v4u*)(WRF + (size_t)it * 8) = oh; *(GAS v4u*)(WRF + 32768 + (size_t)it * 8) = ol;
        }
        for (int m = gw; m < M; m += NGW) rms_row_f32_to_bf16(x_ + (size_t)m * D, g_mix, H1 + (size_t)m * D, lane_);
        for (size_t i = (size_t)gw * 64 + lane_; i < (size_t)M * PLE / 8; i += (size_t)NGW * 64) {
            const f32x4 a = *(const GAS f32x4*)(p_in + i * 8), b = *(const GAS f32x4*)(p_in + i * 8 + 4);
            *(GAS v4u*)(PB + i * 8) = pg8::pack8(a, b);
        }
        if (BOTH(0) || rep_ + 1 < REPS(0)) GRID_BAR();
    } }

    if (IN(1)) { for (int rep_ = 0; rep_ < REPS(1); ++rep_) {
        { pg8::Gemm g{H1, WIN, D}; pg8::StaticOrder S; S.init(M, NPROJ_A, F.G, (int)blockIdx.x);
          pg8::EpiProj E{UB, QB, KB, GPB, GAB};
          pg8::gemm_phase<pg8::EpiProj, pg8::StaticOrder, true>(F.lds, g, S, E, F.wave); }
        { pg8::Gemm g{WIN + (size_t)NPROJ_A * D, H1, D}; pg8::StaticOrder S; S.init(512, M, F.G, (int)blockIdx.x);
          pg8::EpiPlain E{VT, M};
          pg8::gemm_phase<pg8::EpiPlain, pg8::StaticOrder, true>(F.lds, g, S, E, F.wave); }
        if (BOTH(1) || rep_ + 1 < REPS(1)) GRID_BAR();
    } }

    if (IN(2)) { for (int rep_ = 0; rep_ < REPS(2); ++rep_) {
        const int lane_ = lane_id_v(), tid_ = F.wave * 64 + lane_;
        for (int T = gw; T < NB * NH * (SEQ / 32); T += NGW) {
            const int qb = T & 127, h = (T >> 7) & 7, b = T >> 10;
            attn_task(QB, KB, VT, YATT, b, h, qb, lane_);
        }
        for (int tok = gw; tok < M; tok += NGW) pool_row(UB, POOL, tok, lane_);
        if (BOTH(2) || rep_ + 1 < REPS(2)) GRID_BAR();
    } }

    if (IN(3)) { for (int rep_ = 0; rep_ < REPS(3); ++rep_) {
        pg8::Gemm g{POOL, WEFF, PW}; pg8::StaticOrder S; S.init(M, D, F.G, (int)blockIdx.x);
        pg8::EpiGate<false> E{MRG, GPB};
        pg8::gemm_phase<pg8::EpiGate<false>, pg8::StaticOrder, true>(F.lds, g, S, E, F.wave);
        if (BOTH(3) || rep_ + 1 < REPS(3)) GRID_BAR();
    } }
    if (IN(4)) {
        pg8::Gemm g{YATT, WAU, AW}; pg8::StaticOrder S; S.init(M, D, F.G, (int)blockIdx.x);
        pg8::EpiGate<true> E{MRG, GAB};
        pg8::gemm_phase<pg8::EpiGate<true>, pg8::StaticOrder, true>(F.lds, g, S, E, F.wave);
        if (BOTH(4)) GRID_BAR();
    }
    if (IN(5)) { for (int rep_ = 0; rep_ < REPS(5); ++rep_) {
        pg8::Gemm g{MRG, WOUT, D}; pg8::StaticOrder S; S.init(M, D, F.G, (int)blockIdx.x);
        pg8::EpiResid E{X1, x_};
        pg8::gemm_phase<pg8::EpiResid, pg8::StaticOrder, true>(F.lds, g, S, E, F.wave);
        if (BOTH(5) || rep_ + 1 < REPS(5)) GRID_BAR();
    } }

    if (IN(6)) { for (int rep_ = 0; rep_ < REPS(6); ++rep_) {
        const int lane_ = lane_id_v(), tid_ = F.wave * 64 + lane_;
        LAS int* lcnt = ltab;
        LAS int* le = ltab + 128;
        for (int chunk = F.vcu; chunk < M / 256; chunk += F.G) {
            if (tid_ < 128) lcnt[tid_] = 0;
            router_task(X1, WRF, b_router, chunk * 256 + F.wave * 32, lane_, R2, H2F8, TKE, TKW, le + F.wave * 128);
            __syncthreads();
            if (tid_ < 256) {
                const int tok = chunk * 256 + tid_; v4i rk;
#pragma unroll
                for (int k = 0; k < 4; ++k) rk[k] = __hip_atomic_fetch_add((int*)(lcnt + k * 32 + le[tid_ * 4 + k]), 1, __ATOMIC_RELAXED, __HIP_MEMORY_SCOPE_WORKGROUP);
                *(GAS v4i*)(TKR + (size_t)tok * 4) = rk;
            }
            __syncthreads();
            if (tid_ < 128) CNTWG[chunk * 128 + tid_] = lcnt[tid_];
            __syncthreads();
        }
        if (BOTH(6) || rep_ + 1 < REPS(6)) GRID_BAR();
    } }

    if (IN(7)) { for (int rep_ = 0; rep_ < REPS(7); ++rep_) {
        const int lane_ = lane_id_v(), tid_ = F.wave * 64 + lane_;
        LAS int* part = ltab;
        LAS int* tot = ltab + 1024;
        LAS int* below = ltab + 1152;
        LAS int* base = ltab + 1280;
        for (int chunk = F.vcu; chunk < M / 256; chunk += F.G) {
            { const int s = tid_ & 127, q = tid_ >> 7; int st = 0, sb = 0;
              for (int c2 = q * 64; c2 < q * 64 + 64; ++c2) { const int v = CNTWG[c2 * 128 + s]; st += v; sb += (c2 < chunk) ? v : 0; }
              part[(q * 128 + s) * 2] = st; part[(q * 128 + s) * 2 + 1] = sb; }
            __syncthreads();
            if (tid_ < 128) { int st = 0, sb = 0;
#pragma unroll
                for (int q = 0; q < 4; ++q) { st += part[(q * 128 + tid_) * 2]; sb += part[(q * 128 + tid_) * 2 + 1]; }
                tot[tid_] = st; below[tid_] = sb; }
            __syncthreads();
            if (tid_ < 128) { const int k = tid_ >> 5, e = tid_ & 31; int pre = 0;
                for (int e2 = 0; e2 < e; ++e2) pre += tot[k * 32 + e2];
                base[tid_] = k * M + pre + below[tid_];
                if (chunk == 0) SEGTOT[tid_] = tot[tid_]; }
            __syncthreads();
            if (tid_ < 256) { const int tok = chunk * 256 + tid_;
                const v4i te = *(const GAS v4i*)(TKE + (size_t)tok * 4), rk = *(const GAS v4i*)(TKR + (size_t)tok * 4); v4i sl;
#pragma unroll
                for (int k = 0; k < 4; ++k) { const int slot = base[k * 32 + te[k]] + rk[k]; ROWT[slot] = tok; sl[k] = slot - k * M; }
                *(GAS v4i*)(TKS + (size_t)tok * 4) = sl; }
            __syncthreads();
        }
        if (BOTH(7) || rep_ + 1 < REPS(7)) GRID_BAR();
    } }

    for (int k = 0; k < 4; ++k) {
        if (IN(8 + 2 * k) || IN(9 + 2 * k)) {
            const int tid_ = F.wave * 64 + lane_id_v();
            __syncthreads();
            if (tid_ < 32) {
                const int cn = SEGTOT[k * 32 + tid_]; int nt_ = (cn + 255) >> 8, pt = nt_, ps = cn;
#pragma unroll
                for (int o = 1; o < 32; o <<= 1) { const int a = __shfl_up(pt, o), b = __shfl_up(ps, o); if (tid_ >= o) { pt += a; ps += b; } }
                ltab[tid_] = pt - nt_; ltab[33 + tid_] = ps - cn; ltab[65 + tid_] = cn; if (tid_ == 31) ltab[32] = pt; }
            __syncthreads();
        }
        const int T = __builtin_amdgcn_readfirstlane(ltab[32]);
        if (IN(8 + 2 * k)) { for (int rep_ = 0; rep_ < REPS(8 + 2 * k); ++rep_) {
            pg8::Gemm g{H2F8, WGU, D};
            pg8::MoeOrder<true> S{ltab, ROWT + (size_t)k * M, WGU, 8, F.G, F.vcu, T * 8, (size_t)2048 * 1024};
            pg8::EpiMoe1 E{ACT, b_gu};
            pg8::gemm_phase<pg8::EpiMoe1, pg8::MoeOrder<true>, MOE_ALIGN, 1>(F.lds, g, S, E, F.wave);
            if (BOTH(8 + 2 * k) || rep_ + 1 < REPS(8 + 2 * k)) GRID_BAR();
        } }
        if (IN(9 + 2 * k)) { for (int rep_ = 0; rep_ < REPS(9 + 2 * k); ++rep_) {
            pg8::Gemm g{ACT, WDN, DE};
            pg8::MoeOrder<false> S{ltab, ROWT + (size_t)k * M, WDN, 4, F.G, F.vcu, T * 4, (size_t)1024 * 1024};
            pg8::EpiMoe2 E{WSP(bf16, k == 0 ? WS_A : (k == 1 ? WS_C : (k == 2 ? WS_E : WS_Y3))), b_down};
            pg8::gemm_phase<pg8::EpiMoe2, pg8::MoeOrder<false>, MOE_ALIGN, 1>(F.lds, g, S, E, F.wave);
            if (BOTH(9 + 2 * k) || rep_ + 1 < REPS(9 + 2 * k)) GRID_BAR();
        } }
    }

    if (IN(16)) { for (int rep_ = 0; rep_ < REPS(16); ++rep_) {
        const int lane_ = lane_id_v();
        for (int t0 = gw * 4; t0 < M; t0 += NGW * 4) {
            v4i sl[4]; f32x4 tw[4];
#pragma unroll
            for (int i = 0; i < 4; ++i) { sl[i] = *(const GAS v4i*)(TKS + (size_t)(t0 + i) * 4); tw[i] = *(const GAS f32x4*)(TKW + (size_t)(t0 + i) * 4); }
#pragma unroll
            for (int i = 0; i < 4; ++i) {
                bf16* xrow = X1 + (size_t)(t0 + i) * D;
                v4u xv[2], yv[4][2];
#pragma unroll
                for (int j = 0; j < 2; ++j) { xv[j] = ((const GAS v4u*)xrow)[64 * j + lane_];
                    yv[0][j] = ((const GAS v4u*)(WSP(bf16, WS_A) + (size_t)sl[i][0] * D))[64 * j + lane_]; yv[1][j] = ((const GAS v4u*)(WSP(bf16, WS_C) + (size_t)sl[i][1] * D))[64 * j + lane_];
                    yv[2][j] = ((const GAS v4u*)(WSP(bf16, WS_E) + (size_t)sl[i][2] * D))[64 * j + lane_]; yv[3][j] = ((const GAS v4u*)(WSP(bf16, WS_Y3) + (size_t)sl[i][3] * D))[64 * j + lane_]; }
                float s = 0.f;
#pragma unroll
                for (int j = 0; j < 2; ++j) { f32x4 a0, a1; pg8::unpack8(xv[j], a0, a1);
#pragma unroll
                    for (int k = 0; k < 4; ++k) { f32x4 y0, y1; pg8::unpack8(yv[k][j], y0, y1); a0 = a0 + y0 * tw[i][k]; a1 = a1 + y1 * tw[i][k]; }
                    const v4u o = pg8::pack8(a0, a1); f32x4 b0, b1; pg8::unpack8(o, b0, b1);
                    s += (b0[0] * b0[0] + b0[1] * b0[1]) + (b0[2] * b0[2] + b0[3] * b0[3]) + (b1[0] * b1[0] + b1[1] * b1[1]) + (b1[2] * b1[2] + b1[3] * b1[3]);
                    ((GAS v4u*)xrow)[64 * j + lane_] = o; }
                s = wave_sum(s);
                if (lane_ == 0) R3[t0 + i] = 1.0f / sqrtf(s * (1.f / D) + EPS);
            }
        }
        if (BOTH(16) || rep_ + 1 < REPS(16)) GRID_BAR();
    } }
    if (IN(17)) { for (int rep_ = 0; rep_ < REPS(17); ++rep_) {
        pg8::Gemm g{PB, WPP, PLE}; pg8::StaticOrder S; S.init(M, D, F.G, (int)blockIdx.x);
        pg8::EpiPlain E{PPB, D};
        pg8::gemm_phase<pg8::EpiPlain, pg8::StaticOrder, true>(F.lds, g, S, E, F.wave);
        if (BOTH(17) || rep_ + 1 < REPS(17)) GRID_BAR();
    } }
    if (IN(18)) { for (int rep_ = 0; rep_ < REPS(18); ++rep_) {
        pg8::Gemm g{X2, WPG, D}; pg8::StaticOrder S; S.init(M, D, F.G, (int)blockIdx.x);
        pg8::EpiPle E{X3, X2, PPB, R3};
        pg8::gemm_phase<pg8::EpiPle, pg8::StaticOrder, true>(F.lds, g, S, E, F.wave);
        if (BOTH(18) || rep_ + 1 < REPS(18)) GRID_BAR();
    } }
    if (IN(19)) { for (int rep_ = 0; rep_ < REPS(19); ++rep_) {
        const int lane_ = lane_id_v();
        for (int m = gw; m < M; m += NGW) {
            const GAS v4u* xr = (const GAS v4u*)(X3 + (size_t)m * D) + lane_; float f[2][8]; float s = 0.f;
#pragma unroll
            for (int j = 0; j < 2; ++j) { const v4u v = xr[64 * j]; f[j][0] = bflo(v.x); f[j][1] = bfhi(v.x); f[j][2] = bflo(v.y); f[j][3] = bfhi(v.y); f[j][4] = bflo(v.z); f[j][5] = bfhi(v.z); f[j][6] = bflo(v.w); f[j][7] = bfhi(v.w);
#pragma unroll
                for (int q = 0; q < 8; ++q) s += f[j][q] * f[j][q]; }
            s = wave_sum(s);
            const float r = 1.0f / sqrtf(s * (1.f / D) + EPS);
#pragma unroll
            for (int j = 0; j < 2; ++j) { const int c0 = (64 * j + lane_) * 8;
                const f32x4 g0 = *(const GAS f32x4*)(g_final + c0), g1 = *(const GAS f32x4*)(g_final + c0 + 4);
                f32x4 o0 = {f[j][0] * r * g0.x, f[j][1] * r * g0.y, f[j][2] * r * g0.z, f[j][3] * r * g0.w}, o1 = {f[j][4] * r * g1.x, f[j][5] * r * g1.y, f[j][6] * r * g1.z, f[j][7] * r * g1.w};
                *(GAS f32x4*)(args.out + (size_t)m * D + c0) = o0; *(GAS f32x4*)(args.out + (size_t)m * D + c0 + 4) = o1; }
        }
    } }
#undef IN
#undef BOTH
#undef GRID_BAR
}

extern "C" void kernel_launch(void* const* d_in, const int* in_sizes, int n_in, void* d_out, int out_size, void* d_ws, size_t ws_size, hipStream_t stream) {
    static int grid = 0;
    if (grid == 0) {
        if (n_in != 20 || out_size != M * D || ws_size < WS_END) { fprintf(stderr, "kernel_launch: unexpected shapes (n_in %d, out %d, ws %zu); nothing launched\n", n_in, out_size, ws_size); grid = -1; return; }
        int dev = 0, cus = 0, per_cu = 0;
        if (hipGetDevice(&dev) != hipSuccess || hipDeviceGetAttribute(&cus, hipDeviceAttributeMultiprocessorCount, dev) != hipSuccess) { grid = -1; return; }
        if (hipFuncSetAttribute((const void*)mk_fwd, hipFuncAttributeMaxDynamicSharedMemorySize, LDS_BYTES) != hipSuccess) { fprintf(stderr, "kernel_launch: hipFuncSetAttribute failed\n"); grid = -1; return; }
        if (hipOccupancyMaxActiveBlocksPerMultiprocessor(&per_cu, (const void*)mk_fwd, NWAVES * 64, LDS_BYTES) != hipSuccess || per_cu < 1)
            fprintf(stderr, "kernel_launch: note: occupancy query reports %d workgroups per CU\n", per_cu);
        (void)hipGetLastError();
        grid = cus;
    }
    if (grid < 0) return;
    if (hipMemsetAsync((char*)d_ws + WS_CTL, 0, CTL_ZERO_BYTES, stream) != hipSuccess) return;
    Args a{};
    for (int i = 0; i < 20; ++i) a.in[i] = (const float*)d_in[i];
    a.out = (float*)d_out; a.ws = (unsigned char*)d_ws;
#if MK_SPLIT
    for (int ph = 0; ph < NPH; ++ph) { a.ph_lo = ph; a.ph_hi = ph + 1; hipLaunchKernelGGL(mk_fwd, dim3(grid), dim3(NWAVES * 64), LDS_BYTES, stream, a); }
#else
    a.ph_lo = 0; a.ph_hi = NPH; hipLaunchKernelGGL(mk_fwd, dim3(grid), dim3(NWAVES * 64), LDS_BYTES, stream, a);
#endif
}
```

```cpp
#include <hip/hip_runtime.h>
#include <cstdio>
#include <cstdint>

#ifndef MK_SPLIT
#define MK_SPLIT 0
#endif

#ifndef MOE_ALIGN
#define MOE_ALIGN true
#endif
#ifndef REP_MASK
#define REP_MASK 0u
#endif
#define REPS(k) ((((REP_MASK) >> (k)) & 1u) ? 2 : 1)

#define GAS __attribute__((address_space(1)))
#define LAS __attribute__((address_space(3)))
typedef unsigned short bf16;
typedef unsigned v4u __attribute__((ext_vector_type(4)));
typedef unsigned v2u __attribute__((ext_vector_type(2)));
typedef int v4i __attribute__((ext_vector_type(4)));
typedef float f32x2 __attribute__((ext_vector_type(2)));
typedef float f32x4 __attribute__((ext_vector_type(4)));
typedef float f32x16 __attribute__((ext_vector_type(16)));
typedef short bf16x8 __attribute__((ext_vector_type(8)));
typedef __bf16 bf16x2_t __attribute__((ext_vector_type(2)));
typedef GAS unsigned gu32;

constexpr int NB = 16, SEQ = 4096, M = NB * SEQ, D = 1024, NH = 8, HD = 64, PW = 512, AW = 512, NE = 32, TOPK = 4, DE = 1024, PLE = 256;
constexpr int NPROJ_A = 3584;
constexpr float EPS = 1e-6f;
constexpr float LOG2E = 1.4426950408889634f;
constexpr float QSCALE = 0.125f * LOG2E;
constexpr float WSCALE = 64.0f, WSCALE_INV = 1.0f / 64.0f;
constexpr float ATT_THR = 152.0f;
constexpr int NWAVES = 8;
constexpr int NPH = 20;

constexpr size_t MiB = 1u << 20;
constexpr size_t WS_CTL = 0, CTL_ZERO_BYTES = 1 * MiB;
constexpr size_t WS_R2 = 1 * MiB;
constexpr size_t WS_R3 = WS_R2 + 256 * 1024;
constexpr size_t WS_TKE = 2 * MiB;
constexpr size_t WS_TKW = 3 * MiB;
constexpr size_t WS_TKR = 4 * MiB;
constexpr size_t WS_TKS = 13 * MiB;
constexpr size_t WS_ROWT = 5 * MiB;
constexpr size_t WS_CNTWG = 11 * MiB;
constexpr size_t WS_SEGTOT = WS_CNTWG + 256 * 1024;
constexpr size_t WS_WRF = 12 * MiB;
constexpr size_t WS_WIN = 16 * MiB;
constexpr size_t WS_WEFF = 24 * MiB;
constexpr size_t WS_WAU = 25 * MiB;
constexpr size_t WS_WOUT = 26 * MiB;
constexpr size_t WS_WPG = 28 * MiB;
constexpr size_t WS_WPP = 30 * MiB;
constexpr size_t WS_WGU = 32 * MiB;
constexpr size_t WS_WDN = 96 * MiB;
constexpr size_t WS_H2F8 = 128 * MiB;
constexpr size_t WS_A = 224 * MiB;
constexpr size_t WS_B = 352 * MiB;
constexpr size_t WS_C = 480 * MiB;
constexpr size_t WS_E = 608 * MiB;
constexpr size_t WS_PB = 736 * MiB;
constexpr size_t WS_G = 768 * MiB;
constexpr size_t WS_Y3 = 896 * MiB;
constexpr size_t WS_END = 1024 * MiB;
constexpr int CW_BAR = 4096;

constexpr int RING_BYTES = 131072;
constexpr int LDSCTL_OFF = RING_BYTES, MISC_OFF = LDSCTL_OFF + 320;
constexpr int LDS_TAB_OFF = MISC_OFF + 128;
constexpr int LDS_BYTES = 147456;

#define RLX_AGENT __ATOMIC_RELAXED, __HIP_MEMORY_SCOPE_AGENT
#define LDS_WAIT() asm volatile("s_waitcnt lgkmcnt(0)" ::: "memory")
#define VM_WAIT() asm volatile("s_waitcnt vmcnt(0)" ::: "memory")

__device__ __forceinline__ int lane_id_v() { int l; asm volatile("v_mbcnt_lo_u32_b32 %0, -1, 0\n\tv_mbcnt_hi_u32_b32 %0, -1, %0" : "=v"(l)); return l; }
__device__ __forceinline__ unsigned f2bf(float f) { unsigned u = __builtin_bit_cast(unsigned, f); return (u + 0x7fffu + ((u >> 16) & 1u)) >> 16; }
__device__ __forceinline__ unsigned pk2(float lo, float hi) { f32x2 v = {lo, hi}; bf16x2_t b = __builtin_convertvector(v, bf16x2_t); return __builtin_bit_cast(unsigned, b); }
__device__ __forceinline__ unsigned pk4_fp8(float a, float b, float c, float d) { int r = __builtin_amdgcn_cvt_pk_fp8_f32(a, b, 0, false); r = __builtin_amdgcn_cvt_pk_fp8_f32(c, d, r, true); return (unsigned)r; }
__device__ __forceinline__ float bflo(unsigned u) { return __builtin_bit_cast(float, u << 16); }
__device__ __forceinline__ float bfhi(unsigned u) { return __builtin_bit_cast(float, u & 0xffff0000u); }
__device__ __forceinline__ float fast_sigmoid(float v) { return __builtin_amdgcn_rcpf(1.0f + __builtin_amdgcn_exp2f(-LOG2E * v)); }
__device__ __forceinline__ float wave_sum(float v) {
#pragma unroll
    for (int o = 1; o < 64; o <<= 1) v += __shfl_xor(v, o);
    return v;
}

#define XB_TMO      128
#define XB_XCNT(j)  (256  + 64 * (j))
#define XB_XSUB(j)  (1280 + 64 * (j))
#define XB_XGEN(j)  (2304 + 64 * (j))
#define XB_TOP      3328
#define XB_TOPGEN   3392
#define XCD_BAR_WORDS 3456
#define XB_SPIN_CAP (1u << 18)
__device__ __forceinline__ unsigned xb_ld(unsigned* p)              { return __hip_atomic_load(p, __ATOMIC_RELAXED, __HIP_MEMORY_SCOPE_AGENT); }
__device__ __forceinline__ unsigned xb_add(unsigned* p, unsigned v) { return __hip_atomic_fetch_add(p, v, __ATOMIC_RELAXED, __HIP_MEMORY_SCOPE_AGENT); }
__device__ __forceinline__ unsigned xb_xcc_id() { return (unsigned)__builtin_amdgcn_s_getreg((3 << 11) | 20) & 0xFu; }
#define XB_SPIN(cond, bar) do { unsigned _sp = 0; while (cond) { __builtin_amdgcn_s_sleep(1); \
    if ((++_sp & 255u) == 0u) { if (xb_ld(&(bar)[XB_TMO])) break; if (_sp > XB_SPIN_CAP) { atomicAdd(&(bar)[XB_TMO], 1u); break; } } } } while (0)
struct XcdBarrier { unsigned* bar; unsigned x; volatile LAS unsigned* st; };
__device__ __forceinline__ XcdBarrier xcd_barrier_post(unsigned* bar, volatile LAS unsigned* st, int wave) {
    XcdBarrier b; b.bar = bar; b.x = xb_xcc_id(); b.st = st;
    if (wave == 0 && lane_id_v() == 0) (void)xb_add(&bar[XB_XCNT(b.x)], 1u);
    return b;
}
__device__ __forceinline__ void xcd_barrier_complete(unsigned* bar, unsigned x, unsigned& nloc, unsigned& nx) {
    const unsigned G = gridDim.x * gridDim.y * gridDim.z;
    unsigned sum, cnt, mine, sp = 0u;
    for (;;) {
        sum = 0u; cnt = 0u; mine = 0u;
#pragma unroll
        for (unsigned j = 0; j < 16; ++j) { const unsigned c = xb_ld(&bar[XB_XCNT(j)]); sum += c; cnt += (c > 0u) ? 1u : 0u; mine = (j == x) ? c : mine; }
        if (sum == G) break;
        __builtin_amdgcn_s_sleep(1);
        if ((++sp & 255u) == 0u) { if (xb_ld(&bar[XB_TMO])) break; if (sp > XB_SPIN_CAP) { atomicAdd(&bar[XB_TMO], 1u); break; } }
    }
    nloc = mine > 0u ? mine : 1u; nx = cnt > 0u ? cnt : 1u;
}
__device__ __forceinline__ void xcd_barrier(const XcdBarrier& b, int wave) {
    asm volatile("s_waitcnt vmcnt(0)" ::: "memory");
    __syncthreads();
    if (wave == 0 && lane_id_v() == 0) {
        unsigned* bar = b.bar;
        __builtin_amdgcn_s_waitcnt(0);
        unsigned nloc = b.st[0], nx = b.st[1];
        if (nloc == 0u) { xcd_barrier_complete(bar, b.x, nloc, nx); b.st[0] = nloc; b.st[1] = nx; }
        const unsigned old = xb_add(&bar[XB_XSUB(b.x)], 1u);
        const unsigned gen = old / nloc;
        if (old + 1u == (gen + 1u) * nloc) {
            __builtin_amdgcn_fence(__ATOMIC_RELEASE, "agent");
            asm volatile("s_waitcnt vmcnt(0)" ::: "memory");
            const unsigned og = xb_add(&bar[XB_TOP], 1u);
            const unsigned tg = og / nx;
            if (og + 1u == (tg + 1u) * nx) xb_add(&bar[XB_TOPGEN], 1u);
            else XB_SPIN(xb_ld(&bar[XB_TOPGEN]) == tg, bar);
            __builtin_amdgcn_fence(__ATOMIC_ACQUIRE, "agent");
            xb_add(&bar[XB_XGEN(b.x)], 1u);
            asm volatile("s_waitcnt vmcnt(0)" ::: "memory");
        } else {
            XB_SPIN(xb_ld(&bar[XB_XGEN(b.x)]) == gen, bar);
            __builtin_amdgcn_fence(__ATOMIC_ACQUIRE, "agent");
            asm volatile("s_waitcnt vmcnt(0)" ::: "memory");
        }
    }
    __syncthreads();
}

namespace pg8 {
constexpr int BM = 256, BK = 64, HALF = 128, HTB = HALF * BK * 2, NXCD = 8, WGM = 8;
__host__ __device__ __forceinline__ int lds_byte(int r, int c) { const int st = (r >> 4) * 2 + (c >> 5), rr = r & 15, cc = c & 31, ob = rr * 64 + cc * 2; return st * 1024 + (ob ^ (((ob >> 9) & 1) << 5)); }
__host__ __device__ __forceinline__ void stage_rc(int b, int& R, int& C) { const int st = b / 1024, sb = b % 1024, swz = sb ^ (((sb >> 9) & 1) << 5); R = (st >> 1) * 16 + swz / 64; C = (st & 1) * 32 + (swz % 64) / 2; }
__host__ __device__ __forceinline__ int perm32(int rho) { const int n = rho >> 4, i = rho & 15; return 8 * (i >> 2) + 4 * n + (i & 3); }

typedef int v8i __attribute__((ext_vector_type(8)));
typedef int v4i_ __attribute__((ext_vector_type(4)));
__device__ __forceinline__ v8i cat8(const bf16x8 a, const bf16x8 b) { const v4i_ x = __builtin_bit_cast(v4i_, a), y = __builtin_bit_cast(v4i_, b); return __builtin_shufflevector(x, y, 0, 1, 2, 3, 4, 5, 6, 7); }
struct Unit { int pm, pn, e, row0, nvalid; };
struct Gemm { const void* A; const void* Bt; int K; };

struct StaticOrder {
    int nM, nN, nwg, G, c;
    __device__ void init(int Mr, int N, int G_, int c_) { nM = Mr / BM; nN = N / BM; nwg = nM * nN; G = G_; c = c_; }
    __device__ __forceinline__ bool next(int i, Unit& u) const {
        const long L = (long)i * G + c; if (L >= nwg) return false;
        int wgid = (int)L; { const int q = nwg / NXCD, r = nwg % NXCD, xcd = wgid % NXCD, off = wgid / NXCD; wgid = (xcd < r ? xcd * (q + 1) : r * (q + 1) + (xcd - r) * q) + off; }
        const int nig = WGM * nN, gid = wgid / nig, fm = gid * WGM, gsz = (nM - fm) < WGM ? (nM - fm) : WGM;
        u.pm = fm + ((wgid % nig) % gsz); u.pn = (wgid % nig) / gsz; u.e = 0; u.row0 = u.pm * BM; u.nvalid = BM; return true;
    }
    __device__ __forceinline__ void a_off(const Unit& u, int tid, int pitchB, unsigned (&va)[2][2]) const {
#pragma unroll
        for (int i = 0; i < 2; ++i) { int R, C; stage_rc(tid * 16 + i * 8192, R, C);
#pragma unroll
            for (int h = 0; h < 2; ++h) va[h][i] = (unsigned)((u.pm * BM + h * HALF + R) * pitchB + C * 2); }
    }
    __device__ __forceinline__ const char* b_ptr(const Unit& u, const Gemm& g, int pitchB) const { return (const char*)g.Bt + (size_t)u.pn * BM * pitchB; }
};

template <class Epi, class Sched, bool ALIGN_EPI, int ES = 2>
__device__ __forceinline__ void gemm_phase(LAS unsigned char* lds, const Gemm g, const Sched& S, const Epi& E, const int wid) {
    const int lane = lane_id_v(), tid = wid * 64 + lane, wr = wid >> 2, wc = wid & 3, fr = lane & 15, fq = lane >> 4;
    const int K = g.K, pitchB = K * ES; int nt = pitchB / 128;
    asm volatile("" : "+s"(nt));
    unsigned voffB[2];
#pragma unroll
    for (int i = 0; i < 2; ++i) { int R, C; stage_rc(tid * 16 + i * 8192, R, C); const int Rb = Epi::PERM ? ((R & ~31) + perm32(R & 31)) : R;
        voffB[i] = (unsigned)(Rb * pitchB + C * 2); }
    const size_t kstep = (size_t)(BK * 2);
    const size_t hstep = (size_t)HALF * pitchB;
    const unsigned ldsw = (unsigned)wid * 1024u;
    const int aoff = lds_byte(wr * 64 + fr, fq * 8), boff = lds_byte(wc * 32 + fr, fq * 8);
#define PG8_SA(b, h) (((b) * 2 + (h)) * HTB)
#define PG8_SB(b, h) ((4 + (b) * 2 + (h)) * HTB)
#define PG8_STAGE(bufoff, gbase, voff) do { _Pragma("unroll") for (int _i = 0; _i < 2; ++_i) \
        __builtin_amdgcn_global_load_lds((const unsigned*)((const char*)(gbase) + (voff)[_i]), (LAS unsigned*)(lds + (bufoff) + ldsw + _i * 8192), 16, 0, 0); } while (0)
#define PG8_LDA(dst, b, h) do { _Pragma("unroll") for (int m = 0; m < 4; ++m) _Pragma("unroll") for (int k = 0; k < 2; ++k) dst[m][k] = *(const LAS bf16x8*)(lds + PG8_SA(b, h) + aoff + m * 2048 + k * 1024); } while (0)
#define PG8_LDB(dst, b, h) do { _Pragma("unroll") for (int n = 0; n < 2; ++n) _Pragma("unroll") for (int k = 0; k < 2; ++k) dst[n][k] = *(const LAS bf16x8*)(lds + PG8_SB(b, h) + boff + n * 2048 + k * 1024); } while (0)
#define PG8_MMA(ai, bj, At, Bt) do { __builtin_amdgcn_s_setprio(1); _Pragma("unroll") for (int m = 0; m < 4; ++m) _Pragma("unroll") for (int n = 0; n < 2; ++n) { \
        if constexpr (ES == 2) { _Pragma("unroll") for (int k = 0; k < 2; ++k) acc[ai][bj][m][n] = __builtin_amdgcn_mfma_f32_16x16x32_bf16(Bt[n][k], At[m][k], acc[ai][bj][m][n], 0, 0, 0); } \
        else { const v8i a8_ = cat8(Bt[n][0], Bt[n][1]), b8_ = cat8(At[m][0], At[m][1]); \
               if (m == 0 && n == 0) asm volatile("s_nop 1\n\tv_mfma_f32_16x16x128_f8f6f4 %0, %1, %2, %0" : "+v"(acc[ai][bj][m][n]) : "v"(a8_), "v"(b8_)); \
               else asm volatile("v_mfma_f32_16x16x128_f8f6f4 %0, %1, %2, %0" : "+v"(acc[ai][bj][m][n]) : "v"(a8_), "v"(b8_)); } } \
        __builtin_amdgcn_s_setprio(0); } while (0)
#define PG8_WAIT_V(n) asm volatile("s_waitcnt vmcnt(" #n ")" ::: "memory")
#define PG8_WAIT_L(n) asm volatile("s_waitcnt lgkmcnt(" #n ")" ::: "memory")
#define PG8_BAR __builtin_amdgcn_s_barrier()
#define PG8_SCHED __builtin_amdgcn_sched_barrier(0)
    Unit cur, nxt; int ui = 0;
    if (!S.next(0, cur)) return;
    f32x4 acc[2][2][4][2];
#pragma unroll
    for (int a = 0; a < 2; ++a)
#pragma unroll
        for (int b = 0; b < 2; ++b)
#pragma unroll
            for (int m = 0; m < 4; ++m)
#pragma unroll
                for (int n = 0; n < 2; ++n) acc[a][b][m][n] = (f32x4){0.f, 0.f, 0.f, 0.f};
    bf16x8 At[4][2], B0[2][2], B1[2][2];
    unsigned cva[2][2], nva[2][2];
    S.a_off(cur, tid, pitchB, cva);
    const char* const Ab = (const char*)g.A;
    const char* cB = S.b_ptr(cur, g, pitchB);
    PG8_STAGE(PG8_SB(0, 0), cB, voffB); PG8_STAGE(PG8_SB(0, 1), cB + hstep, voffB); PG8_STAGE(PG8_SA(0, 0), Ab, cva[0]); PG8_STAGE(PG8_SA(0, 1), Ab, cva[1]);
    if (wr == 1) PG8_BAR;
    PG8_WAIT_V(2); PG8_BAR;
    PG8_STAGE(PG8_SB(1, 0), cB + kstep, voffB); PG8_STAGE(PG8_SA(1, 0), Ab + kstep, cva[0]); PG8_STAGE(PG8_SB(1, 1), cB + hstep + kstep, voffB);
    PG8_WAIT_V(6); PG8_BAR;
    for (;;) {
        const bool has_next = S.next(ui + 1, nxt);
        const char* nB = cB;
        if (has_next) { S.a_off(nxt, tid, pitchB, nva); nB = S.b_ptr(nxt, g, pitchB); }
        else {
#pragma unroll
            for (int h = 0; h < 2; ++h)
#pragma unroll
                for (int i = 0; i < 2; ++i) nva[h][i] = cva[h][i];
        }
#pragma nounroll
        for (int t = 0; t < nt; t += 2) {
            const bool last = (t == nt - 2);
            const char* Abt = Ab; asm volatile("" : "+s"(Abt));
            const char* a1 = Abt + (size_t)(t + 1) * kstep;
            const char* a2 = last ? Abt : Abt + (size_t)(t + 2) * kstep; const char* b2 = last ? nB : cB + (size_t)(t + 2) * kstep;
            const char* a3 = a2 + kstep; const char* b3 = b2 + kstep;
            unsigned va2[2][2];
#pragma unroll
            for (int h = 0; h < 2; ++h)
#pragma unroll
                for (int i = 0; i < 2; ++i) va2[h][i] = last ? nva[h][i] : cva[h][i];
            PG8_LDB(B0, 0, 0); PG8_LDB(B1, 0, 1); PG8_SCHED; PG8_LDA(At, 0, 0); PG8_STAGE(PG8_SA(1, 1), a1, cva[1]);
            PG8_WAIT_V(8); PG8_WAIT_L(0); PG8_BAR; PG8_MMA(0, 0, At, B0); PG8_MMA(0, 1, At, B1); PG8_BAR; PG8_SCHED;
            PG8_LDA(At, 0, 1); PG8_STAGE(PG8_SB(0, 0), b2, voffB); PG8_STAGE(PG8_SB(0, 1), b2 + hstep, voffB); PG8_STAGE(PG8_SA(0, 0), a2, va2[0]);
            PG8_WAIT_V(8); PG8_WAIT_L(0); PG8_BAR; PG8_MMA(1, 0, At, B0); PG8_MMA(1, 1, At, B1); PG8_BAR; PG8_SCHED;
            PG8_LDB(B0, 1, 0); PG8_LDB(B1, 1, 1); PG8_SCHED; PG8_LDA(At, 1, 0); PG8_STAGE(PG8_SA(0, 1), a2, va2[1]);
            PG8_WAIT_V(8); PG8_WAIT_L(0); PG8_BAR; PG8_MMA(0, 0, At, B0); PG8_MMA(0, 1, At, B1); PG8_BAR; PG8_SCHED;
            PG8_LDA(At, 1, 1); PG8_STAGE(PG8_SB(1, 0), b3, voffB); PG8_STAGE(PG8_SB(1, 1), b3 + hstep, voffB); PG8_STAGE(PG8_SA(1, 0), a3, va2[0]);
            PG8_WAIT_V(8); PG8_WAIT_L(0); PG8_BAR; PG8_MMA(1, 0, At, B0); PG8_MMA(1, 1, At, B1); PG8_BAR; PG8_SCHED;
        }
        if constexpr (ALIGN_EPI) { if (wr == 0) PG8_BAR; }
        if constexpr (ES == 1) asm volatile("s_nop 11");
        E(acc, cur, wr, wc, fr, fq);
        if (!has_next) break;
#pragma unroll
        for (int a = 0; a < 2; ++a)
#pragma unroll
            for (int b = 0; b < 2; ++b)
#pragma unroll
                for (int m = 0; m < 4; ++m)
#pragma unroll
                    for (int n = 0; n < 2; ++n) acc[a][b][m][n] = (f32x4){0.f, 0.f, 0.f, 0.f};
        cur = nxt; cB = nB; ++ui;
#pragma unroll
        for (int h = 0; h < 2; ++h)
#pragma unroll
            for (int i = 0; i < 2; ++i) cva[h][i] = nva[h][i];
        if constexpr (ALIGN_EPI) { if (wr == 1) PG8_BAR; }
    }
    PG8_WAIT_V(0);
    if constexpr (!ALIGN_EPI) { if (wr == 0) PG8_BAR; }
    PG8_BAR;
#undef PG8_SA
#undef PG8_SB
#undef PG8_STAGE
#undef PG8_LDA
#undef PG8_LDB
#undef PG8_MMA
#undef PG8_WAIT_V
#undef PG8_WAIT_L
#undef PG8_BAR
#undef PG8_SCHED
}

__device__ __forceinline__ v4u pack8(const f32x4 a, const f32x4 b) { v4u w; w.x = pk2(a[0], a[1]); w.y = pk2(a[2], a[3]); w.z = pk2(b[0], b[1]); w.w = pk2(b[2], b[3]); return w; }
__device__ __forceinline__ void unpack8(const v4u w, f32x4& a, f32x4& b) { a = (f32x4){bflo(w.x), bfhi(w.x), bflo(w.y), bfhi(w.y)}; b = (f32x4){bflo(w.z), bfhi(w.z), bflo(w.w), bfhi(w.w)}; }

struct EpiPlain {
    static constexpr bool PERM = true;
    bf16* O; int ldc;
    __device__ __forceinline__ void operator()(const f32x4 (&acc)[2][2][4][2], const Unit& u, int wr, int wc, int fr, int fq) const {
        const int row0 = u.pm * BM + wr * 64 + fr, col0 = u.pn * BM + wc * 32 + 8 * fq;
#pragma unroll
        for (int ai = 0; ai < 2; ++ai)
#pragma unroll
            for (int m = 0; m < 4; ++m) { bf16* rowp = O + (size_t)(row0 + ai * HALF + m * 16) * ldc + col0;
#pragma unroll
                for (int bj = 0; bj < 2; ++bj) *(GAS v4u*)(rowp + bj * HALF) = pack8(acc[ai][bj][m][0], acc[ai][bj][m][1]); }
    }
};
struct EpiProj {
    static constexpr bool PERM = true;
    bf16 *U, *Q, *Kb, *GP, *GA;
    __device__ __forceinline__ void operator()(const f32x4 (&acc)[2][2][4][2], const Unit& u, int wr, int wc, int fr, int fq) const {
        const int pn = u.pn; bf16* base; int ldc, colt; float sc = 1.f; bool sig = false;
        if (pn < 2) { base = U; ldc = 512; colt = pn * 256; }
        else if (pn < 4) { base = Q; ldc = 512; colt = (pn - 2) * 256; sc = QSCALE; }
        else if (pn < 6) { base = Kb; ldc = 512; colt = (pn - 4) * 256; }
        else if (pn < 10) { base = GP; ldc = 1024; colt = (pn - 6) * 256; sig = true; }
        else { base = GA; ldc = 1024; colt = (pn - 10) * 256; sig = true; }
        const int row0 = u.pm * BM + wr * 64 + fr, col0 = colt + wc * 32 + 8 * fq;
#pragma unroll
        for (int ai = 0; ai < 2; ++ai)
#pragma unroll
            for (int m = 0; m < 4; ++m) { bf16* rowp = base + (size_t)(row0 + ai * HALF + m * 16) * ldc + col0;
#pragma unroll
                for (int bj = 0; bj < 2; ++bj) { f32x4 v0 = acc[ai][bj][m][0], v1 = acc[ai][bj][m][1];
                    if (sig) {
#pragma unroll
                        for (int j = 0; j < 4; ++j) { v0[j] = fast_sigmoid(v0[j]); v1[j] = fast_sigmoid(v1[j]); }
                    } else { v0 = v0 * sc; v1 = v1 * sc; }
                    *(GAS v4u*)(rowp + bj * HALF) = pack8(v0, v1); } }
    }
};
template <bool ADD> struct EpiGate {
    static constexpr bool PERM = true;
    bf16* O; const bf16* G;
    __device__ __forceinline__ void operator()(const f32x4 (&acc)[2][2][4][2], const Unit& u, int wr, int wc, int fr, int fq) const {
        const int row0 = u.pm * BM + wr * 64 + fr, col0 = u.pn * BM + wc * 32 + 8 * fq;
#pragma unroll
        for (int ai = 0; ai < 2; ++ai)
#pragma unroll
            for (int m = 0; m < 4; ++m) { const size_t ro = (size_t)(row0 + ai * HALF + m * 16) * 1024 + col0;
#pragma unroll
                for (int bj = 0; bj < 2; ++bj) { f32x4 g0, g1; unpack8(*(const GAS v4u*)(G + ro + bj * HALF), g0, g1);
                    f32x4 v0 = acc[ai][bj][m][0] * g0, v1 = acc[ai][bj][m][1] * g1;
                    if (ADD) { f32x4 o0, o1; unpack8(*(const GAS v4u*)(O + ro + bj * HALF), o0, o1); v0 = v0 + o0; v1 = v1 + o1; }
                    *(GAS v4u*)(O + ro + bj * HALF) = pack8(v0, v1); } }
    }
};
struct EpiResid {
    static constexpr bool PERM = true;
    bf16* O; const float* X;
    __device__ __forceinline__ void operator()(const f32x4 (&acc)[2][2][4][2], const Unit& u, int wr, int wc, int fr, int fq) const {
        const int row0 = u.pm * BM + wr * 64 + fr, col0 = u.pn * BM + wc * 32 + 8 * fq;
#pragma unroll
        for (int ai = 0; ai < 2; ++ai)
#pragma unroll
            for (int m = 0; m < 4; ++m) { const size_t ro = (size_t)(row0 + ai * HALF + m * 16) * 1024 + col0;
#pragma unroll
                for (int bj = 0; bj < 2; ++bj) { const f32x4 x0 = *(const GAS f32x4*)(X + ro + bj * HALF), x1 = *(const GAS f32x4*)(X + ro + bj * HALF + 4);
                    *(GAS v4u*)(O + ro + bj * HALF) = pack8(acc[ai][bj][m][0] + x0, acc[ai][bj][m][1] + x1); } }
    }
};
struct EpiPle {
    static constexpr bool PERM = true;
    bf16* O; const bf16* X2; const bf16* PP; const float* R3;
    __device__ __forceinline__ void operator()(const f32x4 (&acc)[2][2][4][2], const Unit& u, int wr, int wc, int fr, int fq) const {
        const int row0 = u.pm * BM + wr * 64 + fr, col0 = u.pn * BM + wc * 32 + 8 * fq;
#pragma unroll
        for (int ai = 0; ai < 2; ++ai)
#pragma unroll
            for (int m = 0; m < 4; ++m) { const int row = row0 + ai * HALF + m * 16; const size_t ro = (size_t)row * 1024 + col0; const float r = R3[row];
#pragma unroll
                for (int bj = 0; bj < 2; ++bj) { f32x4 x0, x1, p0, p1; unpack8(*(const GAS v4u*)(X2 + ro + bj * HALF), x0, x1); unpack8(*(const GAS v4u*)(PP + ro + bj * HALF), p0, p1);
                    f32x4 v0, v1;
#pragma unroll
                    for (int j = 0; j < 4; ++j) { v0[j] = x0[j] + fast_sigmoid(r * acc[ai][bj][m][0][j]) * p0[j]; v1[j] = x1[j] + fast_sigmoid(r * acc[ai][bj][m][1][j]) * p1[j]; }
                    *(GAS v4u*)(O + ro + bj * HALF) = pack8(v0, v1); } }
    }
};

template <bool GATHER> struct MoeOrder {
    const LAS int* tab; const int* row_token; const unsigned char* W; int NT, G, c, total; size_t wstride;
    __device__ __forceinline__ bool next(int i, Unit& u) const {
        const long L = (long)i * G + c; if (L >= total) return false;
        const int rt = (int)(L / NT); u.pn = (int)(L % NT);
        int e = 0;
#pragma unroll
        for (int j = 1; j < 32; ++j) e += (tab[j] <= rt) ? 1 : 0;
        e = __builtin_amdgcn_readfirstlane(e);
        const int lt = rt - __builtin_amdgcn_readfirstlane(tab[e]), cn = __builtin_amdgcn_readfirstlane(tab[65 + e]);
        u.e = e; u.pm = rt; u.row0 = __builtin_amdgcn_readfirstlane(tab[33 + e]) + lt * 256; u.nvalid = (cn - lt * 256) < 256 ? (cn - lt * 256) : 256; return true;
    }
    __device__ __forceinline__ void a_off(const Unit& u, int tid, int pitchB, unsigned (&va)[2][2]) const {
        int R[2], C[2];
#pragma unroll
        for (int i = 0; i < 2; ++i) stage_rc(tid * 16 + i * 8192, R[i], C[i]);
        if constexpr (GATHER) {
            int tok[2][2];
#pragma unroll
            for (int i = 0; i < 2; ++i)
#pragma unroll
                for (int h = 0; h < 2; ++h) { const int rl = h * HALF + R[i]; tok[h][i] = row_token[u.row0 + (rl < u.nvalid ? rl : 0)]; }
#pragma unroll
            for (int i = 0; i < 2; ++i)
#pragma unroll
                for (int h = 0; h < 2; ++h) va[h][i] = (unsigned)(tok[h][i] * pitchB + C[i] * 2);
        } else {
#pragma unroll
            for (int i = 0; i < 2; ++i)
#pragma unroll
                for (int h = 0; h < 2; ++h) va[h][i] = (unsigned)((u.row0 + h * HALF + R[i]) * pitchB + C[i] * 2);
        }
    }
    __device__ __forceinline__ const char* b_ptr(const Unit& u, const Gemm& g, int pitchB) const { return (const char*)(W + (size_t)u.e * wstride + (size_t)u.pn * 256 * pitchB); }
};
struct EpiMoe1 {
    static constexpr bool PERM = true;
    unsigned char* act; const float* bgu;
    __device__ __forceinline__ void operator()(const f32x4 (&acc)[2][2][4][2], const Unit& u, int wr, int wc, int fr, int fq) const {
        const int cl = u.pn * 128 + wc * 32 + 8 * fq;
        const float* bg = bgu + (size_t)u.e * 2048 + cl;
        const f32x4 g0b = *(const GAS f32x4*)(bg), g1b = *(const GAS f32x4*)(bg + 4), u0b = *(const GAS f32x4*)(bg + 1024), u1b = *(const GAS f32x4*)(bg + 1028);
#pragma unroll
        for (int ai = 0; ai < 2; ++ai)
#pragma unroll
            for (int m = 0; m < 4; ++m) { const int rl = ai * HALF + wr * 64 + m * 16 + fr;
                const f32x4 ga = acc[ai][0][m][0] * WSCALE_INV + g0b, gb = acc[ai][0][m][1] * WSCALE_INV + g1b, ua = acc[ai][1][m][0] * WSCALE_INV + u0b, ub = acc[ai][1][m][1] * WSCALE_INV + u1b;
                f32x4 o0, o1;
#pragma unroll
                for (int j = 0; j < 4; ++j) {
                    { const float gt = fminf(ga[j], 7.0f), up = fminf(fmaxf(ua[j], -7.0f), 7.0f); o0[j] = (up + 1.0f) * gt * fast_sigmoid(1.702f * gt); }
                    { const float gt = fminf(gb[j], 7.0f), up = fminf(fmaxf(ub[j], -7.0f), 7.0f); o1[j] = (up + 1.0f) * gt * fast_sigmoid(1.702f * gt); }
                }
                const int orow = rl < u.nvalid ? u.row0 + rl : M + rl;
                v2u o8; o8.x = pk4_fp8(o0[0], o0[1], o0[2], o0[3]); o8.y = pk4_fp8(o1[0], o1[1], o1[2], o1[3]);
                *(GAS v2u*)(act + (size_t)orow * 1024 + cl) = o8; }
    }
};
struct EpiMoe2 {
    static constexpr bool PERM = true;
    bf16* Y; const float* bdn;
    __device__ __forceinline__ void operator()(const f32x4 (&acc)[2][2][4][2], const Unit& u, int wr, int wc, int fr, int fq) const {
        const int col0 = u.pn * 256 + wc * 32 + 8 * fq;
        const float* bd = bdn + (size_t)u.e * 1024 + col0;
        f32x4 bv[2][2];
#pragma unroll
        for (int bj = 0; bj < 2; ++bj) { bv[bj][0] = *(const GAS f32x4*)(bd + bj * HALF); bv[bj][1] = *(const GAS f32x4*)(bd + bj * HALF + 4); }
#pragma unroll
        for (int ai = 0; ai < 2; ++ai)
#pragma unroll
            for (int m = 0; m < 4; ++m) { const int rl = ai * HALF + wr * 64 + m * 16 + fr;
                if (rl < u.nvalid) { bf16* rowp = Y + (size_t)(u.row0 + rl) * 1024 + col0;
#pragma unroll
                    for (int bj = 0; bj < 2; ++bj) *(GAS v4u*)(rowp + bj * HALF) = pack8(acc[ai][bj][m][0] * WSCALE_INV + bv[bj][0], acc[ai][bj][m][1] * WSCALE_INV + bv[bj][1]); } }
    }
};
}

struct Frame {
    LAS unsigned char* lds; volatile LAS unsigned* MISC; gu32* ctl;
    int wave, vcu, G;
};
struct Args { const float* in[20]; float* out; unsigned char* ws; int ph_lo, ph_hi; };

template <bool F8>
__device__ __forceinline__ void p0_transpose_item(const float* W, int N, int k0, int n0, void* WT, int Kp, int dst_row0, const float* gain, float scale, LAS float* scr, int lane) {
    f32x4 v[8]; float gs[8];
    const int kq = lane >> 3, n4 = 4 * (lane & 7);
#pragma unroll
    for (int i = 0; i < 8; ++i) v[i] = *(const GAS f32x4*)(W + (size_t)(k0 + kq + 8 * i) * N + n0 + n4);
#pragma unroll
    for (int i = 0; i < 8; ++i) gs[i] = gain ? gain[k0 + kq + 8 * i] * scale : scale;
#pragma unroll
    for (int i = 0; i < 8; ++i) { LAS float* s = scr + (kq + 8 * i) * 33 + n4; s[0] = v[i].x * gs[i]; s[1] = v[i].y * gs[i]; s[2] = v[i].z * gs[i]; s[3] = v[i].w * gs[i]; }
    LDS_WAIT(); asm volatile("" ::: "memory");
    if constexpr (!F8) {
        const int c = lane & 7;
#pragma unroll
        for (int j = 0; j < 4; ++j) { const int n = (lane >> 3) + 8 * j; const LAS float* s = scr + (8 * c) * 33 + n;
            v4u o; o.x = pk2(s[0 * 33], s[1 * 33]); o.y = pk2(s[2 * 33], s[3 * 33]); o.z = pk2(s[4 * 33], s[5 * 33]); o.w = pk2(s[6 * 33], s[7 * 33]);
            *(GAS v4u*)((bf16*)WT + (size_t)(dst_row0 + n) * Kp + k0 + 8 * c) = o; }
    } else {
        const int c = lane & 3;
#pragma unroll
        for (int j = 0; j < 2; ++j) { const int n = (lane >> 2) + 16 * j; const LAS float* s = scr + (16 * c) * 33 + n;
            v4u o; o.x = pk4_fp8(s[0 * 33], s[1 * 33], s[2 * 33], s[3 * 33]); o.y = pk4_fp8(s[4 * 33], s[5 * 33], s[6 * 33], s[7 * 33]);
            o.z = pk4_fp8(s[8 * 33], s[9 * 33], s[10 * 33], s[11 * 33]); o.w = pk4_fp8(s[12 * 33], s[13 * 33], s[14 * 33], s[15 * 33]);
            *(GAS v4u*)((unsigned char*)WT + (size_t)(dst_row0 + n) * Kp + k0 + 16 * c) = o; }
    }
    LDS_WAIT(); asm volatile("" ::: "memory");
}
__device__ __forceinline__ void rms_row_f32_to_bf16(const float* xrow, const float* g, bf16* orow, int lane) {
    const GAS f32x4* xr = (const GAS f32x4*)xrow + lane; const GAS f32x4* gr = (const GAS f32x4*)g + lane;
    f32x4 v[4]; float s = 0.f;
#pragma unroll
    for (int j = 0; j < 4; ++j) { v[j] = xr[64 * j]; s += (v[j].x * v[j].x + v[j].y * v[j].y) + (v[j].z * v[j].z + v[j].w * v[j].w); }
    const float r = 1.0f / sqrtf(wave_sum(s) * (1.f / D) + EPS);
    GAS v2u* o8 = (GAS v2u*)orow + lane;
#pragma unroll
    for (int j = 0; j < 4; ++j) { const f32x4 gg = gr[64 * j]; v2u o; o.x = pk2(v[j].x * r * gg.x, v[j].y * r * gg.y); o.y = pk2(v[j].z * r * gg.z, v[j].w * r * gg.w); o8[64 * j] = o; }
}

#define MFMA32(a, b, c) __builtin_amdgcn_mfma_f32_32x32x16_bf16((a), (b), (c), 0, 0, 0)
__device__ __forceinline__ bf16x8 ldg16(const bf16* p) { return *(const GAS bf16x8*)p; }
struct KVFrag { bf16x8 k[4], v[4]; };
__device__ __forceinline__ void att_load(KVFrag& f, const bf16* kbase, const bf16* vbase, int key0) {
    const int lk = key0 < 0 ? 0 : key0;
#pragma unroll
    for (int kk = 0; kk < 4; ++kk) f.k[kk] = ldg16(kbase + (size_t)lk * 512 + 16 * kk);
#pragma unroll
    for (int dj = 0; dj < 4; ++dj) f.v[dj] = ldg16(vbase + (size_t)(dj >> 1) * 32 * M + lk + 16 * (dj & 1));
}
__device__ __forceinline__ void att_tile(const KVFrag& f, const bf16x8 (&qf)[4], f32x16& o0, f32x16& o1, float& carry, bool diag, int l31, int hl) {
    f32x16 s;
#pragma unroll
    for (int r = 0; r < 16; ++r) s[r] = 0.f;
#pragma unroll
    for (int kk = 0; kk < 4; ++kk) s = MFMA32(f.k[kk], qf[kk], s);
    float sp[16], ls[16];
    float lo = 0.f, hi = 0.f;
#pragma unroll
    for (int r = 0; r < 16; ++r) {
        const int ko = (r < 8) ? (8 * hl + r) : (16 + 8 * hl + (r - 8));
        const float z = s[r];
        const float e = __builtin_amdgcn_exp2f(-fabsf(z));
        const float lg = __builtin_amdgcn_logf(1.0f + e);
        float spv = fmaxf(z, 0.f) + lg;
        float lsv = fminf(z, 0.f) - lg;
        if (diag && ko >= l31) { spv = 0.f; lsv = -1.0e30f; }
        sp[r] = spv; ls[r] = lsv;
        if (r < 8) lo += spv; else hi += spv;
    }
    const float plo = __shfl_xor(lo, 32), phi = __shfl_xor(hi, 32);
    const float after_lo = (hl == 0) ? (plo + hi + phi) : (hi + phi);
    const float after_hi = (hl == 0) ? phi : 0.f;
    float w[16];
    { float run = carry + after_lo;
#pragma unroll
      for (int r = 7; r >= 0; --r) { w[r] = __builtin_amdgcn_exp2f(ls[r] - run); run += sp[r]; } }
    { float run = carry + after_hi;
#pragma unroll
      for (int r = 15; r >= 8; --r) { w[r] = __builtin_amdgcn_exp2f(ls[r] - run); run += sp[r]; } }
    carry += (lo + hi) + (plo + phi);
    v4u w0, w1;
    w0.x = pk2(w[0], w[1]); w0.y = pk2(w[2], w[3]); w0.z = pk2(w[4], w[5]); w0.w = pk2(w[6], w[7]);
    w1.x = pk2(w[8], w[9]); w1.y = pk2(w[10], w[11]); w1.z = pk2(w[12], w[13]); w1.w = pk2(w[14], w[15]);
    const bf16x8 W0 = __builtin_bit_cast(bf16x8, w0), W1 = __builtin_bit_cast(bf16x8, w1);
    o0 = MFMA32(f.v[0], W0, o0); o0 = MFMA32(f.v[1], W1, o0);
    o1 = MFMA32(f.v[2], W0, o1); o1 = MFMA32(f.v[3], W1, o1);
}
__device__ __forceinline__ void attn_task(const bf16* __restrict__ Q, const bf16* __restrict__ Kp, const bf16* __restrict__ Vt, bf16* __restrict__ Y, int b, int h, int qb, int lane) {
    const int l31 = lane & 31, hl = lane >> 5;
    const int t0 = qb * 32; const size_t tb = (size_t)b * SEQ;
    bf16x8 qf[4];
    { const bf16* qrow = Q + (tb + t0 + l31) * 512 + h * 64 + 8 * hl;
#pragma unroll
      for (int kk = 0; kk < 4; ++kk) qf[kk] = ldg16(qrow + 16 * kk); }
    const int a_ = l31 >> 3, hh = (l31 >> 2) & 1, c_ = l31 & 3;
    const int pim = 16 * (a_ >> 1) + 8 * hh + 4 * (a_ & 1) + c_;
    const bf16* kbase = Kp + (tb + pim) * 512 + h * 64 + 8 * hl;
    const bf16* vbase = Vt + (size_t)(h * 64 + l31) * M + tb + 8 * hl;
    f32x16 o0, o1;
#pragma unroll
    for (int r = 0; r < 16; ++r) { o0[r] = 0.f; o1[r] = 0.f; }
    float carry = 0.f;
    int key0 = t0;
    KVFrag b0, b1, b2;
    att_load(b0, kbase, vbase, key0); att_load(b1, kbase, vbase, key0 - 32);
    bool diag = true;
#define ATT_STEP(cur, pre) { att_load(pre, kbase, vbase, key0 - 64); att_tile(cur, qf, o0, o1, carry, diag, l31, hl); diag = false; \
        if (key0 - 32 < 0) break; if (__all(carry >= ATT_THR)) break; key0 -= 32; }
    for (;;) { ATT_STEP(b0, b2) ATT_STEP(b1, b0) ATT_STEP(b2, b1) }
#undef ATT_STEP
    bf16* yrow = Y + (tb + t0 + l31) * 512 + h * 64 + 4 * hl;
#pragma unroll
    for (int a = 0; a < 4; ++a) {
        v2u p0, p1; p0.x = pk2(o0[4 * a], o0[4 * a + 1]); p0.y = pk2(o0[4 * a + 2], o0[4 * a + 3]); p1.x = pk2(o1[4 * a], o1[4 * a + 1]); p1.y = pk2(o1[4 * a + 2], o1[4 * a + 3]);
        *(GAS v2u*)(yrow + 8 * a) = p0; *(GAS v2u*)(yrow + 32 + 8 * a) = p1;
    }
}

__device__ __forceinline__ void pool_unpack(const v4u v, float (&f)[8]) { f[0] = bflo(v.x); f[1] = bfhi(v.x); f[2] = bflo(v.y); f[3] = bfhi(v.y); f[4] = bflo(v.z); f[5] = bfhi(v.z); f[6] = bflo(v.w); f[7] = bfhi(v.w); }
__device__ __forceinline__ void pool_item(const bf16* __restrict__ U, bf16* __restrict__ P, int tok0, int lane) {
    const int t0 = tok0 & (SEQ - 1); const int g = lane >> 4; const int w = 2 << g;
    v4u row[31];
#pragma unroll
    for (int r = 0; r < 31; ++r) { const int rr = (t0 == 0 && r < 15) ? 15 : r; row[r] = *(const GAS v4u*)(U + (size_t)(tok0 - 15 + rr) * 512 + 8 * lane); }
    if (t0 == 0) {
#pragma unroll
        for (int r = 0; r < 15; ++r) row[r] = (v4u){0u, 0u, 0u, 0u};
    }
    float S[8], f[8];
    pool_unpack(row[15], S); pool_unpack(row[14], f);
#pragma unroll
    for (int q = 0; q < 8; ++q) S[q] += f[q];
    float acc4[8], acc8[8], acc16[8];
#pragma unroll
    for (int q = 0; q < 8; ++q) acc4[q] = S[q];
#pragma unroll
    for (int r = 13; r >= 12; --r) { pool_unpack(row[r], f);
#pragma unroll
        for (int q = 0; q < 8; ++q) acc4[q] += f[q]; }
#pragma unroll
    for (int q = 0; q < 8; ++q) acc8[q] = acc4[q];
#pragma unroll
    for (int r = 11; r >= 8; --r) { pool_unpack(row[r], f);
#pragma unroll
        for (int q = 0; q < 8; ++q) acc8[q] += f[q]; }
#pragma unroll
    for (int q = 0; q < 8; ++q) acc16[q] = acc8[q];
#pragma unroll
    for (int r = 7; r >= 0; --r) { pool_unpack(row[r], f);
#pragma unroll
        for (int q = 0; q < 8; ++q) acc16[q] += f[q]; }
#pragma unroll
    for (int q = 0; q < 8; ++q) S[q] = (g == 0) ? S[q] : (g == 1 ? acc4[q] : (g == 2 ? acc8[q] : acc16[q]));
#pragma unroll
    for (int i = 0; i < 16; ++i) {
        float cur[8]; pool_unpack(row[15 + i], cur);
        if (i > 0) {
            const v4u lv = (g == 0) ? row[15 + i - 2] : (g == 1 ? row[15 + i - 4] : (g == 2 ? row[15 + i - 8] : row[15 + i - 16]));
            pool_unpack(lv, f);
#pragma unroll
            for (int q = 0; q < 8; ++q) S[q] += cur[q] - f[q];
        }
        const int t = t0 + i; const int cnt = (t + 1) < w ? (t + 1) : w; const float inv = 1.0f / (float)cnt;
        v4u o; o.x = pk2(S[0] * inv - cur[0], S[1] * inv - cur[1]); o.y = pk2(S[2] * inv - cur[2], S[3] * inv - cur[3]);
        o.z = pk2(S[4] * inv - cur[4], S[5] * inv - cur[5]); o.w = pk2(S[6] * inv - cur[6], S[7] * inv - cur[7]);
        *(GAS v4u*)(P + (size_t)(tok0 + i) * 512 + 8 * lane) = o;
    }
}

__device__ __forceinline__ void router_task(const bf16* __restrict__ X1, const bf16* __restrict__ WrF, const float* __restrict__ b_router, int T0, int lane,
                                            float* __restrict__ R2_, unsigned char* __restrict__ H2, int* __restrict__ TKE_, float* __restrict__ TKW_, LAS int* lds_e  ) {
    const int l31 = lane & 31, hl = lane >> 5;
    const bf16* xr = X1 + (size_t)(T0 + l31) * 1024 + 8 * hl;
    f32x16 acc;
#pragma unroll
    for (int r = 0; r < 16; ++r) acc[r] = 0.f;
    float ssq = 0.f;
#pragma unroll 8
    for (int kk = 0; kk < 64; ++kk) {
        const v4u xv = *(const GAS v4u*)(xr + 16 * kk);
        const bf16x8 ah = ldg16(WrF + ((size_t)kk * 64 + lane) * 8), al = ldg16(WrF + 32768 + ((size_t)kk * 64 + lane) * 8);
        const float f0 = bflo(xv.x), f1 = bfhi(xv.x), f2 = bflo(xv.y), f3 = bfhi(xv.y), f4 = bflo(xv.z), f5 = bfhi(xv.z), f6 = bflo(xv.w), f7 = bfhi(xv.w);
        ssq += (f0 * f0 + f1 * f1) + (f2 * f2 + f3 * f3) + (f4 * f4 + f5 * f5) + (f6 * f6 + f7 * f7);
        const bf16x8 xb = __builtin_bit_cast(bf16x8, xv);
        acc = MFMA32(ah, xb, acc); acc = MFMA32(al, xb, acc);
    }
    ssq += __shfl_xor(ssq, 32);
    const float r = 1.0f / sqrtf(ssq * (1.f / D) + EPS);
    {
        unsigned char* hr = H2 + (size_t)(T0 + l31) * 1024 + 8 * hl;
#pragma unroll 8
        for (int kk = 0; kk < 64; ++kk) { const v4u xv = *(const GAS v4u*)(xr + 16 * kk);
            v2u o; o.x = pk4_fp8(bflo(xv.x) * r, bfhi(xv.x) * r, bflo(xv.y) * r, bfhi(xv.y) * r); o.y = pk4_fp8(bflo(xv.z) * r, bfhi(xv.z) * r, bflo(xv.w) * r, bfhi(xv.w) * r);
            *(GAS v2u*)(hr + 16 * kk) = o; }
    }
    float v[16];
#pragma unroll
    for (int q = 0; q < 16; ++q) { const int e = 8 * (q >> 2) + 4 * hl + (q & 3); v[q] = acc[q] * r + b_router[e]; }
    float cv[8]; int ce[8];
#pragma unroll
    for (int k = 0; k < 4; ++k) {
        float best = -3.0e38f; int bi = 0;
#pragma unroll
        for (int q = 0; q < 16; ++q) { if (v[q] > best) { best = v[q]; bi = q; } }
        cv[k] = best; ce[k] = 8 * (bi >> 2) + 4 * hl + (bi & 3);
#pragma unroll
        for (int q = 0; q < 16; ++q) { if (q == bi) v[q] = -3.0e38f; }
    }
#pragma unroll
    for (int k = 0; k < 4; ++k) { cv[4 + k] = __shfl_xor(cv[k], 32); ce[4 + k] = __shfl_xor(ce[k], 32); }
    float tv[4]; int te[4];
#pragma unroll
    for (int k = 0; k < 4; ++k) {
        float best = -3.0e38f; int be = 1 << 20; int bi = 0;
#pragma unroll
        for (int q = 0; q < 8; ++q) { if (cv[q] > best || (cv[q] == best && ce[q] < be)) { best = cv[q]; be = ce[q]; bi = q; } }
        tv[k] = best; te[k] = be;
#pragma unroll
        for (int q = 0; q < 8; ++q) { if (q == bi) { cv[q] = -3.0e38f; ce[q] = 1 << 21; } }
    }
    const float p1 = __expf(tv[1] - tv[0]), p2 = __expf(tv[2] - tv[0]), p3 = __expf(tv[3] - tv[0]);
    const float inv = 1.0f / (1.0f + p1 + p2 + p3);
    if (hl == 0) {
        const int tok = T0 + l31;
        R2_[tok] = r;
        *(GAS v4i*)(TKE_ + (size_t)tok * 4) = (v4i){te[0], te[1], te[2], te[3]};
        *(GAS f32x4*)(TKW_ + (size_t)tok * 4) = (f32x4){inv, p1 * inv, p2 * inv, p3 * inv};
        lds_e[l31 * 4 + 0] = te[0]; lds_e[l31 * 4 + 1] = te[1]; lds_e[l31 * 4 + 2] = te[2]; lds_e[l31 * 4 + 3] = te[3];
    }
}


#define IN_(i) (args.in[i])
#define x_ IN_(0)
#define p_in IN_(1)
#define g_mix IN_(2)
#define w_in IN_(3)
#define w_pool_grp IN_(4)
#define pool_scale IN_(5)
#define w_pool_up IN_(6)
#define w_attn_up IN_(7)
#define w_out IN_(8)
#define g_ffn IN_(9)
#define w_router IN_(10)
#define b_router IN_(11)
#define w_gu IN_(12)
#define b_gu IN_(13)
#define w_down IN_(14)
#define b_down IN_(15)
#define g_ple IN_(16)
#define w_ple_gate IN_(17)
#define w_ple_proj IN_(18)
#define g_final IN_(19)
#define WSP(T, off) ((T*)(args.ws + (off)))
#define R2 WSP(float, WS_R2)
#define R3 WSP(float, WS_R3)
#define TKE WSP(int, WS_TKE)
#define TKW WSP(float, WS_TKW)
#define TKR WSP(int, WS_TKR)
#define ROWT WSP(int, WS_ROWT)
#define CNTWG WSP(int, WS_CNTWG)
#define SEGTOT WSP(int, WS_SEGTOT)
#define WRF WSP(bf16, WS_WRF)
#define WIN WSP(bf16, WS_WIN)
#define WEFF WSP(bf16, WS_WEFF)
#define WAU WSP(bf16, WS_WAU)
#define WOUT WSP(bf16, WS_WOUT)
#define WPG WSP(bf16, WS_WPG)
#define WPP WSP(bf16, WS_WPP)
#define WGU WSP(unsigned char, WS_WGU)
#define WDN WSP(unsigned char, WS_WDN)
#define H2F8 WSP(unsigned char, WS_H2F8)
#define TKS WSP(int, WS_TKS)
#define H1 WSP(bf16, WS_A)
#define MRG WSP(bf16, WS_A)
#define PPB WSP(bf16, WS_A)
#define UB WSP(bf16, WS_B)
#define QB WSP(bf16, WS_B + 64 * MiB)
#define X1 WSP(bf16, WS_B)
#define KB WSP(bf16, WS_C)
#define VT WSP(bf16, WS_C + 64 * MiB)
#define X2 WSP(bf16, WS_B)
#define POOL WSP(bf16, WS_E)
#define YATT WSP(bf16, WS_E + 64 * MiB)
#define X3 WSP(bf16, WS_E)
#define PB WSP(bf16, WS_PB)
#define GPB WSP(bf16, WS_G)
#define GAB WSP(bf16, WS_G + 128 * MiB)
#define ACT WSP(unsigned char, WS_G)

__global__ void __launch_bounds__(NWAVES * 64, 2) mk_fwd(Args args) {
    extern __shared__ __attribute__((aligned(16))) unsigned char lds[];
    Frame F;
    F.lds = (LAS unsigned char*)lds;
    F.MISC = (volatile LAS unsigned*)(F.lds + MISC_OFF);
    F.wave = __builtin_amdgcn_readfirstlane((int)threadIdx.x >> 6);
    F.G = gridDim.x; { const int bx = blockIdx.x; F.vcu = (F.G % 8 == 0) ? (bx % 8) * (F.G / 8) + bx / 8 : bx; }
    unsigned char* ws = args.ws;
    F.ctl = (gu32*)(ws + WS_CTL);
    for (int u = (int)threadIdx.x; u < (LDS_BYTES - LDSCTL_OFF) / 4; u += NWAVES * 64) ((LAS unsigned*)(F.lds + LDSCTL_OFF))[u] = 0u;
    __syncthreads();
    const int lo = args.ph_lo, hi = args.ph_hi;
    XcdBarrier bar; bar.bar = (unsigned*)(F.ctl + CW_BAR); bar.x = 0; bar.st = nullptr;
    if (hi - lo > 1) bar = xcd_barrier_post((unsigned*)(F.ctl + CW_BAR), F.MISC + 8, F.wave);
#define IN(k) (lo <= (k) && (k) < hi)
#define BOTH(k) (IN(k) && IN((k) + 1))
#define GRID_BAR() xcd_barrier(bar, F.wave)

    const int gw = F.vcu * NWAVES + F.wave, NGW = F.G * NWAVES;
    LAS int* ltab = (LAS int*)(F.lds + LDS_TAB_OFF);

    if (IN(0)) { for (int rep_ = 0; rep_ < REPS(0); ++rep_) {
        const int lane_ = lane_id_v(), tid_ = F.wave * 64 + lane_;
        LAS float* scr = (LAS float*)(F.lds + F.wave * 16384);
        constexpr int I_IN = 16 * 128, I_AU = 8 * 32, I_OUT = 16 * 32, I_PG = 16 * 32, I_PP = 4 * 32, I_GU = 32 * 16 * 64, I_DN = 32 * 16 * 32;
        constexpr int NITEMS = I_IN + I_AU + I_OUT + I_PG + I_PP + I_GU + I_DN;
        for (int it = gw; it < NITEMS; it += NGW) {
            int r = it;
            if (r < I_IN) { const int kb = r / 128, nb = r % 128, n0 = nb * 32;
                const int blk = n0 / 512; const int dst = (blk < 3) ? n0 : (blk == 3 ? 3584 + (n0 - 1536) : n0 - 512);
                p0_transpose_item<false>(w_in, 4096, kb * 64, n0, WIN, 1024, dst, nullptr, 1.0f, scr, lane_); continue; } r -= I_IN;
            if (r < I_AU) { const int kb = r / 32, nb = r % 32; p0_transpose_item<false>(w_attn_up, 1024, kb * 64, nb * 32, WAU, 512, nb * 32, nullptr, 1.0f, scr, lane_); continue; } r -= I_AU;
            if (r < I_OUT) { const int kb = r / 32, nb = r % 32; p0_transpose_item<false>(w_out, 1024, kb * 64, nb * 32, WOUT, 1024, nb * 32, nullptr, 1.0f, scr, lane_); continue; } r -= I_OUT;
            if (r < I_PG) { const int kb = r / 32, nb = r % 32; p0_transpose_item<false>(w_ple_gate, 1024, kb * 64, nb * 32, WPG, 1024, nb * 32, g_ple, 1.0f, scr, lane_); continue; } r -= I_PG;
            if (r < I_PP) { const int kb = r / 32, nb = r % 32; p0_transpose_item<false>(w_ple_proj, 1024, kb * 64, nb * 32, WPP, 256, nb * 32, nullptr, 1.0f, scr, lane_); continue; } r -= I_PP;
            if (r < I_GU) { const int e = r / 1024, q = r % 1024, kb = q / 64, nb = q % 64, n0 = nb * 32;
                const int j = n0 & 1023; const int dst = 256 * (j / 128) + (j % 128) + (n0 >= 1024 ? 128 : 0);
                p0_transpose_item<true>(w_gu + (size_t)e * 1024 * 2048, 2048, kb * 64, n0, WGU + (size_t)e * 2048 * 1024, 1024, dst, g_ffn, WSCALE, scr, lane_); continue; } r -= I_GU;
            { const int e = r / 512, q = r % 512, kb = q / 32, nb = q % 32;
                p0_transpose_item<true>(w_down + (size_t)e * 1024 * 1024, 1024, kb * 64, nb * 32, WDN + (size_t)e * 1024 * 1024, 1024, nb * 32, nullptr, WSCALE, scr, lane_); }
        }
        for (int it = gw; it < 4 * 16 * 16; it += NGW) {
            const int g = it >> 8, cb = (it >> 4) & 15, db = it & 15; const int d = db * 64 + lane_, c0 = cb * 8;
            float a8[8];
#pragma unroll
            for (int q = 0; q < 8; ++q) a8[q] = 0.f;
            for (int j = 0; j < 128; ++j) { const float wv = w_pool_up[(size_t)(g * 128 + j) * 1024 + d] * pool_scale[g * 128 + j];
#pragma unroll
                for (int q = 0; q < 8; ++q) a8[q] += w_pool_grp[(size_t)(g * 128 + c0 + q) * 128 + j] * wv; }
            v4u o; o.x = pk2(a8[0], a8[1]); o.y = pk2(a8[2], a8[3]); o.z = pk2(a8[4], a8[5]); o.w = pk2(a8[6], a8[7]);
            *(GAS v4u*)(WEFF + (size_t)d * 512 + g * 128 + c0) = o;
        }
        for (int it = gw * 64 + lane_; it < 64 * 64; it += NGW * 64) {
            const int kk = it >> 6, l = it & 63, e = l & 31, k0 = 16 * kk + 8 * (l >> 5);
            unsigned hb[8], lb[8];
#pragma unroll
            for (int i = 0; i < 8; ++i) { const float v = g_ffn[k0 + i] * w_router[(size_t)(k0 + i) * 32 + e]; hb[i] = f2bf(v); lb[i] = f2bf(v - __builtin_bit_cast(float, hb[i] << 16)); }
            v4u oh, ol; oh.x = hb[0] | (hb[1] << 16); oh.y = hb[2] | (hb[3] << 16); oh.z = hb[4] | (hb[5] << 16); oh.w = hb[6] | (hb[7] << 16);
            ol.x = lb[0] | (lb[1] << 16); ol.y = lb[2] | (lb[3] << 16); ol.z = lb[4] | (lb[5] << 16); ol.w = lb[6] | (lb[7] << 16);
            *(GAS v4u*)(WRF + (size_t)it * 8) = oh; *(GAS v4u*)(WRF + 32768 + (size_t)it * 8) = ol;
        }
        for (int m = gw; m < M; m += NGW) rms_row_f32_to_bf16(x_ + (size_t)m * D, g_mix, H1 + (size_t)m * D, lane_);
        for (size_t i = (size_t)gw * 64 + lane_; i < (size_t)M * PLE / 8; i += (size_t)NGW * 64) {
            const f32x4 a = *(const GAS f32x4*)(p_in + i * 8), b = *(const GAS f32x4*)(p_in + i * 8 + 4);
            *(GAS v4u*)(PB + i * 8) = pg8::pack8(a, b);
        }
        if (BOTH(0) || rep_ + 1 < REPS(0)) GRID_BAR();
    } }

    if (IN(1)) { for (int rep_ = 0; rep_ < REPS(1); ++rep_) {
        { pg8::Gemm g{H1, WIN, D}; pg8::StaticOrder S; S.init(M, NPROJ_A, F.G, (int)blockIdx.x);
          pg8::EpiProj E{UB, QB, KB, GPB, GAB};
          pg8::gemm_phase<pg8::EpiProj, pg8::StaticOrder, true>(F.lds, g, S, E, F.wave); }
        { pg8::Gemm g{WIN + (size_t)NPROJ_A * D, H1, D}; pg8::StaticOrder S; S.init(512, M, F.G, (int)blockIdx.x);
          pg8::EpiPlain E{VT, M};
          pg8::gemm_phase<pg8::EpiPlain, pg8::StaticOrder, true>(F.lds, g, S, E, F.wave); }
        if (BOTH(1) || rep_ + 1 < REPS(1)) GRID_BAR();
    } }

    if (IN(2)) { for (int rep_ = 0; rep_ < REPS(2); ++rep_) {
        const int lane_ = lane_id_v(), tid_ = F.wave * 64 + lane_;
        for (int T = gw; T < NB * NH * (SEQ / 32); T += NGW) {
            const int qb = T & 127, h = (T >> 7) & 7, b = T >> 10;
            attn_task(QB, KB, VT, YATT, b, h, qb, lane_);
        }
        for (int it = gw; it < M / 16; it += NGW) pool_item(UB, POOL, it * 16, lane_);
        if (BOTH(2) || rep_ + 1 < REPS(2)) GRID_BAR();
    } }

    if (IN(3)) { for (int rep_ = 0; rep_ < REPS(3); ++rep_) {
        pg8::Gemm g{POOL, WEFF, PW}; pg8::StaticOrder S; S.init(M, D, F.G, (int)blockIdx.x);
        pg8::EpiGate<false> E{MRG, GPB};
        pg8::gemm_phase<pg8::EpiGate<false>, pg8::StaticOrder, true>(F.lds, g, S, E, F.wave);
        if (BOTH(3) || rep_ + 1 < REPS(3)) GRID_BAR();
    } }
    if (IN(4)) {
        pg8::Gemm g{YATT, WAU, AW}; pg8::StaticOrder S; S.init(M, D, F.G, (int)blockIdx.x);
        pg8::EpiGate<true> E{MRG, GAB};
        pg8::gemm_phase<pg8::EpiGate<true>, pg8::StaticOrder, true>(F.lds, g, S, E, F.wave);
        if (BOTH(4)) GRID_BAR();
    }
    if (IN(5)) { for (int rep_ = 0; rep_ < REPS(5); ++rep_) {
        pg8::Gemm g{MRG, WOUT, D}; pg8::StaticOrder S; S.init(M, D, F.G, (int)blockIdx.x);
        pg8::EpiResid E{X1, x_};
        pg8::gemm_phase<pg8::EpiResid, pg8::StaticOrder, true>(F.lds, g, S, E, F.wave);
        if (BOTH(5) || rep_ + 1 < REPS(5)) GRID_BAR();
    } }

    if (IN(6)) { for (int rep_ = 0; rep_ < REPS(6); ++rep_) {
        const int lane_ = lane_id_v(), tid_ = F.wave * 64 + lane_;
        LAS int* lcnt = ltab;
        LAS int* le = ltab + 128;
        for (int chunk = F.vcu; chunk < M / 256; chunk += F.G) {
            if (tid_ < 128) lcnt[tid_] = 0;
            router_task(X1, WRF, b_router, chunk * 256 + F.wave * 32, lane_, R2, H2F8, TKE, TKW, le + F.wave * 128);
            __syncthreads();
            if (tid_ < 256) {
                const int tok = chunk * 256 + tid_; v4i rk;
#pragma unroll
                for (int k = 0; k < 4; ++k) rk[k] = __hip_atomic_fetch_add((int*)(lcnt + k * 32 + le[tid_ * 4 + k]), 1, __ATOMIC_RELAXED, __HIP_MEMORY_SCOPE_WORKGROUP);
                *(GAS v4i*)(TKR + (size_t)tok * 4) = rk;
            }
            __syncthreads();
            if (tid_ < 128) CNTWG[chunk * 128 + tid_] = lcnt[tid_];
            __syncthreads();
        }
        if (BOTH(6) || rep_ + 1 < REPS(6)) GRID_BAR();
    } }

    if (IN(7)) { for (int rep_ = 0; rep_ < REPS(7); ++rep_) {
        const int lane_ = lane_id_v(), tid_ = F.wave * 64 + lane_;
        LAS int* part = ltab;
        LAS int* tot = ltab + 1024;
        LAS int* below = ltab + 1152;
        LAS int* base = ltab + 1280;
        for (int chunk = F.vcu; chunk < M / 256; chunk += F.G) {
            { const int s = tid_ & 127, q = tid_ >> 7; int st = 0, sb = 0;
              for (int c2 = q * 64; c2 < q * 64 + 64; ++c2) { const int v = CNTWG[c2 * 128 + s]; st += v; sb += (c2 < chunk) ? v : 0; }
              part[(q * 128 + s) * 2] = st; part[(q * 128 + s) * 2 + 1] = sb; }
            __syncthreads();
            if (tid_ < 128) { int st = 0, sb = 0;
#pragma unroll
                for (int q = 0; q < 4; ++q) { st += part[(q * 128 + tid_) * 2]; sb += part[(q * 128 + tid_) * 2 + 1]; }
                tot[tid_] = st; below[tid_] = sb; }
            __syncthreads();
            if (tid_ < 128) { const int k = tid_ >> 5, e = tid_ & 31; int pre = 0;
                for (int e2 = 0; e2 < e; ++e2) pre += tot[k * 32 + e2];
                base[tid_] = k * M + pre + below[tid_];
                if (chunk == 0) SEGTOT[tid_] = tot[tid_]; }
            __syncthreads();
            if (tid_ < 256) { const int tok = chunk * 256 + tid_;
                const v4i te = *(const GAS v4i*)(TKE + (size_t)tok * 4), rk = *(const GAS v4i*)(TKR + (size_t)tok * 4); v4i sl;
#pragma unroll
                for (int k = 0; k < 4; ++k) { const int slot = base[k * 32 + te[k]] + rk[k]; ROWT[slot] = tok; sl[k] = slot - k * M; }
                *(GAS v4i*)(TKS + (size_t)tok * 4) = sl; }
            __syncthreads();
        }
        if (BOTH(7) || rep_ + 1 < REPS(7)) GRID_BAR();
    } }

    for (int k = 0; k < 4; ++k) {
        if (IN(8 + 2 * k) || IN(9 + 2 * k)) {
            const int tid_ = F.wave * 64 + lane_id_v();
            __syncthreads();
            if (tid_ < 32) {
                const int cn = SEGTOT[k * 32 + tid_]; int nt_ = (cn + 255) >> 8, pt = nt_, ps = cn;
#pragma unroll
                for (int o = 1; o < 32; o <<= 1) { const int a = __shfl_up(pt, o), b = __shfl_up(ps, o); if (tid_ >= o) { pt += a; ps += b; } }
                ltab[tid_] = pt - nt_; ltab[33 + tid_] = ps - cn; ltab[65 + tid_] = cn; if (tid_ == 31) ltab[32] = pt; }
            __syncthreads();
        }
        const int T = __builtin_amdgcn_readfirstlane(ltab[32]);
        if (IN(8 + 2 * k)) { for (int rep_ = 0; rep_ < REPS(8 + 2 * k); ++rep_) {
            pg8::Gemm g{H2F8, WGU, D};
            pg8::MoeOrder<true> S{ltab, ROWT + (size_t)k * M, WGU, 8, F.G, F.vcu, T * 8, (size_t)2048 * 1024};
            pg8::EpiMoe1 E{ACT, b_gu};
            pg8::gemm_phase<pg8::EpiMoe1, pg8::MoeOrder<true>, MOE_ALIGN, 1>(F.lds, g, S, E, F.wave);
            if (BOTH(8 + 2 * k) || rep_ + 1 < REPS(8 + 2 * k)) GRID_BAR();
        } }
        if (IN(9 + 2 * k)) { for (int rep_ = 0; rep_ < REPS(9 + 2 * k); ++rep_) {
            pg8::Gemm g{ACT, WDN, DE};
            pg8::MoeOrder<false> S{ltab, ROWT + (size_t)k * M, WDN, 4, F.G, F.vcu, T * 4, (size_t)1024 * 1024};
            pg8::EpiMoe2 E{WSP(bf16, k == 0 ? WS_A : (k == 1 ? WS_C : (k == 2 ? WS_E : WS_Y3))), b_down};
            pg8::gemm_phase<pg8::EpiMoe2, pg8::MoeOrder<false>, MOE_ALIGN, 1>(F.lds, g, S, E, F.wave);
            if (BOTH(9 + 2 * k) || rep_ + 1 < REPS(9 + 2 * k)) GRID_BAR();
        } }
    }

    if (IN(16)) { for (int rep_ = 0; rep_ < REPS(16); ++rep_) {
        const int lane_ = lane_id_v();
        for (int t0 = gw * 4; t0 < M; t0 += NGW * 4) {
            v4i sl[4]; f32x4 tw[4];
#pragma unroll
            for (int i = 0; i < 4; ++i) { sl[i] = *(const GAS v4i*)(TKS + (size_t)(t0 + i) * 4); tw[i] = *(const GAS f32x4*)(TKW + (size_t)(t0 + i) * 4); }
#pragma unroll
            for (int i = 0; i < 4; ++i) {
                bf16* xrow = X1 + (size_t)(t0 + i) * D;
                v4u xv[2], yv[4][2];
#pragma unroll
                for (int j = 0; j < 2; ++j) { xv[j] = ((const GAS v4u*)xrow)[64 * j + lane_];
                    yv[0][j] = ((const GAS v4u*)(WSP(bf16, WS_A) + (size_t)sl[i][0] * D))[64 * j + lane_]; yv[1][j] = ((const GAS v4u*)(WSP(bf16, WS_C) + (size_t)sl[i][1] * D))[64 * j + lane_];
                    yv[2][j] = ((const GAS v4u*)(WSP(bf16, WS_E) + (size_t)sl[i][2] * D))[64 * j + lane_]; yv[3][j] = ((const GAS v4u*)(WSP(bf16, WS_Y3) + (size_t)sl[i][3] * D))[64 * j + lane_]; }
                float s = 0.f;
#pragma unroll
                for (int j = 0; j < 2; ++j) { f32x4 a0, a1; pg8::unpack8(xv[j], a0, a1);
#pragma unroll
                    for (int k = 0; k < 4; ++k) { f32x4 y0, y1; pg8::unpack8(yv[k][j], y0, y1); a0 = a0 + y0 * tw[i][k]; a1 = a1 + y1 * tw[i][k]; }
                    const v4u o = pg8::pack8(a0, a1); f32x4 b0, b1; pg8::unpack8(o, b0, b1);
                    s += (b0[0] * b0[0] + b0[1] * b0[1]) + (b0[2] * b0[2] + b0[3] * b0[3]) + (b1[0] * b1[0] + b1[1] * b1[1]) + (b1[2] * b1[2] + b1[3] * b1[3]);
                    ((GAS v4u*)xrow)[64 * j + lane_] = o; }
                s = wave_sum(s);
                if (lane_ == 0) R3[t0 + i] = 1.0f / sqrtf(s * (1.f / D) + EPS);
            }
        }
        if (BOTH(16) || rep_ + 1 < REPS(16)) GRID_BAR();
    } }
    if (IN(17)) { for (int rep_ = 0; rep_ < REPS(17); ++rep_) {
        pg8::Gemm g{PB, WPP, PLE}; pg8::StaticOrder S; S.init(M, D, F.G, (int)blockIdx.x);
        pg8::EpiPlain E{PPB, D};
        pg8::gemm_phase<pg8::EpiPlain, pg8::StaticOrder, true>(F.lds, g, S, E, F.wave);
        if (BOTH(17) || rep_ + 1 < REPS(17)) GRID_BAR();
    } }
    if (IN(18)) { for (int rep_ = 0; rep_ < REPS(18); ++rep_) {
        pg8::Gemm g{X2, WPG, D}; pg8::StaticOrder S; S.init(M, D, F.G, (int)blockIdx.x);
        pg8::EpiPle E{X3, X2, PPB, R3};
        pg8::gemm_phase<pg8::EpiPle, pg8::StaticOrder, true>(F.lds, g, S, E, F.wave);
        if (BOTH(18) || rep_ + 1 < REPS(18)) GRID_BAR();
    } }
    if (IN(19)) { for (int rep_ = 0; rep_ < REPS(19); ++rep_) {
        const int lane_ = lane_id_v();
        for (int m = gw; m < M; m += NGW) {
            const GAS v4u* xr = (const GAS v4u*)(X3 + (size_t)m * D) + lane_; float f[2][8]; float s = 0.f;
#pragma unroll
            for (int j = 0; j < 2; ++j) { const v4u v = xr[64 * j]; f[j][0] = bflo(v.x); f[j][1] = bfhi(v.x); f[j][2] = bflo(v.y); f[j][3] = bfhi(v.y); f[j][4] = bflo(v.z); f[j][5] = bfhi(v.z); f[j][6] = bflo(v.w); f[j][7] = bfhi(v.w);
#pragma unroll
                for (int q = 0; q < 8; ++q) s += f[j][q] * f[j][q]; }
            s = wave_sum(s);
            const float r = 1.0f / sqrtf(s * (1.f / D) + EPS);
#pragma unroll
            for (int j = 0; j < 2; ++j) { const int c0 = (64 * j + lane_) * 8;
                const f32x4 g0 = *(const GAS f32x4*)(g_final + c0), g1 = *(const GAS f32x4*)(g_final + c0 + 4);
                f32x4 o0 = {f[j][0] * r * g0.x, f[j][1] * r * g0.y, f[j][2] * r * g0.z, f[j][3] * r * g0.w}, o1 = {f[j][4] * r * g1.x, f[j][5] * r * g1.y, f[j][6] * r * g1.z, f[j][7] * r * g1.w};
                *(GAS f32x4*)(args.out + (size_t)m * D + c0) = o0; *(GAS f32x4*)(args.out + (size_t)m * D + c0 + 4) = o1; }
        }
    } }
#undef IN
#undef BOTH
#undef GRID_BAR
}

extern "C" void kernel_launch(void* const* d_in, const int* in_sizes, int n_in, void* d_out, int out_size, void* d_ws, size_t ws_size, hipStream_t stream) {
    static int grid = 0;
    if (grid == 0) {
        if (n_in != 20 || out_size != M * D || ws_size < WS_END) { fprintf(stderr, "kernel_launch: unexpected shapes (n_in %d, out %d, ws %zu); nothing launched\n", n_in, out_size, ws_size); grid = -1; return; }
        int dev = 0, cus = 0, per_cu = 0;
        if (hipGetDevice(&dev) != hipSuccess || hipDeviceGetAttribute(&cus, hipDeviceAttributeMultiprocessorCount, dev) != hipSuccess) { grid = -1; return; }
        if (hipFuncSetAttribute((const void*)mk_fwd, hipFuncAttributeMaxDynamicSharedMemorySize, LDS_BYTES) != hipSuccess) { fprintf(stderr, "kernel_launch: hipFuncSetAttribute failed\n"); grid = -1; return; }
        if (hipOccupancyMaxActiveBlocksPerMultiprocessor(&per_cu, (const void*)mk_fwd, NWAVES * 64, LDS_BYTES) != hipSuccess || per_cu < 1)
            fprintf(stderr, "kernel_launch: note: occupancy query reports %d workgroups per CU\n", per_cu);
        (void)hipGetLastError();
        grid = cus;
    }
    if (grid < 0) return;
    if (hipMemsetAsync((char*)d_ws + WS_CTL, 0, CTL_ZERO_BYTES, stream) != hipSuccess) return;
    Args a{};
    for (int i = 0; i < 20; ++i) a.in[i] = (const float*)d_in[i];
    a.out = (float*)d_out; a.ws = (unsigned char*)d_ws;
#if MK_SPLIT
    for (int ph = 0; ph < NPH; ++ph) { a.ph_lo = ph; a.ph_hi = ph + 1; hipLaunchKernelGGL(mk_fwd, dim3(grid), dim3(NWAVES * 64), LDS_BYTES, stream, a); }
#else
    a.ph_lo = 0; a.ph_hi = NPH; hipLaunchKernelGGL(mk_fwd, dim3(grid), dim3(NWAVES * 64), LDS_BYTES, stream, a);
#endif
}
```

```cpp
#include <hip/hip_runtime.h>
#include <cstdio>
#include <cstdint>

#ifndef MK_SPLIT
#define MK_SPLIT 0
#endif

#ifndef MOE_ALIGN
#define MOE_ALIGN true
#endif
#ifndef REP_MASK
#define REP_MASK 0u
#endif
#define REPS(k) ((((REP_MASK) >> (k)) & 1u) ? 2 : 1)

#define GAS __attribute__((address_space(1)))
#define LAS __attribute__((address_space(3)))
typedef unsigned short bf16;
typedef unsigned v4u __attribute__((ext_vector_type(4)));
typedef unsigned v2u __attribute__((ext_vector_type(2)));
typedef int v4i __attribute__((ext_vector_type(4)));
typedef float f32x2 __attribute__((ext_vector_type(2)));
typedef float f32x4 __attribute__((ext_vector_type(4)));
typedef float f32x16 __attribute__((ext_vector_type(16)));
typedef short bf16x8 __attribute__((ext_vector_type(8)));
typedef __bf16 bf16x2_t __attribute__((ext_vector_type(2)));
typedef GAS unsigned gu32;

constexpr int NB = 16, SEQ = 4096, M = NB * SEQ, D = 1024, NH = 8, HD = 64, PW = 512, AW = 512, NE = 32, TOPK = 4, DE = 1024, PLE = 256;
constexpr int NPROJ_A = 3584;
constexpr float EPS = 1e-6f;
constexpr float LOG2E = 1.4426950408889634f;
constexpr float QSCALE = 0.125f * LOG2E;
constexpr float WSCALE = 64.0f, WSCALE_INV = 1.0f / 64.0f;
constexpr float ATT_THR = 152.0f;
constexpr int NWAVES = 8;
constexpr int NPH = 20;

constexpr size_t MiB = 1u << 20;
constexpr size_t WS_CTL = 0, CTL_ZERO_BYTES = 1 * MiB;
constexpr size_t WS_R2 = 1 * MiB;
constexpr size_t WS_R3 = WS_R2 + 256 * 1024;
constexpr size_t WS_TKE = 2 * MiB;
constexpr size_t WS_TKW = 3 * MiB;
constexpr size_t WS_TKR = 4 * MiB;
constexpr size_t WS_TKS = 13 * MiB;
constexpr size_t WS_ROWT = 5 * MiB;
constexpr size_t WS_CNTWG = 11 * MiB;
constexpr size_t WS_SEGTOT = WS_CNTWG + 256 * 1024;
constexpr size_t WS_WRF = 12 * MiB;
constexpr size_t WS_WIN = 16 * MiB;
constexpr size_t WS_WEFF = 24 * MiB;
constexpr size_t WS_WAU = 25 * MiB;
constexpr size_t WS_WOUT = 26 * MiB;
constexpr size_t WS_WPG = 28 * MiB;
constexpr size_t WS_WPP = 30 * MiB;
constexpr size_t WS_WGU = 32 * MiB;
constexpr size_t WS_WDN = 96 * MiB;
constexpr size_t WS_H2F8 = 128 * MiB;
constexpr size_t WS_A = 224 * MiB;
constexpr size_t WS_B = 352 * MiB;
constexpr size_t WS_C = 480 * MiB;
constexpr size_t WS_E = 608 * MiB;
constexpr size_t WS_PB = 736 * MiB;
constexpr size_t WS_G = 768 * MiB;
constexpr size_t WS_Y3 = 896 * MiB;
constexpr size_t WS_END = 1024 * MiB;
constexpr int CW_BAR = 4096;

constexpr int RING_BYTES = 131072;
constexpr int LDSCTL_OFF = RING_BYTES, MISC_OFF = LDSCTL_OFF + 320;
constexpr int LDS_TAB_OFF = MISC_OFF + 128;
constexpr int LDS_BYTES = 147456;

#define RLX_AGENT __ATOMIC_RELAXED, __HIP_MEMORY_SCOPE_AGENT
#define LDS_WAIT() asm volatile("s_waitcnt lgkmcnt(0)" ::: "memory")
#define VM_WAIT() asm volatile("s_waitcnt vmcnt(0)" ::: "memory")

__device__ __forceinline__ int lane_id_v() { int l; asm volatile("v_mbcnt_lo_u32_b32 %0, -1, 0\n\tv_mbcnt_hi_u32_b32 %0, -1, %0" : "=v"(l)); return l; }
__device__ __forceinline__ unsigned f2bf(float f) { unsigned u = __builtin_bit_cast(unsigned, f); return (u + 0x7fffu + ((u >> 16) & 1u)) >> 16; }
__device__ __forceinline__ unsigned pk2(float lo, float hi) { f32x2 v = {lo, hi}; bf16x2_t b = __builtin_convertvector(v, bf16x2_t); return __builtin_bit_cast(unsigned, b); }
__device__ __forceinline__ unsigned pk4_fp8(float a, float b, float c, float d) { int r = __builtin_amdgcn_cvt_pk_fp8_f32(a, b, 0, false); r = __builtin_amdgcn_cvt_pk_fp8_f32(c, d, r, true); return (unsigned)r; }
__device__ __forceinline__ float bflo(unsigned u) { return __builtin_bit_cast(float, u << 16); }
__device__ __forceinline__ float bfhi(unsigned u) { return __builtin_bit_cast(float, u & 0xffff0000u); }
__device__ __forceinline__ float fast_sigmoid(float v) { return __builtin_amdgcn_rcpf(1.0f + __builtin_amdgcn_exp2f(-LOG2E * v)); }
__device__ __forceinline__ float wave_sum(float v) {
#pragma unroll
    for (int o = 1; o < 64; o <<= 1) v += __shfl_xor(v, o);
    return v;
}

#define XB_TMO      128
#define XB_XCNT(j)  (256  + 64 * (j))
#define XB_XSUB(j)  (1280 + 64 * (j))
#define XB_XGEN(j)  (2304 + 64 * (j))
#define XB_TOP      3328
#define XB_TOPGEN   3392
#define XCD_BAR_WORDS 3456
#define XB_SPIN_CAP (1u << 18)
__device__ __forceinline__ unsigned xb_ld(unsigned* p)              { return __hip_atomic_load(p, __ATOMIC_RELAXED, __HIP_MEMORY_SCOPE_AGENT); }
__device__ __forceinline__ unsigned xb_add(unsigned* p, unsigned v) { return __hip_atomic_fetch_add(p, v, __ATOMIC_RELAXED, __HIP_MEMORY_SCOPE_AGENT); }
__device__ __forceinline__ unsigned xb_xcc_id() { return (unsigned)__builtin_amdgcn_s_getreg((3 << 11) | 20) & 0xFu; }
#define XB_SPIN(cond, bar) do { unsigned _sp = 0; while (cond) { __builtin_amdgcn_s_sleep(1); \
    if ((++_sp & 255u) == 0u) { if (xb_ld(&(bar)[XB_TMO])) break; if (_sp > XB_SPIN_CAP) { atomicAdd(&(bar)[XB_TMO], 1u); break; } } } } while (0)
struct XcdBarrier { unsigned* bar; unsigned x; volatile LAS unsigned* st; };
__device__ __forceinline__ XcdBarrier xcd_barrier_post(unsigned* bar, volatile LAS unsigned* st, int wave) {
    XcdBarrier b; b.bar = bar; b.x = xb_xcc_id(); b.st = st;
    if (wave == 0 && lane_id_v() == 0) (void)xb_add(&bar[XB_XCNT(b.x)], 1u);
    return b;
}
__device__ __forceinline__ void xcd_barrier_complete(unsigned* bar, unsigned x, unsigned& nloc, unsigned& nx) {
    const unsigned G = gridDim.x * gridDim.y * gridDim.z;
    unsigned sum, cnt, mine, sp = 0u;
    for (;;) {
        sum = 0u; cnt = 0u; mine = 0u;
#pragma unroll
        for (unsigned j = 0; j < 16; ++j) { const unsigned c = xb_ld(&bar[XB_XCNT(j)]); sum += c; cnt += (c > 0u) ? 1u : 0u; mine = (j == x) ? c : mine; }
        if (sum == G) break;
        __builtin_amdgcn_s_sleep(1);
        if ((++sp & 255u) == 0u) { if (xb_ld(&bar[XB_TMO])) break; if (sp > XB_SPIN_CAP) { atomicAdd(&bar[XB_TMO], 1u); break; } }
    }
    nloc = mine > 0u ? mine : 1u; nx = cnt > 0u ? cnt : 1u;
}
__device__ __forceinline__ void xcd_barrier(const XcdBarrier& b, int wave) {
    asm volatile("s_waitcnt vmcnt(0)" ::: "memory");
    __syncthreads();
    if (wave == 0 && lane_id_v() == 0) {
        unsigned* bar = b.bar;
        __builtin_amdgcn_s_waitcnt(0);
        unsigned nloc = b.st[0], nx = b.st[1];
        if (nloc == 0u) { xcd_barrier_complete(bar, b.x, nloc, nx); b.st[0] = nloc; b.st[1] = nx; }
        const unsigned old = xb_add(&bar[XB_XSUB(b.x)], 1u);
        const unsigned gen = old / nloc;
        if (old + 1u == (gen + 1u) * nloc) {
            __builtin_amdgcn_fence(__ATOMIC_RELEASE, "agent");
            asm volatile("s_waitcnt vmcnt(0)" ::: "memory");
            const unsigned og = xb_add(&bar[XB_TOP], 1u);
            const unsigned tg = og / nx;
            if (og + 1u == (tg + 1u) * nx) xb_add(&bar[XB_TOPGEN], 1u);
            else XB_SPIN(xb_ld(&bar[XB_TOPGEN]) == tg, bar);
            __builtin_amdgcn_fence(__ATOMIC_ACQUIRE, "agent");
            xb_add(&bar[XB_XGEN(b.x)], 1u);
            asm volatile("s_waitcnt vmcnt(0)" ::: "memory");
        } else {
            XB_SPIN(xb_ld(&bar[XB_XGEN(b.x)]) == gen, bar);
            __builtin_amdgcn_fence(__ATOMIC_ACQUIRE, "agent");
            asm volatile("s_waitcnt vmcnt(0)" ::: "memory");
        }
    }
    __syncthreads();
}

namespace pg8 {
constexpr int BM = 256, BK = 64, HALF = 128, HTB = HALF * BK * 2, NXCD = 8, WGM = 8;
__host__ __device__ __forceinline__ int lds_byte(int r, int c) { const int st = (r >> 4) * 2 + (c >> 5), rr = r & 15, cc = c & 31, ob = rr * 64 + cc * 2; return st * 1024 + (ob ^ (((ob >> 9) & 1) << 5)); }
__host__ __device__ __forceinline__ void stage_rc(int b, int& R, int& C) { const int st = b / 1024, sb = b % 1024, swz = sb ^ (((sb >> 9) & 1) << 5); R = (st >> 1) * 16 + swz / 64; C = (st & 1) * 32 + (swz % 64) / 2; }
__host__ __device__ __forceinline__ int perm32(int rho) { const int n = rho >> 4, i = rho & 15; return 8 * (i >> 2) + 4 * n + (i & 3); }

typedef int v8i __attribute__((ext_vector_type(8)));
typedef int v4i_ __attribute__((ext_vector_type(4)));
__device__ __forceinline__ v8i cat8(const bf16x8 a, const bf16x8 b) { const v4i_ x = __builtin_bit_cast(v4i_, a), y = __builtin_bit_cast(v4i_, b); return __builtin_shufflevector(x, y, 0, 1, 2, 3, 4, 5, 6, 7); }
struct Unit { int pm, pn, e, row0, nvalid; };
struct Gemm { const void* A; const void* Bt; int K; };

struct StaticOrder {
    int nM, nN, nwg, G, c;
    __device__ void init(int Mr, int N, int G_, int c_) { nM = Mr / BM; nN = N / BM; nwg = nM * nN; G = G_; c = c_; }
    __device__ __forceinline__ bool next(int i, Unit& u) const {
        const long L = (long)i * G + c; if (L >= nwg) return false;
        int wgid = (int)L; { const int q = nwg / NXCD, r = nwg % NXCD, xcd = wgid % NXCD, off = wgid / NXCD; wgid = (xcd < r ? xcd * (q + 1) : r * (q + 1) + (xcd - r) * q) + off; }
        const int nig = WGM * nN, gid = wgid / nig, fm = gid * WGM, gsz = (nM - fm) < WGM ? (nM - fm) : WGM;
        u.pm = fm + ((wgid % nig) % gsz); u.pn = (wgid % nig) / gsz; u.e = 0; u.row0 = u.pm * BM; u.nvalid = BM; return true;
    }
    __device__ __forceinline__ void a_off(const Unit& u, int tid, int pitchB, unsigned (&va)[2][2]) const {
#pragma unroll
        for (int i = 0; i < 2; ++i) { int R, C; stage_rc(tid * 16 + i * 8192, R, C);
#pragma unroll
            for (int h = 0; h < 2; ++h) va[h][i] = (unsigned)((u.pm * BM + h * HALF + R) * pitchB + C * 2); }
    }
    __device__ __forceinline__ const char* b_ptr(const Unit& u, const Gemm& g, int pitchB) const { return (const char*)g.Bt + (size_t)u.pn * BM * pitchB; }
};

template <class Epi, class Sched, bool ALIGN_EPI, int ES = 2>
__device__ __forceinline__ void gemm_phase(LAS unsigned char* lds, const Gemm g, const Sched& S, const Epi& E, const int wid) {
    const int lane = lane_id_v(), tid = wid * 64 + lane, wr = wid >> 2, wc = wid & 3, fr = lane & 15, fq = lane >> 4;
    const int K = g.K, pitchB = K * ES; int nt = pitchB / 128;
    asm volatile("" : "+s"(nt));
    unsigned voffB[2];
#pragma unroll
    for (int i = 0; i < 2; ++i) { int R, C; stage_rc(tid * 16 + i * 8192, R, C); const int Rb = Epi::PERM ? ((R & ~31) + perm32(R & 31)) : R;
        voffB[i] = (unsigned)(Rb * pitchB + C * 2); }
    const size_t kstep = (size_t)(BK * 2);
    const size_t hstep = (size_t)HALF * pitchB;
    const unsigned ldsw = (unsigned)wid * 1024u;
    const int aoff = lds_byte(wr * 64 + fr, fq * 8), boff = lds_byte(wc * 32 + fr, fq * 8);
#define PG8_SA(b, h) (((b) * 2 + (h)) * HTB)
#define PG8_SB(b, h) ((4 + (b) * 2 + (h)) * HTB)
#define PG8_STAGE(bufoff, gbase, voff) do { _Pragma("unroll") for (int _i = 0; _i < 2; ++_i) \
        __builtin_amdgcn_global_load_lds((const unsigned*)((const char*)(gbase) + (voff)[_i]), (LAS unsigned*)(lds + (bufoff) + ldsw + _i * 8192), 16, 0, 0); } while (0)
#define PG8_LDA(dst, b, h) do { _Pragma("unroll") for (int m = 0; m < 4; ++m) _Pragma("unroll") for (int k = 0; k < 2; ++k) dst[m][k] = *(const LAS bf16x8*)(lds + PG8_SA(b, h) + aoff + m * 2048 + k * 1024); } while (0)
#define PG8_LDB(dst, b, h) do { _Pragma("unroll") for (int n = 0; n < 2; ++n) _Pragma("unroll") for (int k = 0; k < 2; ++k) dst[n][k] = *(const LAS bf16x8*)(lds + PG8_SB(b, h) + boff + n * 2048 + k * 1024); } while (0)
#define PG8_MMA(ai, bj, At, Bt) do { __builtin_amdgcn_s_setprio(1); _Pragma("unroll") for (int m = 0; m < 4; ++m) _Pragma("unroll") for (int n = 0; n < 2; ++n) { \
        if constexpr (ES == 2) { _Pragma("unroll") for (int k = 0; k < 2; ++k) acc[ai][bj][m][n] = __builtin_amdgcn_mfma_f32_16x16x32_bf16(Bt[n][k], At[m][k], acc[ai][bj][m][n], 0, 0, 0); } \
        else { const v8i a8_ = cat8(Bt[n][0], Bt[n][1]), b8_ = cat8(At[m][0], At[m][1]); \
               if (m == 0 && n == 0) asm volatile("s_nop 1\n\tv_mfma_f32_16x16x128_f8f6f4 %0, %1, %2, %0" : "+v"(acc[ai][bj][m][n]) : "v"(a8_), "v"(b8_)); \
               else asm volatile("v_mfma_f32_16x16x128_f8f6f4 %0, %1, %2, %0" : "+v"(acc[ai][bj][m][n]) : "v"(a8_), "v"(b8_)); } } \
        __builtin_amdgcn_s_setprio(0); } while (0)
#define PG8_WAIT_V(n) asm volatile("s_waitcnt vmcnt(" #n ")" ::: "memory")
#define PG8_WAIT_L(n) asm volatile("s_waitcnt lgkmcnt(" #n ")" ::: "memory")
#define PG8_BAR __builtin_amdgcn_s_barrier()
#define PG8_SCHED __builtin_amdgcn_sched_barrier(0)
    Unit cur, nxt; int ui = 0;
    if (!S.next(0, cur)) return;
    f32x4 acc[2][2][4][2];
#pragma unroll
    for (int a = 0; a < 2; ++a)
#pragma unroll
        for (int b = 0; b < 2; ++b)
#pragma unroll
            for (int m = 0; m < 4; ++m)
#pragma unroll
                for (int n = 0; n < 2; ++n) acc[a][b][m][n] = (f32x4){0.f, 0.f, 0.f, 0.f};
    bf16x8 At[4][2], B0[2][2], B1[2][2];
    unsigned cva[2][2], nva[2][2];
    S.a_off(cur, tid, pitchB, cva);
    const char* const Ab = (const char*)g.A;
    const char* cB = S.b_ptr(cur, g, pitchB);
    PG8_STAGE(PG8_SB(0, 0), cB, voffB); PG8_STAGE(PG8_SB(0, 1), cB + hstep, voffB); PG8_STAGE(PG8_SA(0, 0), Ab, cva[0]); PG8_STAGE(PG8_SA(0, 1), Ab, cva[1]);
    if (wr == 1) PG8_BAR;
    PG8_WAIT_V(2); PG8_BAR;
    PG8_STAGE(PG8_SB(1, 0), cB + kstep, voffB); PG8_STAGE(PG8_SA(1, 0), Ab + kstep, cva[0]); PG8_STAGE(PG8_SB(1, 1), cB + hstep + kstep, voffB);
    PG8_WAIT_V(6); PG8_BAR;
    for (;;) {
        const bool has_next = S.next(ui + 1, nxt);
        const char* nB = cB;
        if (has_next) { S.a_off(nxt, tid, pitchB, nva); nB = S.b_ptr(nxt, g, pitchB); }
        else {
#pragma unroll
            for (int h = 0; h < 2; ++h)
#pragma unroll
                for (int i = 0; i < 2; ++i) nva[h][i] = cva[h][i];
        }
#pragma nounroll
        for (int t = 0; t < nt; t += 2) {
            const bool last = (t == nt - 2);
            const char* Abt = Ab; asm volatile("" : "+s"(Abt));
            const char* a1 = Abt + (size_t)(t + 1) * kstep;
            const char* a2 = last ? Abt : Abt + (size_t)(t + 2) * kstep; const char* b2 = last ? nB : cB + (size_t)(t + 2) * kstep;
            const char* a3 = a2 + kstep; const char* b3 = b2 + kstep;
            unsigned va2[2][2];
#pragma unroll
            for (int h = 0; h < 2; ++h)
#pragma unroll
                for (int i = 0; i < 2; ++i) va2[h][i] = last ? nva[h][i] : cva[h][i];
            PG8_LDB(B0, 0, 0); PG8_LDB(B1, 0, 1); PG8_SCHED; PG8_LDA(At, 0, 0); PG8_STAGE(PG8_SA(1, 1), a1, cva[1]);
            PG8_WAIT_V(8); PG8_WAIT_L(0); PG8_BAR; PG8_MMA(0, 0, At, B0); PG8_MMA(0, 1, At, B1); PG8_BAR; PG8_SCHED;
            PG8_LDA(At, 0, 1); PG8_STAGE(PG8_SB(0, 0), b2, voffB); PG8_STAGE(PG8_SB(0, 1), b2 + hstep, voffB); PG8_STAGE(PG8_SA(0, 0), a2, va2[0]);
            PG8_WAIT_V(8); PG8_WAIT_L(0); PG8_BAR; PG8_MMA(1, 0, At, B0); PG8_MMA(1, 1, At, B1); PG8_BAR; PG8_SCHED;
            PG8_LDB(B0, 1, 0); PG8_LDB(B1, 1, 1); PG8_SCHED; PG8_LDA(At, 1, 0); PG8_STAGE(PG8_SA(0, 1), a2, va2[1]);
            PG8_WAIT_V(8); PG8_WAIT_L(0); PG8_BAR; PG8_MMA(0, 0, At, B0); PG8_MMA(0, 1, At, B1); PG8_BAR; PG8_SCHED;
            PG8_LDA(At, 1, 1); PG8_STAGE(PG8_SB(1, 0), b3, voffB); PG8_STAGE(PG8_SB(1, 1), b3 + hstep, voffB); PG8_STAGE(PG8_SA(1, 0), a3, va2[0]);
            PG8_WAIT_V(8); PG8_WAIT_L(0); PG8_BAR; PG8_MMA(1, 0, At, B0); PG8_MMA(1, 1, At, B1); PG8_BAR; PG8_SCHED;
        }
        if constexpr (ALIGN_EPI) { if (wr == 0) PG8_BAR; }
        if constexpr (ES == 1) asm volatile("s_nop 11");
        E(acc, cur, wr, wc, fr, fq);
        if (!has_next) break;
#pragma unroll
        for (int a = 0; a < 2; ++a)
#pragma unroll
            for (int b = 0; b < 2; ++b)
#pragma unroll
                for (int m = 0; m < 4; ++m)
#pragma unroll
                    for (int n = 0; n < 2; ++n) acc[a][b][m][n] = (f32x4){0.f, 0.f, 0.f, 0.f};
        cur = nxt; cB = nB; ++ui;
#pragma unroll
        for (int h = 0; h < 2; ++h)
#pragma unroll
            for (int i = 0; i < 2; ++i) cva[h][i] = nva[h][i];
        if constexpr (ALIGN_EPI) { if (wr == 1) PG8_BAR; }
    }
    PG8_WAIT_V(0);
    if constexpr (!ALIGN_EPI) { if (wr == 0) PG8_BAR; }
    PG8_BAR;
#undef PG8_SA
#undef PG8_SB
#undef PG8_STAGE
#undef PG8_LDA
#undef PG8_LDB
#undef PG8_MMA
#undef PG8_WAIT_V
#undef PG8_WAIT_L
#undef PG8_BAR
#undef PG8_SCHED
}

__device__ __forceinline__ v4u pack8(const f32x4 a, const f32x4 b) { v4u w; w.x = pk2(a[0], a[1]); w.y = pk2(a[2], a[3]); w.z = pk2(b[0], b[1]); w.w = pk2(b[2], b[3]); return w; }
__device__ __forceinline__ void unpack8(const v4u w, f32x4& a, f32x4& b) { a = (f32x4){bflo(w.x), bfhi(w.x), bflo(w.y), bfhi(w.y)}; b = (f32x4){bflo(w.z), bfhi(w.z), bflo(w.w), bfhi(w.w)}; }

struct EpiPlain {
    static constexpr bool PERM = true;
    bf16* O; int ldc;
    __device__ __forceinline__ void operator()(const f32x4 (&acc)[2][2][4][2], const Unit& u, int wr, int wc, int fr, int fq) const {
        const int row0 = u.pm * BM + wr * 64 + fr, col0 = u.pn * BM + wc * 32 + 8 * fq;
#pragma unroll
        for (int ai = 0; ai < 2; ++ai)
#pragma unroll
            for (int m = 0; m < 4; ++m) { bf16* rowp = O + (size_t)(row0 + ai * HALF + m * 16) * ldc + col0;
#pragma unroll
                for (int bj = 0; bj < 2; ++bj) *(GAS v4u*)(rowp + bj * HALF) = pack8(acc[ai][bj][m][0], acc[ai][bj][m][1]); }
    }
};
struct EpiProj {
    static constexpr bool PERM = true;
    bf16 *U, *Q, *Kb, *GP, *GA;
    __device__ __forceinline__ void operator()(const f32x4 (&acc)[2][2][4][2], const Unit& u, int wr, int wc, int fr, int fq) const {
        const int pn = u.pn; bf16* base; int ldc, colt; float sc = 1.f; bool sig = false;
        if (pn < 2) { base = U; ldc = 512; colt = pn * 256; }
        else if (pn < 4) { base = Q; ldc = 512; colt = (pn - 2) * 256; sc = QSCALE; }
        else if (pn < 6) { base = Kb; ldc = 512; colt = (pn - 4) * 256; }
        else if (pn < 10) { base = GP; ldc = 1024; colt = (pn - 6) * 256; sig = true; }
        else { base = GA; ldc = 1024; colt = (pn - 10) * 256; sig = true; }
        const int row0 = u.pm * BM + wr * 64 + fr, col0 = colt + wc * 32 + 8 * fq;
#pragma unroll
        for (int ai = 0; ai < 2; ++ai)
#pragma unroll
            for (int m = 0; m < 4; ++m) { bf16* rowp = base + (size_t)(row0 + ai * HALF + m * 16) * ldc + col0;
#pragma unroll
                for (int bj = 0; bj < 2; ++bj) { f32x4 v0 = acc[ai][bj][m][0], v1 = acc[ai][bj][m][1];
                    if (sig) {
#pragma unroll
                        for (int j = 0; j < 4; ++j) { v0[j] = fast_sigmoid(v0[j]); v1[j] = fast_sigmoid(v1[j]); }
                    } else { v0 = v0 * sc; v1 = v1 * sc; }
                    *(GAS v4u*)(rowp + bj * HALF) = pack8(v0, v1); } }
    }
};
template <bool ADD> struct EpiGate {
    static constexpr bool PERM = true;
    bf16* O; const bf16* G;
    __device__ __forceinline__ void operator()(const f32x4 (&acc)[2][2][4][2], const Unit& u, int wr, int wc, int fr, int fq) const {
        const int row0 = u.pm * BM + wr * 64 + fr, col0 = u.pn * BM + wc * 32 + 8 * fq;
#pragma unroll
        for (int ai = 0; ai < 2; ++ai)
#pragma unroll
            for (int m = 0; m < 4; ++m) { const size_t ro = (size_t)(row0 + ai * HALF + m * 16) * 1024 + col0;
#pragma unroll
                for (int bj = 0; bj < 2; ++bj) { f32x4 g0, g1; unpack8(*(const GAS v4u*)(G + ro + bj * HALF), g0, g1);
                    f32x4 v0 = acc[ai][bj][m][0] * g0, v1 = acc[ai][bj][m][1] * g1;
                    if (ADD) { f32x4 o0, o1; unpack8(*(const GAS v4u*)(O + ro + bj * HALF), o0, o1); v0 = v0 + o0; v1 = v1 + o1; }
                    *(GAS v4u*)(O + ro + bj * HALF) = pack8(v0, v1); } }
    }
};
struct EpiResid {
    static constexpr bool PERM = true;
    bf16* O; const float* X;
    __device__ __forceinline__ void operator()(const f32x4 (&acc)[2][2][4][2], const Unit& u, int wr, int wc, int fr, int fq) const {
        const int row0 = u.pm * BM + wr * 64 + fr, col0 = u.pn * BM + wc * 32 + 8 * fq;
#pragma unroll
        for (int ai = 0; ai < 2; ++ai)
#pragma unroll
            for (int m = 0; m < 4; ++m) { const size_t ro = (size_t)(row0 + ai * HALF + m * 16) * 1024 + col0;
#pragma unroll
                for (int bj = 0; bj < 2; ++bj) { const f32x4 x0 = *(const GAS f32x4*)(X + ro + bj * HALF), x1 = *(const GAS f32x4*)(X + ro + bj * HALF + 4);
                    *(GAS v4u*)(O + ro + bj * HALF) = pack8(acc[ai][bj][m][0] + x0, acc[ai][bj][m][1] + x1); } }
    }
};
struct EpiPle {
    static constexpr bool PERM = true;
    bf16* O; const bf16* X2; const bf16* PP; const float* R3;
    __device__ __forceinline__ void operator()(const f32x4 (&acc)[2][2][4][2], const Unit& u, int wr, int wc, int fr, int fq) const {
        const int row0 = u.pm * BM + wr * 64 + fr, col0 = u.pn * BM + wc * 32 + 8 * fq;
#pragma unroll
        for (int ai = 0; ai < 2; ++ai)
#pragma unroll
            for (int m = 0; m < 4; ++m) { const int row = row0 + ai * HALF + m * 16; const size_t ro = (size_t)row * 1024 + col0; const float r = R3[row] * WSCALE_INV;
#pragma unroll
                for (int bj = 0; bj < 2; ++bj) { f32x4 x0, x1, p0, p1; unpack8(*(const GAS v4u*)(X2 + ro + bj * HALF), x0, x1); unpack8(*(const GAS v4u*)(PP + ro + bj * HALF), p0, p1);
                    f32x4 v0, v1;
#pragma unroll
                    for (int j = 0; j < 4; ++j) { v0[j] = x0[j] + fast_sigmoid(r * acc[ai][bj][m][0][j]) * p0[j]; v1[j] = x1[j] + fast_sigmoid(r * acc[ai][bj][m][1][j]) * p1[j]; }
                    *(GAS v4u*)(O + ro + bj * HALF) = pack8(v0, v1); } }
    }
};

template <bool GATHER> struct MoeOrder {
    const LAS int* tab; const int* row_token; const unsigned char* W; int NT, G, c, total; size_t wstride;
    __device__ __forceinline__ bool next(int i, Unit& u) const {
        const long L = (long)i * G + c; if (L >= total) return false;
        const int rt = (int)(L / NT); u.pn = (int)(L % NT);
        int e = 0;
#pragma unroll
        for (int j = 1; j < 32; ++j) e += (tab[j] <= rt) ? 1 : 0;
        e = __builtin_amdgcn_readfirstlane(e);
        const int lt = rt - __builtin_amdgcn_readfirstlane(tab[e]), cn = __builtin_amdgcn_readfirstlane(tab[65 + e]);
        u.e = e; u.pm = rt; u.row0 = __builtin_amdgcn_readfirstlane(tab[33 + e]) + lt * 256; u.nvalid = (cn - lt * 256) < 256 ? (cn - lt * 256) : 256; return true;
    }
    __device__ __forceinline__ void a_off(const Unit& u, int tid, int pitchB, unsigned (&va)[2][2]) const {
        int R[2], C[2];
#pragma unroll
        for (int i = 0; i < 2; ++i) stage_rc(tid * 16 + i * 8192, R[i], C[i]);
        if constexpr (GATHER) {
            int tok[2][2];
#pragma unroll
            for (int i = 0; i < 2; ++i)
#pragma unroll
                for (int h = 0; h < 2; ++h) { const int rl = h * HALF + R[i]; tok[h][i] = row_token[u.row0 + (rl < u.nvalid ? rl : 0)]; }
#pragma unroll
            for (int i = 0; i < 2; ++i)
#pragma unroll
                for (int h = 0; h < 2; ++h) va[h][i] = (unsigned)(tok[h][i] * pitchB + C[i] * 2);
        } else {
#pragma unroll
            for (int i = 0; i < 2; ++i)
#pragma unroll
                for (int h = 0; h < 2; ++h) va[h][i] = (unsigned)((u.row0 + h * HALF + R[i]) * pitchB + C[i] * 2);
        }
    }
    __device__ __forceinline__ const char* b_ptr(const Unit& u, const Gemm& g, int pitchB) const { return (const char*)(W + (size_t)u.e * wstride + (size_t)u.pn * 256 * pitchB); }
};
struct EpiMoe1 {
    static constexpr bool PERM = true;
    unsigned char* act; const float* bgu;
    __device__ __forceinline__ void operator()(const f32x4 (&acc)[2][2][4][2], const Unit& u, int wr, int wc, int fr, int fq) const {
        const int cl = u.pn * 128 + wc * 32 + 8 * fq;
        const float* bg = bgu + (size_t)u.e * 2048 + cl;
        const f32x4 g0b = *(const GAS f32x4*)(bg), g1b = *(const GAS f32x4*)(bg + 4), u0b = *(const GAS f32x4*)(bg + 1024), u1b = *(const GAS f32x4*)(bg + 1028);
#pragma unroll
        for (int ai = 0; ai < 2; ++ai)
#pragma unroll
            for (int m = 0; m < 4; ++m) { const int rl = ai * HALF + wr * 64 + m * 16 + fr;
                const f32x4 ga = acc[ai][0][m][0] * WSCALE_INV + g0b, gb = acc[ai][0][m][1] * WSCALE_INV + g1b, ua = acc[ai][1][m][0] * WSCALE_INV + u0b, ub = acc[ai][1][m][1] * WSCALE_INV + u1b;
                f32x4 o0, o1;
#pragma unroll
                for (int j = 0; j < 4; ++j) {
                    { const float gt = fminf(ga[j], 7.0f), up = fminf(fmaxf(ua[j], -7.0f), 7.0f); o0[j] = (up + 1.0f) * gt * fast_sigmoid(1.702f * gt); }
                    { const float gt = fminf(gb[j], 7.0f), up = fminf(fmaxf(ub[j], -7.0f), 7.0f); o1[j] = (up + 1.0f) * gt * fast_sigmoid(1.702f * gt); }
                }
                const int orow = rl < u.nvalid ? u.row0 + rl : M + rl;
                v2u o8; o8.x = pk4_fp8(o0[0], o0[1], o0[2], o0[3]); o8.y = pk4_fp8(o1[0], o1[1], o1[2], o1[3]);
                *(GAS v2u*)(act + (size_t)orow * 1024 + cl) = o8; }
    }
};
struct EpiMoe2 {
    static constexpr bool PERM = true;
    bf16* Y; const float* bdn;
    __device__ __forceinline__ void operator()(const f32x4 (&acc)[2][2][4][2], const Unit& u, int wr, int wc, int fr, int fq) const {
        const int col0 = u.pn * 256 + wc * 32 + 8 * fq;
        const float* bd = bdn + (size_t)u.e * 1024 + col0;
        f32x4 bv[2][2];
#pragma unroll
        for (int bj = 0; bj < 2; ++bj) { bv[bj][0] = *(const GAS f32x4*)(bd + bj * HALF); bv[bj][1] = *(const GAS f32x4*)(bd + bj * HALF + 4); }
#pragma unroll
        for (int ai = 0; ai < 2; ++ai)
#pragma unroll
            for (int m = 0; m < 4; ++m) { const int rl = ai * HALF + wr * 64 + m * 16 + fr;
                if (rl < u.nvalid) { bf16* rowp = Y + (size_t)(u.row0 + rl) * 1024 + col0;
#pragma unroll
                    for (int bj = 0; bj < 2; ++bj) *(GAS v4u*)(rowp + bj * HALF) = pack8(acc[ai][bj][m][0] * WSCALE_INV + bv[bj][0], acc[ai][bj][m][1] * WSCALE_INV + bv[bj][1]); } }
    }
};
}

struct Frame {
    LAS unsigned char* lds; volatile LAS unsigned* MISC; gu32* ctl;
    int wave, vcu, G;
};
struct Args { const float* in[20]; float* out; unsigned char* ws; int ph_lo, ph_hi; };

template <bool F8>
__device__ __forceinline__ void p0_transpose_item(const float* W, int N, int k0, int n0, void* WT, int Kp, int dst_row0, const float* gain, float scale, LAS float* scr, int lane) {
    f32x4 v[8]; float gs[8];
    const int kq = lane >> 3, n4 = 4 * (lane & 7);
#pragma unroll
    for (int i = 0; i < 8; ++i) v[i] = *(const GAS f32x4*)(W + (size_t)(k0 + kq + 8 * i) * N + n0 + n4);
#pragma unroll
    for (int i = 0; i < 8; ++i) gs[i] = gain ? gain[k0 + kq + 8 * i] * scale : scale;
#pragma unroll
    for (int i = 0; i < 8; ++i) { LAS float* s = scr + (kq + 8 * i) * 33 + n4; s[0] = v[i].x * gs[i]; s[1] = v[i].y * gs[i]; s[2] = v[i].z * gs[i]; s[3] = v[i].w * gs[i]; }
    LDS_WAIT(); asm volatile("" ::: "memory");
    if constexpr (!F8) {
        const int c = lane & 7;
#pragma unroll
        for (int j = 0; j < 4; ++j) { const int n = (lane >> 3) + 8 * j; const LAS float* s = scr + (8 * c) * 33 + n;
            v4u o; o.x = pk2(s[0 * 33], s[1 * 33]); o.y = pk2(s[2 * 33], s[3 * 33]); o.z = pk2(s[4 * 33], s[5 * 33]); o.w = pk2(s[6 * 33], s[7 * 33]);
            *(GAS v4u*)((bf16*)WT + (size_t)(dst_row0 + n) * Kp + k0 + 8 * c) = o; }
    } else {
        const int c = lane & 3;
#pragma unroll
        for (int j = 0; j < 2; ++j) { const int n = (lane >> 2) + 16 * j; const LAS float* s = scr + (16 * c) * 33 + n;
            v4u o; o.x = pk4_fp8(s[0 * 33], s[1 * 33], s[2 * 33], s[3 * 33]); o.y = pk4_fp8(s[4 * 33], s[5 * 33], s[6 * 33], s[7 * 33]);
            o.z = pk4_fp8(s[8 * 33], s[9 * 33], s[10 * 33], s[11 * 33]); o.w = pk4_fp8(s[12 * 33], s[13 * 33], s[14 * 33], s[15 * 33]);
            *(GAS v4u*)((unsigned char*)WT + (size_t)(dst_row0 + n) * Kp + k0 + 16 * c) = o; }
    }
    LDS_WAIT(); asm volatile("" ::: "memory");
}
__device__ __forceinline__ void rms_row_f32_to_bf16(const float* xrow, const float* g, bf16* orow, int lane) {
    const GAS f32x4* xr = (const GAS f32x4*)xrow + lane; const GAS f32x4* gr = (const GAS f32x4*)g + lane;
    f32x4 v[4]; float s = 0.f;
#pragma unroll
    for (int j = 0; j < 4; ++j) { v[j] = xr[64 * j]; s += (v[j].x * v[j].x + v[j].y * v[j].y) + (v[j].z * v[j].z + v[j].w * v[j].w); }
    const float r = 1.0f / sqrtf(wave_sum(s) * (1.f / D) + EPS);
    GAS v2u* o8 = (GAS v2u*)orow + lane;
#pragma unroll
    for (int j = 0; j < 4; ++j) { const f32x4 gg = gr[64 * j]; v2u o; o.x = pk2(v[j].x * r * gg.x, v[j].y * r * gg.y); o.y = pk2(v[j].z * r * gg.z, v[j].w * r * gg.w); o8[64 * j] = o; }
}

#define MFMA32(a, b, c) __builtin_amdgcn_mfma_f32_32x32x16_bf16((a), (b), (c), 0, 0, 0)
__device__ __forceinline__ bf16x8 ldg16(const bf16* p) { return *(const GAS bf16x8*)p; }
struct KVFrag { bf16x8 k[4], v[4]; };
__device__ __forceinline__ void att_load(KVFrag& f, const bf16* kbase, const bf16* vbase, int key0) {
    const int lk = key0 < 0 ? 0 : key0;
#pragma unroll
    for (int kk = 0; kk < 4; ++kk) f.k[kk] = ldg16(kbase + (size_t)lk * 512 + 16 * kk);
#pragma unroll
    for (int dj = 0; dj < 4; ++dj) f.v[dj] = ldg16(vbase + (size_t)(dj >> 1) * 32 * M + lk + 16 * (dj & 1));
}
__device__ __forceinline__ void att_tile(const KVFrag& f, const bf16x8 (&qf)[4], f32x16& o0, f32x16& o1, float& carry, bool diag, int l31, int hl) {
    f32x16 s;
#pragma unroll
    for (int r = 0; r < 16; ++r) s[r] = 0.f;
#pragma unroll
    for (int kk = 0; kk < 4; ++kk) s = MFMA32(f.k[kk], qf[kk], s);
    float sp[16], ls[16];
    float lo = 0.f, hi = 0.f;
#pragma unroll
    for (int r = 0; r < 16; ++r) {
        const int ko = (r < 8) ? (8 * hl + r) : (16 + 8 * hl + (r - 8));
        const float z = s[r];
        const float e = __builtin_amdgcn_exp2f(-fabsf(z));
        const float lg = __builtin_amdgcn_logf(1.0f + e);
        float spv = fmaxf(z, 0.f) + lg;
        float lsv = fminf(z, 0.f) - lg;
        if (diag && ko >= l31) { spv = 0.f; lsv = -1.0e30f; }
        sp[r] = spv; ls[r] = lsv;
        if (r < 8) lo += spv; else hi += spv;
    }
    const float plo = __shfl_xor(lo, 32), phi = __shfl_xor(hi, 32);
    const float after_lo = (hl == 0) ? (plo + hi + phi) : (hi + phi);
    const float after_hi = (hl == 0) ? phi : 0.f;
    float w[16];
    { float run = carry + after_lo;
#pragma unroll
      for (int r = 7; r >= 0; --r) { w[r] = __builtin_amdgcn_exp2f(ls[r] - run); run += sp[r]; } }
    { float run = carry + after_hi;
#pragma unroll
      for (int r = 15; r >= 8; --r) { w[r] = __builtin_amdgcn_exp2f(ls[r] - run); run += sp[r]; } }
    carry += (lo + hi) + (plo + phi);
    v4u w0, w1;
    w0.x = pk2(w[0], w[1]); w0.y = pk2(w[2], w[3]); w0.z = pk2(w[4], w[5]); w0.w = pk2(w[6], w[7]);
    w1.x = pk2(w[8], w[9]); w1.y = pk2(w[10], w[11]); w1.z = pk2(w[12], w[13]); w1.w = pk2(w[14], w[15]);
    const bf16x8 W0 = __builtin_bit_cast(bf16x8, w0), W1 = __builtin_bit_cast(bf16x8, w1);
    o0 = MFMA32(f.v[0], W0, o0); o0 = MFMA32(f.v[1], W1, o0);
    o1 = MFMA32(f.v[2], W0, o1); o1 = MFMA32(f.v[3], W1, o1);
}
__device__ __forceinline__ void attn_task(const bf16* __restrict__ Q, const bf16* __restrict__ Kp, const bf16* __restrict__ Vt, bf16* __restrict__ Y, int b, int h, int qb, int lane) {
    const int l31 = lane & 31, hl = lane >> 5;
    const int t0 = qb * 32; const size_t tb = (size_t)b * SEQ;
    bf16x8 qf[4];
    { const bf16* qrow = Q + (tb + t0 + l31) * 512 + h * 64 + 8 * hl;
#pragma unroll
      for (int kk = 0; kk < 4; ++kk) qf[kk] = ldg16(qrow + 16 * kk); }
    const int a_ = l31 >> 3, hh = (l31 >> 2) & 1, c_ = l31 & 3;
    const int pim = 16 * (a_ >> 1) + 8 * hh + 4 * (a_ & 1) + c_;
    const bf16* kbase = Kp + (tb + pim) * 512 + h * 64 + 8 * hl;
    const bf16* vbase = Vt + (size_t)(h * 64 + l31) * M + tb + 8 * hl;
    f32x16 o0, o1;
#pragma unroll
    for (int r = 0; r < 16; ++r) { o0[r] = 0.f; o1[r] = 0.f; }
    float carry = 0.f;
    int key0 = t0;
    KVFrag b0, b1, b2;
    att_load(b0, kbase, vbase, key0); att_load(b1, kbase, vbase, key0 - 32);
    bool diag = true;
#define ATT_STEP(cur, pre) { att_load(pre, kbase, vbase, key0 - 64); att_tile(cur, qf, o0, o1, carry, diag, l31, hl); diag = false; \
        if (key0 - 32 < 0) break; if (__all(carry >= ATT_THR)) break; key0 -= 32; }
    for (;;) { ATT_STEP(b0, b2) ATT_STEP(b1, b0) ATT_STEP(b2, b1) }
#undef ATT_STEP
    bf16* yrow = Y + (tb + t0 + l31) * 512 + h * 64 + 4 * hl;
#pragma unroll
    for (int a = 0; a < 4; ++a) {
        v2u p0, p1; p0.x = pk2(o0[4 * a], o0[4 * a + 1]); p0.y = pk2(o0[4 * a + 2], o0[4 * a + 3]); p1.x = pk2(o1[4 * a], o1[4 * a + 1]); p1.y = pk2(o1[4 * a + 2], o1[4 * a + 3]);
        *(GAS v2u*)(yrow + 8 * a) = p0; *(GAS v2u*)(yrow + 32 + 8 * a) = p1;
    }
}

__device__ __forceinline__ void pool_unpack(const v4u v, float (&f)[8]) { f[0] = bflo(v.x); f[1] = bfhi(v.x); f[2] = bflo(v.y); f[3] = bfhi(v.y); f[4] = bflo(v.z); f[5] = bfhi(v.z); f[6] = bflo(v.w); f[7] = bfhi(v.w); }
__device__ __forceinline__ void pool_item(const bf16* __restrict__ U, bf16* __restrict__ P, int tok0, int lane) {
    const int t0 = tok0 & (SEQ - 1); const int g = lane >> 4; const int w = 2 << g;
    v4u row[31];
#pragma unroll
    for (int r = 0; r < 31; ++r) { const int rr = (t0 == 0 && r < 15) ? 15 : r; row[r] = *(const GAS v4u*)(U + (size_t)(tok0 - 15 + rr) * 512 + 8 * lane); }
    if (t0 == 0) {
#pragma unroll
        for (int r = 0; r < 15; ++r) row[r] = (v4u){0u, 0u, 0u, 0u};
    }
    float S[8], f[8];
    pool_unpack(row[15], S); pool_unpack(row[14], f);
#pragma unroll
    for (int q = 0; q < 8; ++q) S[q] += f[q];
    float acc4[8], acc8[8], acc16[8];
#pragma unroll
    for (int q = 0; q < 8; ++q) acc4[q] = S[q];
#pragma unroll
    for (int r = 13; r >= 12; --r) { pool_unpack(row[r], f);
#pragma unroll
        for (int q = 0; q < 8; ++q) acc4[q] += f[q]; }
#pragma unroll
    for (int q = 0; q < 8; ++q) acc8[q] = acc4[q];
#pragma unroll
    for (int r = 11; r >= 8; --r) { pool_unpack(row[r], f);
#pragma unroll
        for (int q = 0; q < 8; ++q) acc8[q] += f[q]; }
#pragma unroll
    for (int q = 0; q < 8; ++q) acc16[q] = acc8[q];
#pragma unroll
    for (int r = 7; r >= 0; --r) { pool_unpack(row[r], f);
#pragma unroll
        for (int q = 0; q < 8; ++q) acc16[q] += f[q]; }
#pragma unroll
    for (int q = 0; q < 8; ++q) S[q] = (g == 0) ? S[q] : (g == 1 ? acc4[q] : (g == 2 ? acc8[q] : acc16[q]));
#pragma unroll
    for (int i = 0; i < 16; ++i) {
        float cur[8]; pool_unpack(row[15 + i], cur);
        if (i > 0) {
            const v4u lv = (g == 0) ? row[15 + i - 2] : (g == 1 ? row[15 + i - 4] : (g == 2 ? row[15 + i - 8] : row[15 + i - 16]));
            pool_unpack(lv, f);
#pragma unroll
            for (int q = 0; q < 8; ++q) S[q] += cur[q] - f[q];
        }
        const int t = t0 + i; const int cnt = (t + 1) < w ? (t + 1) : w; const float inv = 1.0f / (float)cnt;
        v4u o; o.x = pk2(S[0] * inv - cur[0], S[1] * inv - cur[1]); o.y = pk2(S[2] * inv - cur[2], S[3] * inv - cur[3]);
        o.z = pk2(S[4] * inv - cur[4], S[5] * inv - cur[5]); o.w = pk2(S[6] * inv - cur[6], S[7] * inv - cur[7]);
        *(GAS v4u*)(P + (size_t)(tok0 + i) * 512 + 8 * lane) = o;
    }
}

__device__ __forceinline__ void router_task(const bf16* __restrict__ X1, const bf16* __restrict__ WrF, const float* __restrict__ b_router, int T0, int lane,
                                            float* __restrict__ R2_, unsigned char* __restrict__ H2, int* __restrict__ TKE_, float* __restrict__ TKW_, LAS int* lds_e  ) {
    const int l31 = lane & 31, hl = lane >> 5;
    const bf16* xr = X1 + (size_t)(T0 + l31) * 1024 + 8 * hl;
    f32x16 acc;
#pragma unroll
    for (int r = 0; r < 16; ++r) acc[r] = 0.f;
    float ssq = 0.f;
#pragma unroll 8
    for (int kk = 0; kk < 64; ++kk) {
        const v4u xv = *(const GAS v4u*)(xr + 16 * kk);
        const bf16x8 ah = ldg16(WrF + ((size_t)kk * 64 + lane) * 8), al = ldg16(WrF + 32768 + ((size_t)kk * 64 + lane) * 8);
        const float f0 = bflo(xv.x), f1 = bfhi(xv.x), f2 = bflo(xv.y), f3 = bfhi(xv.y), f4 = bflo(xv.z), f5 = bfhi(xv.z), f6 = bflo(xv.w), f7 = bfhi(xv.w);
        ssq += (f0 * f0 + f1 * f1) + (f2 * f2 + f3 * f3) + (f4 * f4 + f5 * f5) + (f6 * f6 + f7 * f7);
        const bf16x8 xb = __builtin_bit_cast(bf16x8, xv);
        acc = MFMA32(ah, xb, acc); acc = MFMA32(al, xb, acc);
    }
    ssq += __shfl_xor(ssq, 32);
    const float r = 1.0f / sqrtf(ssq * (1.f / D) + EPS);
    {
        unsigned char* hr = H2 + (size_t)(T0 + l31) * 1024 + 8 * hl;
#pragma unroll 8
        for (int kk = 0; kk < 64; ++kk) { const v4u xv = *(const GAS v4u*)(xr + 16 * kk);
            v2u o; o.x = pk4_fp8(bflo(xv.x) * r, bfhi(xv.x) * r, bflo(xv.y) * r, bfhi(xv.y) * r); o.y = pk4_fp8(bflo(xv.z) * r, bfhi(xv.z) * r, bflo(xv.w) * r, bfhi(xv.w) * r);
            *(GAS v2u*)(hr + 16 * kk) = o; }
    }
    float v[16];
#pragma unroll
    for (int q = 0; q < 16; ++q) { const int e = 8 * (q >> 2) + 4 * hl + (q & 3); v[q] = acc[q] * r + b_router[e]; }
    float cv[8]; int ce[8];
#pragma unroll
    for (int k = 0; k < 4; ++k) {
        float best = -3.0e38f; int bi = 0;
#pragma unroll
        for (int q = 0; q < 16; ++q) { if (v[q] > best) { best = v[q]; bi = q; } }
        cv[k] = best; ce[k] = 8 * (bi >> 2) + 4 * hl + (bi & 3);
#pragma unroll
        for (int q = 0; q < 16; ++q) { if (q == bi) v[q] = -3.0e38f; }
    }
#pragma unroll
    for (int k = 0; k < 4; ++k) { cv[4 + k] = __shfl_xor(cv[k], 32); ce[4 + k] = __shfl_xor(ce[k], 32); }
    float tv[4]; int te[4];
#pragma unroll
    for (int k = 0; k < 4; ++k) {
        float best = -3.0e38f; int be = 1 << 20; int bi = 0;
#pragma unroll
        for (int q = 0; q < 8; ++q) { if (cv[q] > best || (cv[q] == best && ce[q] < be)) { best = cv[q]; be = ce[q]; bi = q; } }
        tv[k] = best; te[k] = be;
#pragma unroll
        for (int q = 0; q < 8; ++q) { if (q == bi) { cv[q] = -3.0e38f; ce[q] = 1 << 21; } }
    }
    const float p1 = __expf(tv[1] - tv[0]), p2 = __expf(tv[2] - tv[0]), p3 = __expf(tv[3] - tv[0]);
    const float inv = 1.0f / (1.0f + p1 + p2 + p3);
    if (hl == 0) {
        const int tok = T0 + l31;
        R2_[tok] = r;
        *(GAS v4i*)(TKE_ + (size_t)tok * 4) = (v4i){te[0], te[1], te[2], te[3]};
        *(GAS f32x4*)(TKW_ + (size_t)tok * 4) = (f32x4){inv, p1 * inv, p2 * inv, p3 * inv};
        lds_e[l31 * 4 + 0] = te[0]; lds_e[l31 * 4 + 1] = te[1]; lds_e[l31 * 4 + 2] = te[2]; lds_e[l31 * 4 + 3] = te[3];
    }
}


#define IN_(i) (args.in[i])
#define x_ IN_(0)
#define p_in IN_(1)
#define g_mix IN_(2)
#define w_in IN_(3)
#define w_pool_grp IN_(4)
#define pool_scale IN_(5)
#define w_pool_up IN_(6)
#define w_attn_up IN_(7)
#define w_out IN_(8)
#define g_ffn IN_(9)
#define w_router IN_(10)
#define b_router IN_(11)
#define w_gu IN_(12)
#define b_gu IN_(13)
#define w_down IN_(14)
#define b_down IN_(15)
#define g_ple IN_(16)
#define w_ple_gate IN_(17)
#define w_ple_proj IN_(18)
#define g_final IN_(19)
#define WSP(T, off) ((T*)(args.ws + (off)))
#define R2 WSP(float, WS_R2)
#define R3 WSP(float, WS_R3)
#define TKE WSP(int, WS_TKE)
#define TKW WSP(float, WS_TKW)
#define TKR WSP(int, WS_TKR)
#define ROWT WSP(int, WS_ROWT)
#define CNTWG WSP(int, WS_CNTWG)
#define SEGTOT WSP(int, WS_SEGTOT)
#define WRF WSP(bf16, WS_WRF)
#define WIN WSP(bf16, WS_WIN)
#define WEFF WSP(bf16, WS_WEFF)
#define WAU WSP(bf16, WS_WAU)
#define WOUT WSP(bf16, WS_WOUT)
#define WPG WSP(unsigned char, WS_WPG)
#define X2F8 WSP(unsigned char, WS_H2F8)
#define WPP WSP(bf16, WS_WPP)
#define WGU WSP(unsigned char, WS_WGU)
#define WDN WSP(unsigned char, WS_WDN)
#define H2F8 WSP(unsigned char, WS_H2F8)
#define TKS WSP(int, WS_TKS)
#define H1 WSP(bf16, WS_A)
#define MRG WSP(bf16, WS_A)
#define PPB WSP(bf16, WS_A)
#define UB WSP(bf16, WS_B)
#define QB WSP(bf16, WS_B + 64 * MiB)
#define X1 WSP(bf16, WS_B)
#define KB WSP(bf16, WS_C)
#define VT WSP(bf16, WS_C + 64 * MiB)
#define X2 WSP(bf16, WS_B)
#define POOL WSP(bf16, WS_E)
#define YATT WSP(bf16, WS_E + 64 * MiB)
#define X3 WSP(bf16, WS_E)
#define PB WSP(bf16, WS_PB)
#define GPB WSP(bf16, WS_G)
#define GAB WSP(bf16, WS_G + 128 * MiB)
#define ACT WSP(unsigned char, WS_G)

__global__ void __launch_bounds__(NWAVES * 64, 2) mk_fwd(Args args) {
    extern __shared__ __attribute__((aligned(16))) unsigned char lds[];
    Frame F;
    F.lds = (LAS unsigned char*)lds;
    F.MISC = (volatile LAS unsigned*)(F.lds + MISC_OFF);
    F.wave = __builtin_amdgcn_readfirstlane((int)threadIdx.x >> 6);
    F.G = gridDim.x; { const int bx = blockIdx.x; F.vcu = (F.G % 8 == 0) ? (bx % 8) * (F.G / 8) + bx / 8 : bx; }
    unsigned char* ws = args.ws;
    F.ctl = (gu32*)(ws + WS_CTL);
    for (int u = (int)threadIdx.x; u < (LDS_BYTES - LDSCTL_OFF) / 4; u += NWAVES * 64) ((LAS unsigned*)(F.lds + LDSCTL_OFF))[u] = 0u;
    __syncthreads();
    const int lo = args.ph_lo, hi = args.ph_hi;
    XcdBarrier bar; bar.bar = (unsigned*)(F.ctl + CW_BAR); bar.x = 0; bar.st = nullptr;
    if (hi - lo > 1) bar = xcd_barrier_post((unsigned*)(F.ctl + CW_BAR), F.MISC + 8, F.wave);
#define IN(k) (lo <= (k) && (k) < hi)
#define BOTH(k) (IN(k) && IN((k) + 1))
#define GRID_BAR() xcd_barrier(bar, F.wave)

    const int gw = F.vcu * NWAVES + F.wave, NGW = F.G * NWAVES;
    LAS int* ltab = (LAS int*)(F.lds + LDS_TAB_OFF);

    if (IN(0)) { for (int rep_ = 0; rep_ < REPS(0); ++rep_) {
        const int lane_ = lane_id_v(), tid_ = F.wave * 64 + lane_;
        LAS float* scr = (LAS float*)(F.lds + F.wave * 16384);
        constexpr int I_IN = 16 * 128, I_AU = 8 * 32, I_OUT = 16 * 32, I_PG = 16 * 32, I_PP = 4 * 32, I_GU = 32 * 16 * 64, I_DN = 32 * 16 * 32;
        constexpr int NITEMS = I_IN + I_AU + I_OUT + I_PG + I_PP + I_GU + I_DN;
        for (int it = gw; it < NITEMS; it += NGW) {
            int r = it;
            if (r < I_IN) { const int kb = r / 128, nb = r % 128, n0 = nb * 32;
                const int blk = n0 / 512; const int dst = (blk < 3) ? n0 : (blk == 3 ? 3584 + (n0 - 1536) : n0 - 512);
                p0_transpose_item<false>(w_in, 4096, kb * 64, n0, WIN, 1024, dst, nullptr, 1.0f, scr, lane_); continue; } r -= I_IN;
            if (r < I_AU) { const int kb = r / 32, nb = r % 32; p0_transpose_item<false>(w_attn_up, 1024, kb * 64, nb * 32, WAU, 512, nb * 32, nullptr, 1.0f, scr, lane_); continue; } r -= I_AU;
            if (r < I_OUT) { const int kb = r / 32, nb = r % 32; p0_transpose_item<false>(w_out, 1024, kb * 64, nb * 32, WOUT, 1024, nb * 32, nullptr, 1.0f, scr, lane_); continue; } r -= I_OUT;
            if (r < I_PG) { const int kb = r / 32, nb = r % 32; p0_transpose_item<true>(w_ple_gate, 1024, kb * 64, nb * 32, WPG, 1024, nb * 32, g_ple, WSCALE, scr, lane_); continue; } r -= I_PG;
            if (r < I_PP) { const int kb = r / 32, nb = r % 32; p0_transpose_item<false>(w_ple_proj, 1024, kb * 64, nb * 32, WPP, 256, nb * 32, nullptr, 1.0f, scr, lane_); continue; } r -= I_PP;
            if (r < I_GU) { const int e = r / 1024, q = r % 1024, kb = q / 64, nb = q % 64, n0 = nb * 32;
                const int j = n0 & 1023; const int dst = 256 * (j / 128) + (j % 128) + (n0 >= 1024 ? 128 : 0);
                p0_transpose_item<true>(w_gu + (size_t)e * 1024 * 2048, 2048, kb * 64, n0, WGU + (size_t)e * 2048 * 1024, 1024, dst, g_ffn, WSCALE, scr, lane_); continue; } r -= I_GU;
            { const int e = r / 512, q = r % 512, kb = q / 32, nb = q % 32;
                p0_transpose_item<true>(w_down + (size_t)e * 1024 * 1024, 1024, kb * 64, nb * 32, WDN + (size_t)e * 1024 * 1024, 1024, nb * 32, nullptr, WSCALE, scr, lane_); }
        }
        for (int it = gw; it < 4 * 16 * 16; it += NGW) {
            const int g = it >> 8, cb = (it >> 4) & 15, db = it & 15; const int d = db * 64 + lane_, c0 = cb * 8;
            float a8[8];
#pragma unroll
            for (int q = 0; q < 8; ++q) a8[q] = 0.f;
            for (int j = 0; j < 128; ++j) { const float wv = w_pool_up[(size_t)(g * 128 + j) * 1024 + d] * pool_scale[g * 128 + j];
#pragma unroll
                for (int q = 0; q < 8; ++q) a8[q] += w_pool_grp[(size_t)(g * 128 + c0 + q) * 128 + j] * wv; }
            v4u o; o.x = pk2(a8[0], a8[1]); o.y = pk2(a8[2], a8[3]); o.z = pk2(a8[4], a8[5]); o.w = pk2(a8[6], a8[7]);
            *(GAS v4u*)(WEFF + (size_t)d * 512 + g * 128 + c0) = o;
        }
        for (int it = gw * 64 + lane_; it < 64 * 64; it += NGW * 64) {
            const int kk = it >> 6, l = it & 63, e = l & 31, k0 = 16 * kk + 8 * (l >> 5);
            unsigned hb[8], lb[8];
#pragma unroll
            for (int i = 0; i < 8; ++i) { const float v = g_ffn[k0 + i] * w_router[(size_t)(k0 + i) * 32 + e]; hb[i] = f2bf(v); lb[i] = f2bf(v - __builtin_bit_cast(float, hb[i] << 16)); }
            v4u oh, ol; oh.x = hb[0] | (hb[1] << 16); oh.y = hb[2] | (hb[3] << 16); oh.z = hb[4] | (hb[5] << 16); oh.w = hb[6] | (hb[7] << 16);
            ol.x = lb[0] | (lb[1] << 16); ol.y = lb[2] | (lb[3] << 16); ol.z = lb[4] | (lb[5] << 16); ol.w = lb[6] | (lb[7] << 16);
            *(GAS v4u*)(WRF + (size_t)it * 8) = oh; *(GAS v4u*)(WRF + 32768 + (size_t)it * 8) = ol;
        }
        for (int m = gw; m < M; m += NGW) rms_row_f32_to_bf16(x_ + (size_t)m * D, g_mix, H1 + (size_t)m * D, lane_);
        for (size_t i = (size_t)gw * 64 + lane_; i < (size_t)M * PLE / 8; i += (size_t)NGW * 64) {
            const f32x4 a = *(const GAS f32x4*)(p_in + i * 8), b = *(const GAS f32x4*)(p_in + i * 8 + 4);
            *(GAS v4u*)(PB + i * 8) = pg8::pack8(a, b);
        }
        if (BOTH(0) || rep_ + 1 < REPS(0)) GRID_BAR();
    } }

    if (IN(1)) { for (int rep_ = 0; rep_ < REPS(1); ++rep_) {
        { pg8::Gemm g{H1, WIN, D}; pg8::StaticOrder S; S.init(M, NPROJ_A, F.G, (int)blockIdx.x);
          pg8::EpiProj E{UB, QB, KB, GPB, GAB};
          pg8::gemm_phase<pg8::EpiProj, pg8::StaticOrder, true>(F.lds, g, S, E, F.wave); }
        { pg8::Gemm g{WIN + (size_t)NPROJ_A * D, H1, D}; pg8::StaticOrder S; S.init(512, M, F.G, (int)blockIdx.x);
          pg8::EpiPlain E{VT, M};
          pg8::gemm_phase<pg8::EpiPlain, pg8::StaticOrder, true>(F.lds, g, S, E, F.wave); }
        if (BOTH(1) || rep_ + 1 < REPS(1)) GRID_BAR();
    } }

    if (IN(2)) { for (int rep_ = 0; rep_ < REPS(2); ++rep_) {
        const int lane_ = lane_id_v(), tid_ = F.wave * 64 + lane_;
        for (int T = gw; T < NB * NH * (SEQ / 32); T += NGW) {
            const int qb = T & 127, h = (T >> 7) & 7, b = T >> 10;
            attn_task(QB, KB, VT, YATT, b, h, qb, lane_);
        }
        for (int it = gw; it < M / 16; it += NGW) pool_item(UB, POOL, it * 16, lane_);
        if (BOTH(2) || rep_ + 1 < REPS(2)) GRID_BAR();
    } }

    if (IN(3)) { for (int rep_ = 0; rep_ < REPS(3); ++rep_) {
        pg8::Gemm g{POOL, WEFF, PW}; pg8::StaticOrder S; S.init(M, D, F.G, (int)blockIdx.x);
        pg8::EpiGate<false> E{MRG, GPB};
        pg8::gemm_phase<pg8::EpiGate<false>, pg8::StaticOrder, true>(F.lds, g, S, E, F.wave);
        if (BOTH(3) || rep_ + 1 < REPS(3)) GRID_BAR();
    } }
    if (IN(4)) {
        pg8::Gemm g{YATT, WAU, AW}; pg8::StaticOrder S; S.init(M, D, F.G, (int)blockIdx.x);
        pg8::EpiGate<true> E{MRG, GAB};
        pg8::gemm_phase<pg8::EpiGate<true>, pg8::StaticOrder, true>(F.lds, g, S, E, F.wave);
        if (BOTH(4)) GRID_BAR();
    }
    if (IN(5)) { for (int rep_ = 0; rep_ < REPS(5); ++rep_) {
        pg8::Gemm g{MRG, WOUT, D}; pg8::StaticOrder S; S.init(M, D, F.G, (int)blockIdx.x);
        pg8::EpiResid E{X1, x_};
        pg8::gemm_phase<pg8::EpiResid, pg8::StaticOrder, true>(F.lds, g, S, E, F.wave);
        if (BOTH(5) || rep_ + 1 < REPS(5)) GRID_BAR();
    } }

    if (IN(6)) { for (int rep_ = 0; rep_ < REPS(6); ++rep_) {
        const int lane_ = lane_id_v(), tid_ = F.wave * 64 + lane_;
        LAS int* lcnt = ltab;
        LAS int* le = ltab + 128;
        for (int chunk = F.vcu; chunk < M / 256; chunk += F.G) {
            if (tid_ < 128) lcnt[tid_] = 0;
            router_task(X1, WRF, b_router, chunk * 256 + F.wave * 32, lane_, R2, H2F8, TKE, TKW, le + F.wave * 128);
            __syncthreads();
            if (tid_ < 256) {
                const int tok = chunk * 256 + tid_; v4i rk;
#pragma unroll
                for (int k = 0; k < 4; ++k) rk[k] = __hip_atomic_fetch_add((int*)(lcnt + k * 32 + le[tid_ * 4 + k]), 1, __ATOMIC_RELAXED, __HIP_MEMORY_SCOPE_WORKGROUP);
                *(GAS v4i*)(TKR + (size_t)tok * 4) = rk;
            }
            __syncthreads();
            if (tid_ < 128) CNTWG[chunk * 128 + tid_] = lcnt[tid_];
            __syncthreads();
        }
        if (BOTH(6) || rep_ + 1 < REPS(6)) GRID_BAR();
    } }

    if (IN(7)) { for (int rep_ = 0; rep_ < REPS(7); ++rep_) {
        const int lane_ = lane_id_v(), tid_ = F.wave * 64 + lane_;
        LAS int* part = ltab;
        LAS int* tot = ltab + 1024;
        LAS int* below = ltab + 1152;
        LAS int* base = ltab + 1280;
        for (int chunk = F.vcu; chunk < M / 256; chunk += F.G) {
            { const int s = tid_ & 127, q = tid_ >> 7; int st = 0, sb = 0;
              for (int c2 = q * 64; c2 < q * 64 + 64; ++c2) { const int v = CNTWG[c2 * 128 + s]; st += v; sb += (c2 < chunk) ? v : 0; }
              part[(q * 128 + s) * 2] = st; part[(q * 128 + s) * 2 + 1] = sb; }
            __syncthreads();
            if (tid_ < 128) { int st = 0, sb = 0;
#pragma unroll
                for (int q = 0; q < 4; ++q) { st += part[(q * 128 + tid_) * 2]; sb += part[(q * 128 + tid_) * 2 + 1]; }
                tot[tid_] = st; below[tid_] = sb; }
            __syncthreads();
            if (tid_ < 128) { const int k = tid_ >> 5, e = tid_ & 31; int pre = 0;
                for (int e2 = 0; e2 < e; ++e2) pre += tot[k * 32 + e2];
                base[tid_] = k * M + pre + below[tid_];
                if (chunk == 0) SEGTOT[tid_] = tot[tid_]; }
            __syncthreads();
            if (tid_ < 256) { const int tok = chunk * 256 + tid_;
                const v4i te = *(const GAS v4i*)(TKE + (size_t)tok * 4), rk = *(const GAS v4i*)(TKR + (size_t)tok * 4); v4i sl;
#pragma unroll
                for (int k = 0; k < 4; ++k) { const int slot = base[k * 32 + te[k]] + rk[k]; ROWT[slot] = tok; sl[k] = slot - k * M; }
                *(GAS v4i*)(TKS + (size_t)tok * 4) = sl; }
            __syncthreads();
        }
        if (BOTH(7) || rep_ + 1 < REPS(7)) GRID_BAR();
    } }

    for (int k = 0; k < 4; ++k) {
        if (IN(8 + 2 * k) || IN(9 + 2 * k)) {
            const int tid_ = F.wave * 64 + lane_id_v();
            __syncthreads();
            if (tid_ < 32) {
                const int cn = SEGTOT[k * 32 + tid_]; int nt_ = (cn + 255) >> 8, pt = nt_, ps = cn;
#pragma unroll
                for (int o = 1; o < 32; o <<= 1) { const int a = __shfl_up(pt, o), b = __shfl_up(ps, o); if (tid_ >= o) { pt += a; ps += b; } }
                ltab[tid_] = pt - nt_; ltab[33 + tid_] = ps - cn; ltab[65 + tid_] = cn; if (tid_ == 31) ltab[32] = pt; }
            __syncthreads();
        }
        const int T = __builtin_amdgcn_readfirstlane(ltab[32]);
        if (IN(8 + 2 * k)) { for (int rep_ = 0; rep_ < REPS(8 + 2 * k); ++rep_) {
            pg8::Gemm g{H2F8, WGU, D};
            pg8::MoeOrder<true> S{ltab, ROWT + (size_t)k * M, WGU, 8, F.G, F.vcu, T * 8, (size_t)2048 * 1024};
            pg8::EpiMoe1 E{ACT, b_gu};
            pg8::gemm_phase<pg8::EpiMoe1, pg8::MoeOrder<true>, MOE_ALIGN, 1>(F.lds, g, S, E, F.wave);
            if (BOTH(8 + 2 * k) || rep_ + 1 < REPS(8 + 2 * k)) GRID_BAR();
        } }
        if (IN(9 + 2 * k)) { for (int rep_ = 0; rep_ < REPS(9 + 2 * k); ++rep_) {
            pg8::Gemm g{ACT, WDN, DE};
            pg8::MoeOrder<false> S{ltab, ROWT + (size_t)k * M, WDN, 4, F.G, F.vcu, T * 4, (size_t)1024 * 1024};
            pg8::EpiMoe2 E{WSP(bf16, k == 0 ? WS_A : (k == 1 ? WS_C : (k == 2 ? WS_E : WS_Y3))), b_down};
            pg8::gemm_phase<pg8::EpiMoe2, pg8::MoeOrder<false>, MOE_ALIGN, 1>(F.lds, g, S, E, F.wave);
            if (BOTH(9 + 2 * k) || rep_ + 1 < REPS(9 + 2 * k)) GRID_BAR();
        } }
    }

    if (IN(16)) { for (int rep_ = 0; rep_ < REPS(16); ++rep_) {
        const int lane_ = lane_id_v();
        for (int t0 = gw * 4; t0 < M; t0 += NGW * 4) {
            v4i sl[4]; f32x4 tw[4];
#pragma unroll
            for (int i = 0; i < 4; ++i) { sl[i] = *(const GAS v4i*)(TKS + (size_t)(t0 + i) * 4); tw[i] = *(const GAS f32x4*)(TKW + (size_t)(t0 + i) * 4); }
#pragma unroll
            for (int i = 0; i < 4; ++i) {
                bf16* xrow = X1 + (size_t)(t0 + i) * D;
                v4u xv[2], yv[4][2];
#pragma unroll
                for (int j = 0; j < 2; ++j) { xv[j] = ((const GAS v4u*)xrow)[64 * j + lane_];
                    yv[0][j] = ((const GAS v4u*)(WSP(bf16, WS_A) + (size_t)sl[i][0] * D))[64 * j + lane_]; yv[1][j] = ((const GAS v4u*)(WSP(bf16, WS_C) + (size_t)sl[i][1] * D))[64 * j + lane_];
                    yv[2][j] = ((const GAS v4u*)(WSP(bf16, WS_E) + (size_t)sl[i][2] * D))[64 * j + lane_]; yv[3][j] = ((const GAS v4u*)(WSP(bf16, WS_Y3) + (size_t)sl[i][3] * D))[64 * j + lane_]; }
                float s = 0.f;
#pragma unroll
                for (int j = 0; j < 2; ++j) { f32x4 a0, a1; pg8::unpack8(xv[j], a0, a1);
#pragma unroll
                    for (int k = 0; k < 4; ++k) { f32x4 y0, y1; pg8::unpack8(yv[k][j], y0, y1); a0 = a0 + y0 * tw[i][k]; a1 = a1 + y1 * tw[i][k]; }
                    const v4u o = pg8::pack8(a0, a1); f32x4 b0, b1; pg8::unpack8(o, b0, b1);
                    s += (b0[0] * b0[0] + b0[1] * b0[1]) + (b0[2] * b0[2] + b0[3] * b0[3]) + (b1[0] * b1[0] + b1[1] * b1[1]) + (b1[2] * b1[2] + b1[3] * b1[3]);
                    ((GAS v4u*)xrow)[64 * j + lane_] = o;
                    v2u o8; o8.x = pk4_fp8(b0[0], b0[1], b0[2], b0[3]); o8.y = pk4_fp8(b1[0], b1[1], b1[2], b1[3]);
                    ((GAS v2u*)(X2F8 + (size_t)(t0 + i) * D))[64 * j + lane_] = o8; }
                s = wave_sum(s);
                if (lane_ == 0) R3[t0 + i] = 1.0f / sqrtf(s * (1.f / D) + EPS);
            }
        }
        if (BOTH(16) || rep_ + 1 < REPS(16)) GRID_BAR();
    } }
    if (IN(17)) { for (int rep_ = 0; rep_ < REPS(17); ++rep_) {
        pg8::Gemm g{PB, WPP, PLE}; pg8::StaticOrder S; S.init(M, D, F.G, (int)blockIdx.x);
        pg8::EpiPlain E{PPB, D};
        pg8::gemm_phase<pg8::EpiPlain, pg8::StaticOrder, true>(F.lds, g, S, E, F.wave);
        if (BOTH(17) || rep_ + 1 < REPS(17)) GRID_BAR();
    } }
    if (IN(18)) { for (int rep_ = 0; rep_ < REPS(18); ++rep_) {
        pg8::Gemm g{X2F8, WPG, D}; pg8::StaticOrder S; S.init(M, D, F.G, (int)blockIdx.x);
        pg8::EpiPle E{X3, X2, PPB, R3};
        pg8::gemm_phase<pg8::EpiPle, pg8::StaticOrder, true, 1>(F.lds, g, S, E, F.wave);
        if (BOTH(18) || rep_ + 1 < REPS(18)) GRID_BAR();
    } }
    if (IN(19)) { for (int rep_ = 0; rep_ < REPS(19); ++rep_) {
        const int lane_ = lane_id_v();
        for (int m = gw; m < M; m += NGW) {
            const GAS v4u* xr = (const GAS v4u*)(X3 + (size_t)m * D) + lane_; float f[2][8]; float s = 0.f;
#pragma unroll
            for (int j = 0; j < 2; ++j) { const v4u v = xr[64 * j]; f[j][0] = bflo(v.x); f[j][1] = bfhi(v.x); f[j][2] = bflo(v.y); f[j][3] = bfhi(v.y); f[j][4] = bflo(v.z); f[j][5] = bfhi(v.z); f[j][6] = bflo(v.w); f[j][7] = bfhi(v.w);
#pragma unroll
                for (int q = 0; q < 8; ++q) s += f[j][q] * f[j][q]; }
            s = wave_sum(s);
            const float r = 1.0f / sqrtf(s * (1.f / D) + EPS);
#pragma unroll
            for (int j = 0; j < 2; ++j) { const int c0 = (64 * j + lane_) * 8;
                const f32x4 g0 = *(const GAS f32x4*)(g_final + c0), g1 = *(const GAS f32x4*)(g_final + c0 + 4);
                f32x4 o0 = {f[j][0] * r * g0.x, f[j][1] * r * g0.y, f[j][2] * r * g0.z, f[j][3] * r * g0.w}, o1 = {f[j][4] * r * g1.x, f[j][5] * r * g1.y, f[j][6] * r * g1.z, f[j][7] * r * g1.w};
                *(GAS f32x4*)(args.out + (size_t)m * D + c0) = o0; *(GAS f32x4*)(args.out + (size_t)m * D + c0 + 4) = o1; }
        }
    } }
#undef IN
#undef BOTH
#undef GRID_BAR
}

extern "C" void kernel_launch(void* const* d_in, const int* in_sizes, int n_in, void* d_out, int out_size, void* d_ws, size_t ws_size, hipStream_t stream) {
    static int grid = 0;
    if (grid == 0) {
        if (n_in != 20 || out_size != M * D || ws_size < WS_END) { fprintf(stderr, "kernel_launch: unexpected shapes (n_in %d, out %d, ws %zu); nothing launched\n", n_in, out_size, ws_size); grid = -1; return; }
        int dev = 0, cus = 0, per_cu = 0;
        if (hipGetDevice(&dev) != hipSuccess || hipDeviceGetAttribute(&cus, hipDeviceAttributeMultiprocessorCount, dev) != hipSuccess) { grid = -1; return; }
        if (hipFuncSetAttribute((const void*)mk_fwd, hipFuncAttributeMaxDynamicSharedMemorySize, LDS_BYTES) != hipSuccess) { fprintf(stderr, "kernel_launch: hipFuncSetAttribute failed\n"); grid = -1; return; }
        if (hipOccupancyMaxActiveBlocksPerMultiprocessor(&per_cu, (const void*)mk_fwd, NWAVES * 64, LDS_BYTES) != hipSuccess || per_cu < 1)
            fprintf(stderr, "kernel_launch: note: occupancy query reports %d workgroups per CU\n", per_cu);
        (void)hipGetLastError();
        grid = cus;
    }
    if (grid < 0) return;
    if (hipMemsetAsync((char*)d_ws + WS_CTL, 0, CTL_ZERO_BYTES, stream) != hipSuccess) return;
    Args a{};
    for (int i = 0; i < 20; ++i) a.in[i] = (const float*)d_in[i];
    a.out = (float*)d_out; a.ws = (unsigned char*)d_ws;
#if MK_SPLIT
    for (int ph = 0; ph < NPH; ++ph) { a.ph_lo = ph; a.ph_hi = ph + 1; hipLaunchKernelGGL(mk_fwd, dim3(grid), dim3(NWAVES * 64), LDS_BYTES, stream, a); }
#else
    a.ph_lo = 0; a.ph_hi = NPH; hipLaunchKernelGGL(mk_fwd, dim3(grid), dim3(NWAVES * 64), LDS_BYTES, stream, a);
#endif
}
```

```cpp
#include <hip/hip_runtime.h>
#include <cstdio>
#include <cstdint>

#ifndef MK_SPLIT
#define MK_SPLIT 0
#endif

#ifndef MOE_ALIGN
#define MOE_ALIGN true
#endif
#ifndef STAGGER_P1
#define STAGGER_P1 0
#endif
#ifndef STAGGER_MOE
#define STAGGER_MOE 0
#endif
#ifndef REP_MASK
#define REP_MASK 0u
#endif
#define REPS(k) ((((REP_MASK) >> (k)) & 1u) ? 2 : 1)

#define GAS __attribute__((address_space(1)))
#define LAS __attribute__((address_space(3)))
typedef unsigned short bf16;
typedef unsigned v4u __attribute__((ext_vector_type(4)));
typedef unsigned v2u __attribute__((ext_vector_type(2)));
typedef int v4i __attribute__((ext_vector_type(4)));
typedef float f32x2 __attribute__((ext_vector_type(2)));
typedef float f32x4 __attribute__((ext_vector_type(4)));
typedef float f32x16 __attribute__((ext_vector_type(16)));
typedef short bf16x8 __attribute__((ext_vector_type(8)));
typedef __bf16 bf16x2_t __attribute__((ext_vector_type(2)));
typedef GAS unsigned gu32;

constexpr int NB = 16, SEQ = 4096, M = NB * SEQ, D = 1024, NH = 8, HD = 64, PW = 512, AW = 512, NE = 32, TOPK = 4, DE = 1024, PLE = 256;
constexpr int NPROJ_A = 3584;
constexpr float EPS = 1e-6f;
constexpr float LOG2E = 1.4426950408889634f;
constexpr float QSCALE = 0.125f * LOG2E;
constexpr float WSCALE = 64.0f, WSCALE_INV = 1.0f / 64.0f;
constexpr int NWAVES = 8;
constexpr int NPH = 20;

constexpr size_t MiB = 1u << 20;
constexpr size_t WS_CTL = 0, CTL_ZERO_BYTES = 1 * MiB;
constexpr size_t WS_R2 = 1 * MiB;
constexpr size_t WS_R3 = WS_R2 + 256 * 1024;
constexpr size_t WS_TKE = 2 * MiB;
constexpr size_t WS_TKW = 3 * MiB;
constexpr size_t WS_TKR = 4 * MiB;
constexpr size_t WS_TKS = 13 * MiB;
constexpr size_t WS_SSQP = 224 * MiB;
constexpr size_t WS_ROWT = 5 * MiB;
constexpr size_t WS_CNTWG = 11 * MiB;
constexpr size_t WS_SEGTOT = WS_CNTWG + 256 * 1024;
constexpr size_t WS_WRF = 12 * MiB;
constexpr size_t WS_WG8 = 14 * MiB;
constexpr size_t WS_WIN = 16 * MiB;
constexpr size_t WS_WEFF = 24 * MiB;
constexpr size_t WS_WAU = 25 * MiB;
constexpr size_t WS_WOUT = 26 * MiB;
constexpr size_t WS_WPG = 28 * MiB;
constexpr size_t WS_WPP = 30 * MiB;
constexpr size_t WS_WGU = 32 * MiB;
constexpr size_t WS_WDN = 96 * MiB;
constexpr size_t WS_H2F8 = 128 * MiB;
constexpr size_t WS_A = 224 * MiB;
constexpr size_t WS_B = 352 * MiB;
constexpr size_t WS_C = 480 * MiB;
constexpr size_t WS_E = 608 * MiB;
constexpr size_t WS_PB = 192 * MiB;
constexpr size_t WS_ACT = 736 * MiB;
constexpr size_t WS_G = 768 * MiB;
constexpr size_t WS_END = 1024 * MiB;
constexpr int CW_BAR = 4096;
constexpr size_t WS_CUR = 512 * 1024;
constexpr size_t WS_ROWREL = 608 * MiB;

constexpr int RING_BYTES = 131072;
constexpr int LDSCTL_OFF = RING_BYTES, MISC_OFF = LDSCTL_OFF + 320;
constexpr int LDS_TAB_OFF = MISC_OFF + 128;
constexpr int LDS_BYTES = 147456;

#define RLX_AGENT __ATOMIC_RELAXED, __HIP_MEMORY_SCOPE_AGENT
#define LDS_WAIT() asm volatile("s_waitcnt lgkmcnt(0)" ::: "memory")
#define VM_WAIT() asm volatile("s_waitcnt vmcnt(0)" ::: "memory")

__device__ __forceinline__ int lane_id_v() { int l; asm volatile("v_mbcnt_lo_u32_b32 %0, -1, 0\n\tv_mbcnt_hi_u32_b32 %0, -1, %0" : "=v"(l)); return l; }
__device__ __forceinline__ unsigned f2bf(float f) { unsigned u = __builtin_bit_cast(unsigned, f); return (u + 0x7fffu + ((u >> 16) & 1u)) >> 16; }
__device__ __forceinline__ unsigned pk2(float lo, float hi) { f32x2 v = {lo, hi}; bf16x2_t b = __builtin_convertvector(v, bf16x2_t); return __builtin_bit_cast(unsigned, b); }
__device__ __forceinline__ void swap16(unsigned& a, unsigned& b) { const auto r = __builtin_amdgcn_permlane16_swap(a, b, false, false); a = r[0]; b = r[1]; }
__device__ __forceinline__ unsigned pk4_fp8(float a, float b, float c, float d) { int r = __builtin_amdgcn_cvt_pk_fp8_f32(a, b, 0, false); r = __builtin_amdgcn_cvt_pk_fp8_f32(c, d, r, true); return (unsigned)r; }
__device__ __forceinline__ float bflo(unsigned u) { return __builtin_bit_cast(float, u << 16); }
__device__ __forceinline__ float bfhi(unsigned u) { return __builtin_bit_cast(float, u & 0xffff0000u); }
__device__ __forceinline__ float fast_sigmoid(float v) { return __builtin_amdgcn_rcpf(1.0f + __builtin_amdgcn_exp2f(-LOG2E * v)); }
__device__ __forceinline__ float wave_sum(float v) {
#pragma unroll
    for (int o = 1; o < 64; o <<= 1) v += __shfl_xor(v, o);
    return v;
}

#define XB_TMO      128
#define XB_XCNT(j)  (256  + 64 * (j))
#define XB_XSUB(j)  (1280 + 64 * (j))
#define XB_XGEN(j)  (2304 + 64 * (j))
#define XB_TOP      3328
#define XB_TOPGEN   3392
#define XCD_BAR_WORDS 3456
#define XB_SPIN_CAP (1u << 18)
__device__ __forceinline__ unsigned xb_ld(unsigned* p)              { return __hip_atomic_load(p, __ATOMIC_RELAXED, __HIP_MEMORY_SCOPE_AGENT); }
__device__ __forceinline__ unsigned xb_add(unsigned* p, unsigned v) { return __hip_atomic_fetch_add(p, v, __ATOMIC_RELAXED, __HIP_MEMORY_SCOPE_AGENT); }
__device__ __forceinline__ unsigned xb_xcc_id() { return (unsigned)__builtin_amdgcn_s_getreg((3 << 11) | 20) & 0xFu; }
#define XB_SPIN(cond, bar) do { unsigned _sp = 0; while (cond) { __builtin_amdgcn_s_sleep(1); \
    if ((++_sp & 255u) == 0u) { if (xb_ld(&(bar)[XB_TMO])) break; if (_sp > XB_SPIN_CAP) { atomicAdd(&(bar)[XB_TMO], 1u); break; } } } } while (0)
struct XcdBarrier { unsigned* bar; unsigned x; volatile LAS unsigned* st; };
__device__ __forceinline__ XcdBarrier xcd_barrier_post(unsigned* bar, volatile LAS unsigned* st, int wave) {
    XcdBarrier b; b.bar = bar; b.x = xb_xcc_id(); b.st = st;
    if (wave == 0 && lane_id_v() == 0) (void)xb_add(&bar[XB_XCNT(b.x)], 1u);
    return b;
}
__device__ __forceinline__ void xcd_barrier_complete(unsigned* bar, unsigned x, unsigned& nloc, unsigned& nx) {
    const unsigned G = gridDim.x * gridDim.y * gridDim.z;
    unsigned sum, cnt, mine, sp = 0u;
    for (;;) {
        sum = 0u; cnt = 0u; mine = 0u;
#pragma unroll
        for (unsigned j = 0; j < 16; ++j) { const unsigned c = xb_ld(&bar[XB_XCNT(j)]); sum += c; cnt += (c > 0u) ? 1u : 0u; mine = (j == x) ? c : mine; }
        if (sum == G) break;
        __builtin_amdgcn_s_sleep(1);
        if ((++sp & 255u) == 0u) { if (xb_ld(&bar[XB_TMO])) break; if (sp > XB_SPIN_CAP) { atomicAdd(&bar[XB_TMO], 1u); break; } }
    }
    nloc = mine > 0u ? mine : 1u; nx = cnt > 0u ? cnt : 1u;
}
__device__ __forceinline__ void xcd_barrier(const XcdBarrier& b, int wave) {
    asm volatile("s_waitcnt vmcnt(0)" ::: "memory");
    __syncthreads();
    if (wave == 0 && lane_id_v() == 0) {
        unsigned* bar = b.bar;
        __builtin_amdgcn_s_waitcnt(0);
        unsigned nloc = b.st[0], nx = b.st[1];
        if (nloc == 0u) { xcd_barrier_complete(bar, b.x, nloc, nx); b.st[0] = nloc; b.st[1] = nx; }
        const unsigned old = xb_add(&bar[XB_XSUB(b.x)], 1u);
        const unsigned gen = old / nloc;
        if (old + 1u == (gen + 1u) * nloc) {
            __builtin_amdgcn_fence(__ATOMIC_RELEASE, "agent");
            asm volatile("s_waitcnt vmcnt(0)" ::: "memory");
            const unsigned og = xb_add(&bar[XB_TOP], 1u);
            const unsigned tg = og / nx;
            if (og + 1u == (tg + 1u) * nx) xb_add(&bar[XB_TOPGEN], 1u);
            else XB_SPIN(xb_ld(&bar[XB_TOPGEN]) == tg, bar);
            __builtin_amdgcn_fence(__ATOMIC_ACQUIRE, "agent");
            xb_add(&bar[XB_XGEN(b.x)], 1u);
            asm volatile("s_waitcnt vmcnt(0)" ::: "memory");
        } else {
            XB_SPIN(xb_ld(&bar[XB_XGEN(b.x)]) == gen, bar);
            __builtin_amdgcn_fence(__ATOMIC_ACQUIRE, "agent");
            asm volatile("s_waitcnt vmcnt(0)" ::: "memory");
        }
    }
    __syncthreads();
}

namespace pg8 {
constexpr int BM = 256, BK = 64, HALF = 128, HTB = HALF * BK * 2, NXCD = 8, WGM = 8;
__host__ __device__ __forceinline__ int lds_byte(int r, int c) { const int st = (r >> 4) * 2 + (c >> 5), rr = r & 15, cc = c & 31, ob = rr * 64 + cc * 2; return st * 1024 + (ob ^ (((ob >> 9) & 1) << 5)); }
__host__ __device__ __forceinline__ void stage_rc(int b, int& R, int& C) { const int st = b / 1024, sb = b % 1024, swz = sb ^ (((sb >> 9) & 1) << 5); R = (st >> 1) * 16 + swz / 64; C = (st & 1) * 32 + (swz % 64) / 2; }
__host__ __device__ __forceinline__ int perm32(int rho) { const int n = rho >> 4, i = rho & 15; return 8 * (i >> 2) + 4 * n + (i & 3); }

typedef int v8i __attribute__((ext_vector_type(8)));
typedef int v4i_ __attribute__((ext_vector_type(4)));
__device__ __forceinline__ v8i cat8(const bf16x8 a, const bf16x8 b) { const v4i_ x = __builtin_bit_cast(v4i_, a), y = __builtin_bit_cast(v4i_, b); return __builtin_shufflevector(x, y, 0, 1, 2, 3, 4, 5, 6, 7); }
struct Unit { int pm, pn, e, row0, nvalid, k; };
struct Gemm { const void* A; const void* Bt; int K; };

struct StaticOrder {
    int nM, nN, nwg, G, c;
    __device__ void init(int Mr, int N, int G_, int c_) { nM = Mr / BM; nN = N / BM; nwg = nM * nN; G = G_; c = c_; }
    __device__ __forceinline__ bool next(int i, Unit& u) const {
        const long L = (long)i * G + c; if (L >= nwg) return false;
        int wgid = (int)L; { const int q = nwg / NXCD, r = nwg % NXCD, xcd = wgid % NXCD, off = wgid / NXCD; wgid = (xcd < r ? xcd * (q + 1) : r * (q + 1) + (xcd - r) * q) + off; }
        const int nig = WGM * nN, gid = wgid / nig, fm = gid * WGM, gsz = (nM - fm) < WGM ? (nM - fm) : WGM;
        u.pm = fm + ((wgid % nig) % gsz); u.pn = (wgid % nig) / gsz; u.e = 0; u.row0 = u.pm * BM; u.nvalid = BM; u.k = 0; return true;
    }
    __device__ __forceinline__ void a_off(const Unit& u, int tid, int pitchB, unsigned (&va)[2][2]) const {
#pragma unroll
        for (int i = 0; i < 2; ++i) { int R, C; stage_rc(tid * 16 + i * 8192, R, C);
#pragma unroll
            for (int h = 0; h < 2; ++h) va[h][i] = (unsigned)((u.pm * BM + h * HALF + R) * pitchB + C * 2); }
    }
    __device__ __forceinline__ const char* b_ptr(const Unit& u, const Gemm& g, int pitchB) const { return (const char*)g.Bt + (size_t)u.pn * BM * pitchB; }
    __device__ __forceinline__ unsigned a_kofs(int kt) const { return (unsigned)kt * 128u; }
    __device__ __forceinline__ bool keep_acc(const Unit&) const { return false; }
};
struct DualOrder {
    StaticOrder so; int Mr, N;
    __device__ void init(int Mr_, int N_, int G_, int c_) { so.init(Mr_, N_, G_, c_); Mr = Mr_; N = N_; }
    __device__ __forceinline__ bool next(int i, Unit& u) const { if (!so.next(i >> 1, u)) return false; u.k = i & 1; return true; }
    __device__ __forceinline__ void a_off(const Unit& u, int tid, int pitchB, unsigned (&va)[2][2]) const {
#pragma unroll
        for (int i = 0; i < 2; ++i) { int R, C; stage_rc(tid * 16 + i * 8192, R, C);
#pragma unroll
            for (int h = 0; h < 2; ++h) va[h][i] = (unsigned)((u.k * Mr + u.pm * BM + h * HALF + R) * pitchB + C * 2); }
    }
    __device__ __forceinline__ const char* b_ptr(const Unit& u, const Gemm& g, int pitchB) const { return (const char*)g.Bt + (size_t)(u.k * N + u.pn * BM) * pitchB; }
    __device__ __forceinline__ unsigned a_kofs(int kt) const { return (unsigned)kt * 128u; }
    __device__ __forceinline__ bool keep_acc(const Unit& u) const { return u.k == 0; }
};

template <class Epi, class Sched, bool ALIGN_EPI, int ES = 2>
__device__ __forceinline__ void gemm_phase(LAS unsigned char* lds, const Gemm g, const Sched& S, const Epi& E, const int wid, const int stagger = 0) {
    const int lane = lane_id_v(), tid = wid * 64 + lane, wr = wid >> 2, wc = wid & 3, fr = lane & 15, fq = lane >> 4;
    const int K = g.K, pitchB = K * ES; int nt = pitchB / 128;
    asm volatile("" : "+s"(nt));
    unsigned voffB[2];
#pragma unroll
    for (int i = 0; i < 2; ++i) { int R, C; stage_rc(tid * 16 + i * 8192, R, C); const int Rb = Epi::PERM ? ((R & ~31) + perm32(R & 31)) : R;
        voffB[i] = (unsigned)(Rb * pitchB + C * 2); }
    const size_t kstep = (size_t)(BK * 2);
    const size_t hstep = (size_t)HALF * pitchB;
    const unsigned ldsw = (unsigned)wid * 1024u;
    const int aoff = lds_byte(wr * 64 + fr, fq * 8), boff = lds_byte(wc * 32 + fr, fq * 8);
#define PG8_SA(b, h) (((b) * 2 + (h)) * HTB)
#define PG8_SB(b, h) ((4 + (b) * 2 + (h)) * HTB)
#define PG8_STAGE(bufoff, gbase, voff) do { _Pragma("unroll") for (int _i = 0; _i < 2; ++_i) \
        __builtin_amdgcn_global_load_lds((const unsigned*)((const char*)(gbase) + (voff)[_i]), (LAS unsigned*)(lds + (bufoff) + ldsw + _i * 8192), 16, 0, 0); } while (0)
#define PG8_LDA(dst, b, h) do { _Pragma("unroll") for (int m = 0; m < 4; ++m) _Pragma("unroll") for (int k = 0; k < 2; ++k) dst[m][k] = *(const LAS bf16x8*)(lds + PG8_SA(b, h) + aoff + m * 2048 + k * 1024); } while (0)
#define PG8_LDB(dst, b, h) do { _Pragma("unroll") for (int n = 0; n < 2; ++n) _Pragma("unroll") for (int k = 0; k < 2; ++k) dst[n][k] = *(const LAS bf16x8*)(lds + PG8_SB(b, h) + boff + n * 2048 + k * 1024); } while (0)
#define PG8_MMA(ai, bj, At, Bt) do { __builtin_amdgcn_s_setprio(1); _Pragma("unroll") for (int m = 0; m < 4; ++m) _Pragma("unroll") for (int n = 0; n < 2; ++n) { \
        if constexpr (ES == 2) { _Pragma("unroll") for (int k = 0; k < 2; ++k) acc[ai][bj][m][n] = __builtin_amdgcn_mfma_f32_16x16x32_bf16(Bt[n][k], At[m][k], acc[ai][bj][m][n], 0, 0, 0); } \
        else { const v8i a8_ = cat8(Bt[n][0], Bt[n][1]), b8_ = cat8(At[m][0], At[m][1]); \
               if (m == 0 && n == 0) asm volatile("s_nop 1\n\tv_mfma_f32_16x16x128_f8f6f4 %0, %1, %2, %0" : "+v"(acc[ai][bj][m][n]) : "v"(a8_), "v"(b8_)); \
               else asm volatile("v_mfma_f32_16x16x128_f8f6f4 %0, %1, %2, %0" : "+v"(acc[ai][bj][m][n]) : "v"(a8_), "v"(b8_)); } } \
        __builtin_amdgcn_s_setprio(0); } while (0)
#define PG8_WAIT_V(n) asm volatile("s_waitcnt vmcnt(" #n ")" ::: "memory")
#define PG8_WAIT_L(n) asm volatile("s_waitcnt lgkmcnt(" #n ")" ::: "memory")
#define PG8_BAR __builtin_amdgcn_s_barrier()
#define PG8_SCHED __builtin_amdgcn_sched_barrier(0)
    Unit cur, nxt; int ui = 0;
    if (!S.next(0, cur)) return;
    if (stagger > 0) {
        const unsigned long long t0_ = __builtin_amdgcn_s_memrealtime(), dl_ = (unsigned long long)((blockIdx.x >> 3) & 7u) * (unsigned)stagger;
        while (__builtin_amdgcn_s_memrealtime() - t0_ < dl_) __builtin_amdgcn_s_sleep(4); }
    f32x4 acc[2][2][4][2];
#pragma unroll
    for (int a = 0; a < 2; ++a)
#pragma unroll
        for (int b = 0; b < 2; ++b)
#pragma unroll
            for (int m = 0; m < 4; ++m)
#pragma unroll
                for (int n = 0; n < 2; ++n) acc[a][b][m][n] = (f32x4){0.f, 0.f, 0.f, 0.f};
    bf16x8 At[4][2], B0[2][2], B1[2][2];
    unsigned cva[2][2], nva[2][2];
    S.a_off(cur, tid, pitchB, cva);
    const char* const Ab = (const char*)g.A;
    const char* cB = S.b_ptr(cur, g, pitchB);
    PG8_STAGE(PG8_SB(0, 0), cB, voffB); PG8_STAGE(PG8_SB(0, 1), cB + hstep, voffB); PG8_STAGE(PG8_SA(0, 0), Ab, cva[0]); PG8_STAGE(PG8_SA(0, 1), Ab, cva[1]);
    if (wr == 1) PG8_BAR;
    PG8_WAIT_V(2); PG8_BAR;
    PG8_STAGE(PG8_SB(1, 0), cB + kstep, voffB); PG8_STAGE(PG8_SA(1, 0), Ab + S.a_kofs(1), cva[0]); PG8_STAGE(PG8_SB(1, 1), cB + hstep + kstep, voffB);
    PG8_WAIT_V(6); PG8_BAR;
    for (;;) {
        const bool has_next = S.next(ui + 1, nxt);
        const char* nB = cB;
        if (has_next) { S.a_off(nxt, tid, pitchB, nva); nB = S.b_ptr(nxt, g, pitchB); }
        else {
#pragma unroll
            for (int h = 0; h < 2; ++h)
#pragma unroll
                for (int i = 0; i < 2; ++i) nva[h][i] = cva[h][i];
        }
#pragma nounroll
        for (int t = 0; t < nt; t += 2) {
            const bool last = (t == nt - 2);
            const char* Abt = Ab; asm volatile("" : "+s"(Abt));
            const char* a1 = Abt + S.a_kofs(t + 1);
            const char* a2 = last ? Abt : Abt + S.a_kofs(t + 2); const char* b2 = last ? nB : cB + (size_t)(t + 2) * kstep;
            const char* a3 = last ? Abt + S.a_kofs(1) : Abt + S.a_kofs(t + 3); const char* b3 = b2 + kstep;
            unsigned va2[2][2];
#pragma unroll
            for (int h = 0; h < 2; ++h)
#pragma unroll
                for (int i = 0; i < 2; ++i) va2[h][i] = last ? nva[h][i] : cva[h][i];
            PG8_LDB(B0, 0, 0); PG8_LDB(B1, 0, 1); PG8_SCHED; PG8_LDA(At, 0, 0); PG8_STAGE(PG8_SA(1, 1), a1, cva[1]);
            PG8_WAIT_V(8); PG8_WAIT_L(0); PG8_BAR; PG8_MMA(0, 0, At, B0); PG8_MMA(0, 1, At, B1); PG8_BAR; PG8_SCHED;
            PG8_LDA(At, 0, 1); PG8_STAGE(PG8_SB(0, 0), b2, voffB); PG8_STAGE(PG8_SB(0, 1), b2 + hstep, voffB); PG8_STAGE(PG8_SA(0, 0), a2, va2[0]);
            PG8_WAIT_V(8); PG8_WAIT_L(0); PG8_BAR; PG8_MMA(1, 0, At, B0); PG8_MMA(1, 1, At, B1); PG8_BAR; PG8_SCHED;
            PG8_LDB(B0, 1, 0); PG8_LDB(B1, 1, 1); PG8_SCHED; PG8_LDA(At, 1, 0); PG8_STAGE(PG8_SA(0, 1), a2, va2[1]);
            PG8_WAIT_V(8); PG8_WAIT_L(0); PG8_BAR; PG8_MMA(0, 0, At, B0); PG8_MMA(0, 1, At, B1); PG8_BAR; PG8_SCHED;
            PG8_LDA(At, 1, 1); PG8_STAGE(PG8_SB(1, 0), b3, voffB); PG8_STAGE(PG8_SB(1, 1), b3 + hstep, voffB); PG8_STAGE(PG8_SA(1, 0), a3, va2[0]);
            PG8_WAIT_V(8); PG8_WAIT_L(0); PG8_BAR; PG8_MMA(1, 0, At, B0); PG8_MMA(1, 1, At, B1); PG8_BAR; PG8_SCHED;
        }
        if constexpr (ALIGN_EPI) { if (wr == 0) PG8_BAR; }
        if constexpr (ES == 1) asm volatile("s_nop 11");
        E(acc, cur, wr, wc, fr, fq);
        if (!has_next) break;
        if (!S.keep_acc(cur)) {
#pragma unroll
        for (int a = 0; a < 2; ++a)
#pragma unroll
            for (int b = 0; b < 2; ++b)
#pragma unroll
                for (int m = 0; m < 4; ++m)
#pragma unroll
                    for (int n = 0; n < 2; ++n) acc[a][b][m][n] = (f32x4){0.f, 0.f, 0.f, 0.f};
        }
        cur = nxt; cB = nB; ++ui;
#pragma unroll
        for (int h = 0; h < 2; ++h)
#pragma unroll
            for (int i = 0; i < 2; ++i) cva[h][i] = nva[h][i];
        if constexpr (ALIGN_EPI) { if (wr == 1) PG8_BAR; }
    }
    PG8_WAIT_V(0);
    if constexpr (!ALIGN_EPI) { if (wr == 0) PG8_BAR; }
    PG8_BAR;
#undef PG8_SA
#undef PG8_SB
#undef PG8_STAGE
#undef PG8_LDA
#undef PG8_LDB
#undef PG8_MMA
#undef PG8_WAIT_V
#undef PG8_WAIT_L
#undef PG8_BAR
#undef PG8_SCHED
}

__device__ __forceinline__ f32x4 one_plus_expneg4(const f32x4 v) { const f32x4 a = v * (-LOG2E); f32x4 e;
#pragma unroll
    for (int j = 0; j < 4; ++j) e[j] = __builtin_amdgcn_exp2f(a[j]);
    return e + 1.0f; }
__device__ __forceinline__ f32x4 sigmoid4(const f32x4 v) { const f32x4 d = one_plus_expneg4(v); f32x4 r;
#pragma unroll
    for (int j = 0; j < 4; ++j) r[j] = __builtin_amdgcn_rcpf(d[j]);
    return r; }
__device__ __forceinline__ v4u pack8(const f32x4 a, const f32x4 b) { v4u w; w.x = pk2(a[0], a[1]); w.y = pk2(a[2], a[3]); w.z = pk2(b[0], b[1]); w.w = pk2(b[2], b[3]); return w; }
__device__ __forceinline__ void unpack8(const v4u w, f32x4& a, f32x4& b) { a = (f32x4){bflo(w.x), bfhi(w.x), bflo(w.y), bfhi(w.y)}; b = (f32x4){bflo(w.z), bfhi(w.z), bflo(w.w), bfhi(w.w)}; }

__device__ __forceinline__ size_t nat_off(int unit_id, int wr, int wc, int fr, int fq, int ai, int m, int bj) { return ((size_t)((unit_id * 8 + wr * 4 + wc) * 16 + (ai * 8 + m * 2 + bj))) * 512 + (fq * 16 + fr) * 8; }
__device__ __forceinline__ void st16_nt(bf16* p, const v4u v) { asm volatile("global_store_dwordx4 %0, %1, off sc0 sc1 nt\n\ts_nop 1" :: "v"(p), "v"(v) : "memory"); }
struct EpiNative {
    static constexpr bool PERM = true;
    bf16* O; int nN;
    __device__ __forceinline__ void operator()(const f32x4 (&acc)[2][2][4][2], const Unit& u, int wr, int wc, int fr, int fq) const {
        const int uid = u.pm * nN + u.pn;
#pragma unroll
        for (int ai = 0; ai < 2; ++ai)
#pragma unroll
            for (int m = 0; m < 4; ++m)
#pragma unroll
                for (int bj = 0; bj < 2; ++bj) st16_nt(O + nat_off(uid, wr, wc, fr, fq, ai, m, bj), pack8(acc[ai][bj][m][0], acc[ai][bj][m][1]));
    }
};
struct EpiPlain {
    static constexpr bool PERM = true;
    bf16* O; int ldc;
    __device__ __forceinline__ void operator()(const f32x4 (&acc)[2][2][4][2], const Unit& u, int wr, int wc, int fr, int fq) const {
        const int row0 = u.pm * BM + wr * 64 + fr, col0 = u.pn * BM + wc * 32 + 8 * fq;
#pragma unroll
        for (int ai = 0; ai < 2; ++ai)
#pragma unroll
            for (int m = 0; m < 4; ++m) { bf16* rowp = O + (size_t)(row0 + ai * HALF + m * 16) * ldc + col0;
#pragma unroll
                for (int bj = 0; bj < 2; ++bj) *(GAS v4u*)(rowp + bj * HALF) = pack8(acc[ai][bj][m][0], acc[ai][bj][m][1]); }
    }
};
struct EpiProj {
    static constexpr bool PERM = true;
    bf16 *U, *Q, *Kb;
    __device__ __forceinline__ void operator()(const f32x4 (&acc)[2][2][4][2], const Unit& u, int wr, int wc, int fr, int fq) const {
        const int pn = u.pn;
        if (pn >= 2) {
            bf16* base = pn < 4 ? Q : Kb; const int uid = u.pm * 2 + (pn & 1); const float sc = pn < 4 ? QSCALE : 1.f;
#pragma unroll
            for (int ai = 0; ai < 2; ++ai)
#pragma unroll
                for (int m = 0; m < 4; ++m)
#pragma unroll
                    for (int bj = 0; bj < 2; ++bj) st16_nt(base + nat_off(uid, wr, wc, fr, fq, ai, m, bj), pack8(acc[ai][bj][m][0] * sc, acc[ai][bj][m][1] * sc));
            return;
        }
        const int row0 = u.pm * BM + wr * 64 + fr, col0 = pn * 256 + wc * 32 + 8 * fq;
#pragma unroll
        for (int ai = 0; ai < 2; ++ai)
#pragma unroll
            for (int m = 0; m < 4; ++m) { bf16* rowp = U + (size_t)(row0 + ai * HALF + m * 16) * 512 + col0;
#pragma unroll
                for (int bj = 0; bj < 2; ++bj) *(GAS v4u*)(rowp + bj * HALF) = pack8(acc[ai][bj][m][0], acc[ai][bj][m][1]); }
    }
};
struct EpiGate8 {
    static constexpr bool PERM = true;
    bf16 *GP, *GA;
    __device__ __forceinline__ void operator()(const f32x4 (&acc)[2][2][4][2], const Unit& u, int wr, int wc, int fr, int fq) const {
        bf16* base = u.pn < 4 ? GP : GA; const int uid = u.pm * 4 + (u.pn & 3);
#pragma unroll
        for (int ai = 0; ai < 2; ++ai)
#pragma unroll
            for (int m = 0; m < 4; ++m)
#pragma unroll
                for (int bj = 0; bj < 2; ++bj) st16_nt(base + nat_off(uid, wr, wc, fr, fq, ai, m, bj), pack8(acc[ai][bj][m][0] * WSCALE_INV, acc[ai][bj][m][1] * WSCALE_INV));
    }
};
struct EpiDual {
    static constexpr bool PERM = true;
    bf16* O; const bf16* GP; const bf16* GA;
    __device__ __forceinline__ void operator()(f32x4 (&acc)[2][2][4][2], const Unit& u, int wr, int wc, int fr, int fq) const {
        const int uid = u.pm * 4 + u.pn; const int row0 = u.pm * BM + wr * 64 + fr, col0 = u.pn * BM + wc * 32 + 8 * fq;
        if (u.k == 0) {
#pragma unroll
            for (int ai = 0; ai < 2; ++ai)
#pragma unroll
                for (int m = 0; m < 4; ++m)
#pragma unroll
                    for (int bj = 0; bj < 2; ++bj) { const size_t no = nat_off(uid, wr, wc, fr, fq, ai, m, bj);
                        f32x4 b0, b1, a0, a1; unpack8(*(const GAS v4u*)(GA + no), b0, b1); unpack8(*(const GAS v4u*)(GP + no), a0, a1);
                        const f32x4 lim = {-80.f, -80.f, -80.f, -80.f};
                        acc[ai][bj][m][0] = acc[ai][bj][m][0] * (one_plus_expneg4(__builtin_elementwise_max(b0, lim)) * sigmoid4(a0));
                        acc[ai][bj][m][1] = acc[ai][bj][m][1] * (one_plus_expneg4(__builtin_elementwise_max(b1, lim)) * sigmoid4(a1)); }
        } else {
#pragma unroll
            for (int ai = 0; ai < 2; ++ai) {
                v4u gv[4][2];
#pragma unroll
                for (int m = 0; m < 4; ++m)
#pragma unroll
                    for (int bj = 0; bj < 2; ++bj) gv[m][bj] = *(const GAS v4u*)(GA + nat_off(uid, wr, wc, fr, fq, ai, m, bj));
#pragma unroll
                for (int m = 0; m < 4; ++m)
#pragma unroll
                    for (int bj = 0; bj < 2; ++bj) { f32x4 b0, b1; unpack8(gv[m][bj], b0, b1); const f32x4 lim = {-80.f, -80.f, -80.f, -80.f};
                        const f32x4 v0 = acc[ai][bj][m][0] * sigmoid4(__builtin_elementwise_max(b0, lim)), v1 = acc[ai][bj][m][1] * sigmoid4(__builtin_elementwise_max(b1, lim));
                        *(GAS v4u*)(O + (size_t)(row0 + ai * HALF + m * 16) * 1024 + col0 + bj * HALF) = pack8(v0, v1); }
            }
        }
    }
};
struct EpiResid {
    static constexpr bool PERM = true;
    bf16* O; const bf16* X; float* SSQP;
    __device__ __forceinline__ void operator()(const f32x4 (&acc)[2][2][4][2], const Unit& u, int wr, int wc, int fr, int fq) const {
        const int row0 = u.pm * BM + wr * 64 + fr, col0 = u.pn * BM + wc * 32 + 8 * fq;
#pragma unroll
        for (int ai = 0; ai < 2; ++ai) {
            v4u xv[4][2];
#pragma unroll
            for (int m = 0; m < 4; ++m)
#pragma unroll
                for (int bj = 0; bj < 2; ++bj) xv[m][bj] = *(const GAS v4u*)(X + (size_t)(row0 + ai * HALF + m * 16) * 1024 + col0 + bj * HALF);
#pragma unroll
            for (int m = 0; m < 4; ++m) { float s = 0.f;
#pragma unroll
                for (int bj = 0; bj < 2; ++bj) { f32x4 x0, x1; unpack8(xv[m][bj], x0, x1);
                    const v4u o = pack8(acc[ai][bj][m][0] + x0, acc[ai][bj][m][1] + x1); f32x4 y0, y1; unpack8(o, y0, y1);
                    s += (y0[0] * y0[0] + y0[1] * y0[1]) + (y0[2] * y0[2] + y0[3] * y0[3]) + (y1[0] * y1[0] + y1[1] * y1[1]) + (y1[2] * y1[2] + y1[3] * y1[3]);
                    *(GAS v4u*)(O + (size_t)(row0 + ai * HALF + m * 16) * 1024 + col0 + bj * HALF) = o; }
                s += __shfl_xor(s, 16); s += __shfl_xor(s, 32);
                if (fq == 0) SSQP[(size_t)(row0 + ai * HALF + m * 16) * 16 + u.pn * 4 + wc] = s; }
        }
    }
};
struct EpiPle {
    static constexpr bool PERM = true;
    bf16* O; const bf16* X2; const bf16* PP; const float* R3;
    __device__ __forceinline__ void operator()(const f32x4 (&acc)[2][2][4][2], const Unit& u, int wr, int wc, int fr, int fq) const {
        const int row0 = u.pm * BM + wr * 64 + fr, col0 = u.pn * BM + wc * 32 + 8 * fq; const int uid = u.pm * 4 + u.pn;
#pragma unroll
        for (int ai = 0; ai < 2; ++ai) {
            v4u pv[4][2]; float rr[4];
#pragma unroll
            for (int m = 0; m < 4; ++m) { const int row = row0 + ai * HALF + m * 16; rr[m] = R3[row] * WSCALE_INV;
#pragma unroll
                for (int bj = 0; bj < 2; ++bj) pv[m][bj] = *(const GAS v4u*)(PP + nat_off(uid, wr, wc, fr, fq, ai, m, bj)); }
#pragma unroll
            for (int m = 0; m < 4; ++m) { const int row = row0 + ai * HALF + m * 16; const float r = rr[m];
#pragma unroll
                for (int bj = 0; bj < 2; ++bj) { f32x4 p0, p1; unpack8(pv[m][bj], p0, p1);
                    const f32x4 v0 = sigmoid4(acc[ai][bj][m][0] * r) * p0, v1 = sigmoid4(acc[ai][bj][m][1] * r) * p1;
                    *(GAS v4u*)(O + (size_t)row * 1024 + col0 + bj * HALF) = pack8(v0, v1); } }
        }
    }
};

template <bool GATHER> struct MoeOrder {
    const LAS int* tab; const int* row_token; const unsigned char* W; int NT, G, c, total; size_t wstride;
    __device__ __forceinline__ int kstepA() const { return 128; }
    __device__ __forceinline__ bool next(int i, Unit& u) const {
        const int per = G >> 3, x = c / per, j = c - x * per;
        long L;
        if (per > 0 && (G & 7) == 0) { const int chunk = ((total + 7) >> 3); const int off = i * per + j; if (off >= chunk) return false; L = (long)x * chunk + off; }
        else L = (long)i * G + c;
        if (L >= total) return false;
        const int rt = (int)(L / NT); u.pn = (int)(L % NT);
        int lo = 0, hi = 32;
#pragma unroll
        for (int it = 0; it < 5; ++it) { const int mid = (lo + hi) >> 1; const int v = __builtin_amdgcn_readfirstlane(tab[mid]); if (v <= rt) lo = mid; else hi = mid; }
        const int lt = rt - __builtin_amdgcn_readfirstlane(tab[lo]), cn = __builtin_amdgcn_readfirstlane(tab[65 + lo]);
        u.e = lo; u.k = lt * 256; u.pm = rt; u.row0 = __builtin_amdgcn_readfirstlane(tab[33 + lo]) + lt * 256; u.nvalid = (cn - lt * 256) < 256 ? (cn - lt * 256) : 256; return true;
    }
    __device__ __forceinline__ void a_off(const Unit& u, int tid, int pitchB, unsigned (&va)[2][2]) const {
        int R[2], C[2];
#pragma unroll
        for (int i = 0; i < 2; ++i) stage_rc(tid * 16 + i * 8192, R[i], C[i]);
        if constexpr (GATHER) {
            int tok[2][2];
            const int c0 = __builtin_amdgcn_readfirstlane(tab[98 + u.e]), c1 = c0 + __builtin_amdgcn_readfirstlane(tab[130 + u.e]), c2 = c1 + __builtin_amdgcn_readfirstlane(tab[162 + u.e]);
#pragma unroll
            for (int i = 0; i < 2; ++i)
#pragma unroll
                for (int h = 0; h < 2; ++h) { const int rl = h * HALF + R[i]; const int r = u.k + (rl < u.nvalid ? rl : 0);
                    const int k = (r >= c0) + (r >= c1) + (r >= c2); const int idx = r - (k == 0 ? 0 : (k == 1 ? c0 : (k == 2 ? c1 : c2)));
                    tok[h][i] = row_token[(size_t)(k * 32 + u.e) * 65536 + idx]; }
#pragma unroll
            for (int i = 0; i < 2; ++i)
#pragma unroll
                for (int h = 0; h < 2; ++h) va[h][i] = (unsigned)(tok[h][i] * pitchB + C[i] * 2);
        } else {
#pragma unroll
            for (int i = 0; i < 2; ++i)
#pragma unroll
                for (int h = 0; h < 2; ++h) va[h][i] = (unsigned)(u.pm * 8 * 32768 + (h * HALF + R[i]) * 128 + C[i] * 2);
        }
    }
    __device__ __forceinline__ const char* b_ptr(const Unit& u, const Gemm& g, int pitchB) const { return (const char*)(W + (size_t)u.e * wstride + (size_t)u.pn * 256 * pitchB); }
    __device__ __forceinline__ unsigned a_kofs(int kt) const { return GATHER ? (unsigned)kt * 128u : (unsigned)kt * 32768u; }
    __device__ __forceinline__ bool keep_acc(const Unit&) const { return false; }
};
__device__ __forceinline__ void swiglu4(const f32x4 ag, const f32x4 au, const f32x4 bg, const f32x4 bu, f32x4& o) {
#pragma unroll
    for (int h = 0; h < 2; ++h) {
        f32x2 g = (f32x2){ag[2 * h], ag[2 * h + 1]} * WSCALE_INV + (f32x2){bg[2 * h], bg[2 * h + 1]};
        f32x2 up = (f32x2){au[2 * h], au[2 * h + 1]} * WSCALE_INV + (f32x2){bu[2 * h], bu[2 * h + 1]};
        g = __builtin_elementwise_min(g, (f32x2){7.0f, 7.0f});
        up = __builtin_elementwise_min(__builtin_elementwise_max(up, (f32x2){-7.0f, -7.0f}), (f32x2){7.0f, 7.0f});
        const f32x2 a = g * (-1.702f * LOG2E);
        f32x2 e; e.x = __builtin_amdgcn_exp2f(a.x); e.y = __builtin_amdgcn_exp2f(a.y);
        const f32x2 d = e + 1.0f;
        f32x2 rc; rc.x = __builtin_amdgcn_rcpf(d.x); rc.y = __builtin_amdgcn_rcpf(d.y);
        const f32x2 r = (up + 1.0f) * (g * rc);
        o[2 * h] = r.x; o[2 * h + 1] = r.y;
    }
}
struct EpiMoe1 {
    static constexpr bool PERM = true;
    unsigned char* act; const float* bgu;
    __device__ __forceinline__ void operator()(const f32x4 (&acc)[2][2][4][2], const Unit& u, int wr, int wc, int fr, int fq) const {
        const int cl = u.pn * 128 + wc * 32 + 8 * fq;
        const float* bg = bgu + (size_t)u.e * 2048 + cl;
        const f32x4 g0b = *(const GAS f32x4*)(bg), g1b = *(const GAS f32x4*)(bg + 4), u0b = *(const GAS f32x4*)(bg + 1024), u1b = *(const GAS f32x4*)(bg + 1028);
#pragma unroll
        for (int ai = 0; ai < 2; ++ai)
#pragma unroll
            for (int mp = 0; mp < 4; mp += 2) { v2u o8[2];
#pragma unroll
                for (int q = 0; q < 2; ++q) { const int m = mp + q; f32x4 o0, o1;
                    swiglu4(acc[ai][0][m][0], acc[ai][1][m][0], g0b, u0b, o0); swiglu4(acc[ai][0][m][1], acc[ai][1][m][1], g1b, u1b, o1);
                    o8[q].x = pk4_fp8(o0[0], o0[1], o0[2], o0[3]); o8[q].y = pk4_fp8(o1[0], o1[1], o1[2], o1[3]); }
                unsigned ax = o8[0].x, ay = o8[0].y, bx = o8[1].x, by = o8[1].y; swap16(ax, bx); swap16(ay, by);
                const int rl = ai * HALF + wr * 64 + (mp + (fq & 1)) * 16 + fr;
                v4u o; o.x = ax; o.y = ay; o.z = bx; o.w = by;
                *(GAS v4u*)(act + ((size_t)(u.pm * 8 + u.pn) * 256 + rl) * 128 + wc * 32 + 8 * (fq & 2)) = o; }
    }
};
struct EpiMoe2 {
    static constexpr bool PERM = true;
    unsigned char* Y; const float* bdn;
    __device__ __forceinline__ void operator()(const f32x4 (&acc)[2][2][4][2], const Unit& u, int wr, int wc, int fr, int fq) const {
        const int col0 = u.pn * 256 + wc * 32 + 8 * fq;
        const float* bd = bdn + (size_t)u.e * 1024 + col0;
        f32x4 bv[2][2];
#pragma unroll
        for (int bj = 0; bj < 2; ++bj) { bv[bj][0] = *(const GAS f32x4*)(bd + bj * HALF); bv[bj][1] = *(const GAS f32x4*)(bd + bj * HALF + 4); }
#pragma unroll
        for (int ai = 0; ai < 2; ++ai)
#pragma unroll
            for (int mp = 0; mp < 4; mp += 2) { v4u o[2];
#pragma unroll
                for (int bj = 0; bj < 2; ++bj) { v2u o8[2];
#pragma unroll
                    for (int q = 0; q < 2; ++q) { const int m = mp + q; const f32x4 y0 = acc[ai][bj][m][0] * WSCALE_INV + bv[bj][0], y1 = acc[ai][bj][m][1] * WSCALE_INV + bv[bj][1];
                        o8[q].x = pk4_fp8(y0[0], y0[1], y0[2], y0[3]); o8[q].y = pk4_fp8(y1[0], y1[1], y1[2], y1[3]); }
                    unsigned ax = o8[0].x, ay = o8[0].y, bx = o8[1].x, by = o8[1].y; swap16(ax, bx); swap16(ay, by);
                    o[bj].x = ax; o[bj].y = ay; o[bj].z = bx; o[bj].w = by; }
                const int rl = ai * HALF + wr * 64 + (mp + (fq & 1)) * 16 + fr;
                if (rl < u.nvalid) { unsigned char* rowp = Y + (size_t)(u.row0 + rl) * 1024 + u.pn * 256 + wc * 32 + 8 * (fq & 2);
                    *(GAS v4u*)(rowp) = o[0]; *(GAS v4u*)(rowp + HALF) = o[1]; } }
    }
};
}

struct Frame {
    LAS unsigned char* lds; volatile LAS unsigned* MISC; gu32* ctl;
    int wave, vcu, G;
};
struct Args { const float* in[20]; float* out; unsigned char* ws; int ph_lo, ph_hi; };

template <bool F8>
__device__ __forceinline__ void p0_transpose_item(const float* W, int N, int k0, int n0, void* WT, int Kp, int dst_row0, const float* gain, float scale, LAS float* scr, int lane) {
    f32x4 v[8]; float gs[8];
    const int kq = lane >> 3, n4 = 4 * (lane & 7);
#pragma unroll
    for (int i = 0; i < 8; ++i) v[i] = *(const GAS f32x4*)(W + (size_t)(k0 + kq + 8 * i) * N + n0 + n4);
#pragma unroll
    for (int i = 0; i < 8; ++i) gs[i] = gain ? gain[k0 + kq + 8 * i] * scale : scale;
#pragma unroll
    for (int i = 0; i < 8; ++i) { LAS float* s = scr + (kq + 8 * i) * 33 + n4; s[0] = v[i].x * gs[i]; s[1] = v[i].y * gs[i]; s[2] = v[i].z * gs[i]; s[3] = v[i].w * gs[i]; }
    LDS_WAIT(); asm volatile("" ::: "memory");
    if constexpr (!F8) {
        const int c = lane & 7;
#pragma unroll
        for (int j = 0; j < 4; ++j) { const int n = (lane >> 3) + 8 * j; const LAS float* s = scr + (8 * c) * 33 + n;
            v4u o; o.x = pk2(s[0 * 33], s[1 * 33]); o.y = pk2(s[2 * 33], s[3 * 33]); o.z = pk2(s[4 * 33], s[5 * 33]); o.w = pk2(s[6 * 33], s[7 * 33]);
            *(GAS v4u*)((bf16*)WT + (size_t)(dst_row0 + n) * Kp + k0 + 8 * c) = o; }
    } else {
        const int c = lane & 3;
#pragma unroll
        for (int j = 0; j < 2; ++j) { const int n = (lane >> 2) + 16 * j; const LAS float* s = scr + (16 * c) * 33 + n;
            v4u o; o.x = pk4_fp8(s[0 * 33], s[1 * 33], s[2 * 33], s[3 * 33]); o.y = pk4_fp8(s[4 * 33], s[5 * 33], s[6 * 33], s[7 * 33]);
            o.z = pk4_fp8(s[8 * 33], s[9 * 33], s[10 * 33], s[11 * 33]); o.w = pk4_fp8(s[12 * 33], s[13 * 33], s[14 * 33], s[15 * 33]);
            *(GAS v4u*)((unsigned char*)WT + (size_t)(dst_row0 + n) * Kp + k0 + 16 * c) = o; }
    }
    LDS_WAIT(); asm volatile("" ::: "memory");
}
__device__ __forceinline__ void rms_row_f32_to_bf16(const float* xrow, const float* g, bf16* orow, bf16* xbrow, unsigned char* o8row, int lane) {
    f32x4 v[2][2]; float s = 0.f;
#pragma unroll
    for (int j = 0; j < 2; ++j)
#pragma unroll
        for (int q = 0; q < 2; ++q) { v[j][q] = *(const GAS f32x4*)(xrow + 512 * j + 8 * lane + 4 * q); s += (v[j][q].x * v[j][q].x + v[j][q].y * v[j][q].y) + (v[j][q].z * v[j][q].z + v[j][q].w * v[j][q].w); }
    const float r = 1.0f / sqrtf(wave_sum(s) * (1.f / D) + EPS);
#pragma unroll
    for (int j = 0; j < 2; ++j) { const int c0 = 512 * j + 8 * lane;
        const f32x4 g0 = *(const GAS f32x4*)(g + c0), g1 = *(const GAS f32x4*)(g + c0 + 4);
        const f32x4 h0 = {v[j][0].x * r * g0.x, v[j][0].y * r * g0.y, v[j][0].z * r * g0.z, v[j][0].w * r * g0.w}, h1 = {v[j][1].x * r * g1.x, v[j][1].y * r * g1.y, v[j][1].z * r * g1.z, v[j][1].w * r * g1.w};
        *(GAS v4u*)(orow + c0) = pg8::pack8(h0, h1);
        *(GAS v4u*)(xbrow + c0) = pg8::pack8(v[j][0], v[j][1]);
        v2u o8; o8.x = pk4_fp8(h0[0], h0[1], h0[2], h0[3]); o8.y = pk4_fp8(h1[0], h1[1], h1[2], h1[3]);
        *(GAS v2u*)(o8row + c0) = o8; }
}

#define MFMA32(a, b, c) __builtin_amdgcn_mfma_f32_32x32x16_bf16((a), (b), (c), 0, 0, 0)
__device__ __forceinline__ bf16x8 ldg16(const bf16* p) { return *(const GAS bf16x8*)p; }
struct KVFrag { bf16x8 k[4], v[4]; };
struct AttAddr { const bf16* K; const bf16* V; int tb, h; unsigned lk, lv; };
__device__ __forceinline__ void att_load(KVFrag& f, const AttAddr& A, int key0_) {
    const int key0 = key0_ < 0 ? 0 : key0_;
    const int r0 = A.tb + key0, h3 = A.h & 3;
#pragma unroll
    for (int kk = 0; kk < 4; ++kk) {
        const unsigned uoff = (unsigned)((((((r0 >> 8) * 2 + (A.h >> 2)) * 8 + ((r0 >> 6) & 1) * 4 + (2 * (h3 & 1) + (kk >> 1))) * 16 + ((r0 >> 7) & 1) * 8 + ((r0 >> 4) & 3) * 2 + (h3 >> 1)) * 512) + (2 * (kk & 1)) * 128);
        f.k[kk] = ldg16(A.K + uoff + A.lk); }
#pragma unroll
    for (int dj = 0; dj < 4; ++dj) { const int dblk = dj >> 1, j = dj & 1;
        const unsigned uoff = (unsigned)(((((((A.h >> 2) * (M / 256) + (r0 >> 8)) * 8 + (h3 & 1) * 4 + ((r0 >> 5) & 3)) * 16 + (h3 >> 1) * 8 + dblk * 4 + ((r0 >> 7) & 1)) * 512) + (2 * j) * 128));
        f.v[dj] = ldg16(A.V + uoff + A.lv); }
}
__device__ __forceinline__ void att_tile(const KVFrag& f, const bf16x8 (&qf)[4], f32x16& o0, f32x16& o1, float& carry, bool diag, int l31, int hl) {
    f32x16 s;
#pragma unroll
    for (int r = 0; r < 16; ++r) s[r] = 0.f;
#pragma unroll
    for (int kk = 0; kk < 4; ++kk) s = MFMA32(f.k[kk], qf[kk], s);
    float kp[16], bt[16];
    float lo = 1.f, hi = 1.f;
#pragma unroll
    for (int r = 0; r < 16; ++r) {
        const int ko = (r < 8) ? (8 * hl + r) : (16 + 8 * hl + (r - 8));
        const float e = __builtin_amdgcn_exp2f(s[r]);
        float k = __builtin_amdgcn_rcpf(1.0f + e);
        float b = e * k;
        if (e > 3.0e38f) b = 1.0f;
        if (diag && ko >= l31) { k = 1.f; b = 0.f; }
        kp[r] = k; bt[r] = b;
        if (r < 8) lo *= k; else hi *= k;
    }
    const float plo = __shfl_xor(lo, 32), phi = __shfl_xor(hi, 32);
    const float after_lo = (hl == 0) ? (plo * hi * phi) : (hi * phi);
    const float after_hi = (hl == 0) ? phi : 1.f;
    float w[16];
    { float run = carry * after_lo;
#pragma unroll
      for (int r = 7; r >= 0; --r) { w[r] = bt[r] * run; run *= kp[r]; } }
    { float run = carry * after_hi;
#pragma unroll
      for (int r = 15; r >= 8; --r) { w[r] = bt[r] * run; run *= kp[r]; } }
    carry *= (lo * hi) * (plo * phi);
    v4u w0, w1;
    w0.x = pk2(w[0], w[1]); w0.y = pk2(w[2], w[3]); w0.z = pk2(w[4], w[5]); w0.w = pk2(w[6], w[7]);
    w1.x = pk2(w[8], w[9]); w1.y = pk2(w[10], w[11]); w1.z = pk2(w[12], w[13]); w1.w = pk2(w[14], w[15]);
    const bf16x8 W0 = __builtin_bit_cast(bf16x8, w0), W1 = __builtin_bit_cast(bf16x8, w1);
    o0 = MFMA32(f.v[0], W0, o0); o0 = MFMA32(f.v[1], W1, o0);
    o1 = MFMA32(f.v[2], W0, o1); o1 = MFMA32(f.v[3], W1, o1);
}
__device__ __forceinline__ void attn_task(const bf16* __restrict__ Q, const bf16* __restrict__ Kp, const bf16* __restrict__ Vt, bf16* __restrict__ Y, int b, int h, int qb, int lane) {
    const int l31 = lane & 31, hl = lane >> 5;
    const int t0 = qb * 32; const size_t tb = (size_t)b * SEQ;
    const int a_ = l31 >> 3, hh = (l31 >> 2) & 1, c_ = l31 & 3;
    const int pim = 16 * (a_ >> 1) + 8 * hh + 4 * (a_ & 1) + c_;
    AttAddr A; A.K = Kp; A.V = Vt; A.tb = (int)tb; A.h = h;
    A.lk = (unsigned)((pim >> 4) * 1024 + (hl * 16 + (pim & 15)) * 8);
    A.lv = (unsigned)((l31 >> 4) * 1024 + (hl * 16 + (l31 & 15)) * 8);
    bf16x8 qf[4];
    { const int r0 = (int)tb + t0, h3 = h & 3; const unsigned lq = (unsigned)((l31 >> 4) * 1024 + (hl * 16 + (l31 & 15)) * 8);
#pragma unroll
      for (int kk = 0; kk < 4; ++kk) {
          const unsigned uoff = (unsigned)((((((r0 >> 8) * 2 + (h >> 2)) * 8 + ((r0 >> 6) & 1) * 4 + (2 * (h3 & 1) + (kk >> 1))) * 16 + ((r0 >> 7) & 1) * 8 + ((r0 >> 4) & 3) * 2 + (h3 >> 1)) * 512) + (2 * (kk & 1)) * 128);
          qf[kk] = ldg16(Q + uoff + lq); } }
    f32x16 o0, o1;
#pragma unroll
    for (int r = 0; r < 16; ++r) { o0[r] = 0.f; o1[r] = 0.f; }
    float carry = 1.f;
    int key0 = t0;
    KVFrag b0, b1, b2;
    att_load(b0, A, key0); att_load(b1, A, key0 - 32);
    bool diag = true;
#define ATT_STEP(cur, pre) { att_load(pre, A, key0 - 64); att_tile(cur, qf, o0, o1, carry, diag, l31, hl); diag = false; \
        if (key0 - 32 < 0) break; if (__all(carry == 0.f)) break; key0 -= 32; }
    for (;;) { ATT_STEP(b0, b2) ATT_STEP(b1, b0) ATT_STEP(b2, b1) }
#undef ATT_STEP
    bf16* yrow = Y + (tb + t0 + l31) * 512 + h * 64 + 4 * hl;
#pragma unroll
    for (int a = 0; a < 4; ++a) {
        v2u p0, p1; p0.x = pk2(o0[4 * a], o0[4 * a + 1]); p0.y = pk2(o0[4 * a + 2], o0[4 * a + 3]); p1.x = pk2(o1[4 * a], o1[4 * a + 1]); p1.y = pk2(o1[4 * a + 2], o1[4 * a + 3]);
        *(GAS v2u*)(yrow + 8 * a) = p0; *(GAS v2u*)(yrow + 32 + 8 * a) = p1;
    }
}

__device__ __forceinline__ void pool_unpack(const v4u v, float (&f)[8]) { f[0] = bflo(v.x); f[1] = bfhi(v.x); f[2] = bflo(v.y); f[3] = bfhi(v.y); f[4] = bflo(v.z); f[5] = bfhi(v.z); f[6] = bflo(v.w); f[7] = bfhi(v.w); }
__device__ __forceinline__ void pool_item(const bf16* __restrict__ U, bf16* __restrict__ P, int tok0, int lane) {
    const int t0 = tok0 & (SEQ - 1); const int g = lane >> 4; const int w = 2 << g;
    v4u row[31];
#pragma unroll
    for (int r = 0; r < 31; ++r) { const int rr = (t0 == 0 && r < 15) ? 15 : r; row[r] = *(const GAS v4u*)(U + (size_t)(tok0 - 15 + rr) * 512 + 8 * lane); }
    if (t0 == 0) {
#pragma unroll
        for (int r = 0; r < 15; ++r) row[r] = (v4u){0u, 0u, 0u, 0u};
    }
    float S[8], f[8];
    pool_unpack(row[15], S); pool_unpack(row[14], f);
#pragma unroll
    for (int q = 0; q < 8; ++q) S[q] += f[q];
    float acc4[8], acc8[8], acc16[8];
#pragma unroll
    for (int q = 0; q < 8; ++q) acc4[q] = S[q];
#pragma unroll
    for (int r = 13; r >= 12; --r) { pool_unpack(row[r], f);
#pragma unroll
        for (int q = 0; q < 8; ++q) acc4[q] += f[q]; }
#pragma unroll
    for (int q = 0; q < 8; ++q) acc8[q] = acc4[q];
#pragma unroll
    for (int r = 11; r >= 8; --r) { pool_unpack(row[r], f);
#pragma unroll
        for (int q = 0; q < 8; ++q) acc8[q] += f[q]; }
#pragma unroll
    for (int q = 0; q < 8; ++q) acc16[q] = acc8[q];
#pragma unroll
    for (int r = 7; r >= 0; --r) { pool_unpack(row[r], f);
#pragma unroll
        for (int q = 0; q < 8; ++q) acc16[q] += f[q]; }
#pragma unroll
    for (int q = 0; q < 8; ++q) S[q] = (g == 0) ? S[q] : (g == 1 ? acc4[q] : (g == 2 ? acc8[q] : acc16[q]));
#pragma unroll
    for (int i = 0; i < 16; ++i) {
        float cur[8]; pool_unpack(row[15 + i], cur);
        if (i > 0) {
            const v4u lv = (g == 0) ? row[15 + i - 2] : (g == 1 ? row[15 + i - 4] : (g == 2 ? row[15 + i - 8] : row[15 + i - 16]));
            pool_unpack(lv, f);
#pragma unroll
            for (int q = 0; q < 8; ++q) S[q] += cur[q] - f[q];
        }
        const int t = t0 + i; const int cnt = (t + 1) < w ? (t + 1) : w; const float inv = 1.0f / (float)cnt;
        v4u o; o.x = pk2(S[0] * inv - cur[0], S[1] * inv - cur[1]); o.y = pk2(S[2] * inv - cur[2], S[3] * inv - cur[3]);
        o.z = pk2(S[4] * inv - cur[4], S[5] * inv - cur[5]); o.w = pk2(S[6] * inv - cur[6], S[7] * inv - cur[7]);
        *(GAS v4u*)(P + (size_t)(tok0 + i) * 512 + 8 * lane) = o;
    }
}

__device__ __forceinline__ void router_task(const bf16* __restrict__ X1, const bf16* __restrict__ WrF, const float* __restrict__ b_router, int T0, int lane,
                                            const float* __restrict__ SSQP_, float* __restrict__ R2_, unsigned char* __restrict__ H2, int* __restrict__ TKE_, float* __restrict__ TKW_, LAS int* lds_e  ) {
    const int l31 = lane & 31, hl = lane >> 5;
    const bf16* xr = X1 + (size_t)(T0 + l31) * 1024 + 8 * hl;
    f32x16 acc;
#pragma unroll
    for (int r = 0; r < 16; ++r) acc[r] = 0.f;
    float ssq = 0.f;
    { const GAS f32x4* sp = (const GAS f32x4*)(SSQP_ + (size_t)(T0 + l31) * 16);
#pragma unroll
      for (int j = 0; j < 4; ++j) { const f32x4 t = sp[j]; ssq += (t[0] + t[1]) + (t[2] + t[3]); } }
    const float r = 1.0f / sqrtf(ssq * (1.f / D) + EPS);
    unsigned char* hw = H2 + (size_t)(T0 + l31) * 1024 + 16 * hl;
#pragma unroll 4
    for (int kk = 0; kk < 64; kk += 2) {
        v2u o[2];
#pragma unroll
        for (int q = 0; q < 2; ++q) {
            const v4u xv = *(const GAS v4u*)(xr + 16 * (kk + q));
            const bf16x8 ah = ldg16(WrF + ((size_t)(kk + q) * 64 + lane) * 8), al = ldg16(WrF + 32768 + ((size_t)(kk + q) * 64 + lane) * 8);
            o[q].x = pk4_fp8(bflo(xv.x) * r, bfhi(xv.x) * r, bflo(xv.y) * r, bfhi(xv.y) * r); o[q].y = pk4_fp8(bflo(xv.z) * r, bfhi(xv.z) * r, bflo(xv.w) * r, bfhi(xv.w) * r);
            const bf16x8 xb = __builtin_bit_cast(bf16x8, xv);
            acc = MFMA32(ah, xb, acc); acc = MFMA32(al, xb, acc);
        }
        unsigned ax = o[0].x, ay = o[0].y, bx = o[1].x, by = o[1].y;
        { const auto r0 = __builtin_amdgcn_permlane32_swap(ax, bx, false, false); ax = r0[0]; bx = r0[1]; const auto r1 = __builtin_amdgcn_permlane32_swap(ay, by, false, false); ay = r1[0]; by = r1[1]; }
        v4u ow; ow.x = ax; ow.y = ay; ow.z = bx; ow.w = by;
        *(GAS v4u*)(hw + 16 * kk) = ow;
    }
    float v[16];
#pragma unroll
    for (int q = 0; q < 16; ++q) { const int e = 8 * (q >> 2) + 4 * hl + (q & 3); v[q] = acc[q] * r + b_router[e]; }
    float cv[8]; int ce[8];
#pragma unroll
    for (int k = 0; k < 4; ++k) {
        float best = -3.0e38f; int bi = 0;
#pragma unroll
        for (int q = 0; q < 16; ++q) { if (v[q] > best) { best = v[q]; bi = q; } }
        cv[k] = best; ce[k] = 8 * (bi >> 2) + 4 * hl + (bi & 3);
#pragma unroll
        for (int q = 0; q < 16; ++q) { if (q == bi) v[q] = -3.0e38f; }
    }
#pragma unroll
    for (int k = 0; k < 4; ++k) { cv[4 + k] = __shfl_xor(cv[k], 32); ce[4 + k] = __shfl_xor(ce[k], 32); }
    float tv[4]; int te[4];
#pragma unroll
    for (int k = 0; k < 4; ++k) {
        float best = -3.0e38f; int be = 1 << 20; int bi = 0;
#pragma unroll
        for (int q = 0; q < 8; ++q) { if (cv[q] > best || (cv[q] == best && ce[q] < be)) { best = cv[q]; be = ce[q]; bi = q; } }
        tv[k] = best; te[k] = be;
#pragma unroll
        for (int q = 0; q < 8; ++q) { if (q == bi) { cv[q] = -3.0e38f; ce[q] = 1 << 21; } }
    }
    const float p1 = __expf(tv[1] - tv[0]), p2 = __expf(tv[2] - tv[0]), p3 = __expf(tv[3] - tv[0]);
    const float inv = 1.0f / (1.0f + p1 + p2 + p3);
    if (hl == 0) {
        const int tok = T0 + l31;
        R2_[tok] = r;
        *(GAS v4i*)(TKE_ + (size_t)tok * 4) = (v4i){te[0], te[1], te[2], te[3]};
        *(GAS f32x4*)(TKW_ + (size_t)tok * 4) = (f32x4){inv, p1 * inv, p2 * inv, p3 * inv};
        lds_e[l31 * 4 + 0] = te[0]; lds_e[l31 * 4 + 1] = te[1]; lds_e[l31 * 4 + 2] = te[2]; lds_e[l31 * 4 + 3] = te[3];
    }
}


#define IN_(i) (args.in[i])
#define x_ IN_(0)
#define p_in IN_(1)
#define g_mix IN_(2)
#define w_in IN_(3)
#define w_pool_grp IN_(4)
#define pool_scale IN_(5)
#define w_pool_up IN_(6)
#define w_attn_up IN_(7)
#define w_out IN_(8)
#define g_ffn IN_(9)
#define w_router IN_(10)
#define b_router IN_(11)
#define w_gu IN_(12)
#define b_gu IN_(13)
#define w_down IN_(14)
#define b_down IN_(15)
#define g_ple IN_(16)
#define w_ple_gate IN_(17)
#define w_ple_proj IN_(18)
#define g_final IN_(19)
#define WSP(T, off) ((T*)(args.ws + (off)))
#define R2 WSP(float, WS_R2)
#define R3 WSP(float, WS_R3)
#define TKE WSP(int, WS_TKE)
#define TKW WSP(float, WS_TKW)
#define TKR WSP(int, WS_TKR)
#define ROWT WSP(int, WS_ROWT)
#define CNTWG WSP(int, WS_CNTWG)
#define SEGTOT WSP(int, WS_SEGTOT)
#define CUR WSP(int, WS_CUR)
#define ROWREL WSP(int, WS_ROWREL)
#define WRF WSP(bf16, WS_WRF)
#define WIN WSP(bf16, WS_WIN)
#define WEFF WSP(bf16, WS_WEFF)
#define WAU WSP(bf16, WS_WAU)
#define WOUT WSP(bf16, WS_WOUT)
#define WPG WSP(unsigned char, WS_WPG)
#define X2F8 WSP(unsigned char, WS_H2F8)
#define WPP WSP(bf16, WS_WPP)
#define WGU WSP(unsigned char, WS_WGU)
#define WDN WSP(unsigned char, WS_WDN)
#define H2F8 WSP(unsigned char, WS_H2F8)
#define TKS WSP(int, WS_TKS)
#define H1 WSP(bf16, WS_A)
#define H1F8 WSP(unsigned char, WS_H2F8)
#define WG8 WSP(unsigned char, WS_WG8)
#define MRG WSP(bf16, WS_C)
#define PPB WSP(bf16, WS_A)
#define UB WSP(bf16, WS_B)
#define QB WSP(bf16, WS_B + 64 * MiB)
#define X1 WSP(bf16, WS_B)
#define KB WSP(bf16, WS_C)
#define VT WSP(bf16, WS_C + 64 * MiB)
#define X2 WSP(bf16, WS_B)
#define POOL WSP(bf16, WS_E)
#define YATT WSP(bf16, WS_E + 64 * MiB)
#define X3 WSP(bf16, WS_E)
#define PB WSP(bf16, WS_PB)
#define GPB WSP(bf16, WS_G)
#define GAB WSP(bf16, WS_G + 128 * MiB)
#define XB ((bf16*)args.out)
#define ACT WSP(unsigned char, WS_ACT)

__global__ void __launch_bounds__(NWAVES * 64, 2) mk_fwd(Args args) {
    extern __shared__ __attribute__((aligned(16))) unsigned char lds[];
    Frame F;
    F.lds = (LAS unsigned char*)lds;
    F.MISC = (volatile LAS unsigned*)(F.lds + MISC_OFF);
    F.wave = __builtin_amdgcn_readfirstlane((int)threadIdx.x >> 6);
    F.G = gridDim.x; { const int bx = blockIdx.x; F.vcu = (F.G % 8 == 0) ? (bx % 8) * (F.G / 8) + bx / 8 : bx; }
    unsigned char* ws = args.ws;
    F.ctl = (gu32*)(ws + WS_CTL);
    for (int u = (int)threadIdx.x; u < (LDS_BYTES - LDSCTL_OFF) / 4; u += NWAVES * 64) ((LAS unsigned*)(F.lds + LDSCTL_OFF))[u] = 0u;
    __syncthreads();
    const int lo = args.ph_lo, hi = args.ph_hi;
    XcdBarrier bar; bar.bar = (unsigned*)(F.ctl + CW_BAR); bar.x = 0; bar.st = nullptr;
    if (hi - lo > 1) bar = xcd_barrier_post((unsigned*)(F.ctl + CW_BAR), F.MISC + 8, F.wave);
#define IN(k) (lo <= (k) && (k) < hi)
#define BOTH(k) (IN(k) && IN((k) + 1))
#define GRID_BAR() xcd_barrier(bar, F.wave)

    const int gw = F.vcu * NWAVES + F.wave, NGW = F.G * NWAVES;
    LAS int* ltab = (LAS int*)(F.lds + LDS_TAB_OFF);

    if (IN(0)) { for (int rep_ = 0; rep_ < REPS(0); ++rep_) {
        const int lane_ = lane_id_v(), tid_ = F.wave * 64 + lane_;
        LAS float* scr = (LAS float*)(F.lds + F.wave * 16384);
        constexpr int I_IN = 16 * 128, I_AU = 8 * 32, I_OUT = 16 * 32, I_PG = 16 * 32, I_PP = 4 * 32, I_GU = 32 * 16 * 64, I_DN = 32 * 16 * 32;
        constexpr int NITEMS = I_IN + I_AU + I_OUT + I_PG + I_PP + I_GU + I_DN;
        for (int it = gw; it < NITEMS; it += NGW) {
            int r = it;
            if (r < I_IN) { const int kb = r / 128, nb = r % 128, n0 = nb * 32;
                const int blk = n0 / 512;
                if (blk >= 4) { p0_transpose_item<true>(w_in, 4096, kb * 64, n0, WG8, 1024, n0 - 2048, nullptr, WSCALE, scr, lane_); continue; }
                const int dst = (blk < 3) ? n0 : 3584 + (n0 - 1536);
                p0_transpose_item<false>(w_in, 4096, kb * 64, n0, WIN, 1024, dst, nullptr, 1.0f, scr, lane_); continue; } r -= I_IN;
            if (r < I_AU) { const int kb = r / 32, nb = r % 32; p0_transpose_item<false>(w_attn_up, 1024, kb * 64, nb * 32, WAU, 512, nb * 32, nullptr, 1.0f, scr, lane_); continue; } r -= I_AU;
            if (r < I_OUT) { const int kb = r / 32, nb = r % 32; p0_transpose_item<false>(w_out, 1024, kb * 64, nb * 32, WOUT, 1024, nb * 32, nullptr, 1.0f, scr, lane_); continue; } r -= I_OUT;
            if (r < I_PG) { const int kb = r / 32, nb = r % 32; p0_transpose_item<true>(w_ple_gate, 1024, kb * 64, nb * 32, WPG, 1024, nb * 32, g_ple, WSCALE, scr, lane_); continue; } r -= I_PG;
            if (r < I_PP) { const int kb = r / 32, nb = r % 32; p0_transpose_item<false>(w_ple_proj, 1024, kb * 64, nb * 32, WPP, 256, nb * 32, nullptr, 1.0f, scr, lane_); continue; } r -= I_PP;
            if (r < I_GU) { const int e = r / 1024, q = r % 1024, kb = q / 64, nb = q % 64, n0 = nb * 32;
                const int j = n0 & 1023; const int dst = 256 * (j / 128) + (j % 128) + (n0 >= 1024 ? 128 : 0);
                p0_transpose_item<true>(w_gu + (size_t)e * 1024 * 2048, 2048, kb * 64, n0, WGU + (size_t)e * 2048 * 1024, 1024, dst, g_ffn, WSCALE, scr, lane_); continue; } r -= I_GU;
            { const int e = r / 512, q = r % 512, kb = q / 32, nb = q % 32;
                p0_transpose_item<true>(w_down + (size_t)e * 1024 * 1024, 1024, kb * 64, nb * 32, WDN + (size_t)e * 1024 * 1024, 1024, nb * 32, nullptr, WSCALE, scr, lane_); }
        }
        for (int it = gw; it < 4 * 16 * 16; it += NGW) {
            const int g = it >> 8, cb = (it >> 4) & 15, db = it & 15; const int d = db * 64 + lane_, c0 = cb * 8;
            float a8[8];
#pragma unroll
            for (int q = 0; q < 8; ++q) a8[q] = 0.f;
            for (int j = 0; j < 128; ++j) { const float wv = w_pool_up[(size_t)(g * 128 + j) * 1024 + d] * pool_scale[g * 128 + j];
#pragma unroll
                for (int q = 0; q < 8; ++q) a8[q] += w_pool_grp[(size_t)(g * 128 + c0 + q) * 128 + j] * wv; }
            v4u o; o.x = pk2(a8[0], a8[1]); o.y = pk2(a8[2], a8[3]); o.z = pk2(a8[4], a8[5]); o.w = pk2(a8[6], a8[7]);
            *(GAS v4u*)(WEFF + (size_t)d * 512 + g * 128 + c0) = o;
        }
        for (int it = gw * 64 + lane_; it < 64 * 64; it += NGW * 64) {
            const int kk = it >> 6, l = it & 63, e = l & 31, k0 = 16 * kk + 8 * (l >> 5);
            unsigned hb[8], lb[8];
#pragma unroll
            for (int i = 0; i < 8; ++i) { const float v = g_ffn[k0 + i] * w_router[(size_t)(k0 + i) * 32 + e]; hb[i] = f2bf(v); lb[i] = f2bf(v - __builtin_bit_cast(float, hb[i] << 16)); }
            v4u oh, ol; oh.x = hb[0] | (hb[1] << 16); oh.y = hb[2] | (hb[3] << 16); oh.z = hb[4] | (hb[5] << 16); oh.w = hb[6] | (hb[7] << 16);
            ol.x = lb[0] | (lb[1] << 16); ol.y = lb[2] | (lb[3] << 16); ol.z = lb[4] | (lb[5] << 16); ol.w = lb[6] | (lb[7] << 16);
            *(GAS v4u*)(WRF + (size_t)it * 8) = oh; *(GAS v4u*)(WRF + 32768 + (size_t)it * 8) = ol;
        }
        for (int m = gw; m < M; m += NGW) rms_row_f32_to_bf16(x_ + (size_t)m * D, g_mix, H1 + (size_t)m * D, XB + (size_t)m * D, H1F8 + (size_t)m * D, lane_);
        for (size_t i = (size_t)gw * 64 + lane_; i < (size_t)M * PLE / 8; i += (size_t)NGW * 64) {
            const f32x4 a = *(const GAS f32x4*)(p_in + i * 8), b = *(const GAS f32x4*)(p_in + i * 8 + 4);
            *(GAS v4u*)(PB + i * 8) = pg8::pack8(a, b);
        }
        if (BOTH(0) || rep_ + 1 < REPS(0)) GRID_BAR();
    } }

    if (IN(1)) { for (int rep_ = 0; rep_ < REPS(1); ++rep_) {
        { pg8::Gemm g{H1, WIN, D}; pg8::StaticOrder S; S.init(M, 1536, F.G, (int)blockIdx.x);
          pg8::EpiProj E{UB, QB, KB};
          pg8::gemm_phase<pg8::EpiProj, pg8::StaticOrder, true>(F.lds, g, S, E, F.wave, STAGGER_P1); }
        { pg8::Gemm g{H1F8, WG8, D}; pg8::StaticOrder S; S.init(M, 2048, F.G, (int)blockIdx.x);
          pg8::EpiGate8 E{GPB, GAB};
          pg8::gemm_phase<pg8::EpiGate8, pg8::StaticOrder, true, 1>(F.lds, g, S, E, F.wave); }
        { pg8::Gemm g{WIN + (size_t)NPROJ_A * D, H1, D}; pg8::StaticOrder S; S.init(512, M, F.G, (int)blockIdx.x);
          pg8::EpiNative E{VT, M / 256};
          pg8::gemm_phase<pg8::EpiNative, pg8::StaticOrder, true>(F.lds, g, S, E, F.wave); }
        if (BOTH(1) || rep_ + 1 < REPS(1)) GRID_BAR();
    } }

    if (IN(2)) { for (int rep_ = 0; rep_ < REPS(2); ++rep_) {
        const int lane_ = lane_id_v(), tid_ = F.wave * 64 + lane_;
        for (int T = gw; T < NB * NH * (SEQ / 32); T += NGW) {
            const int qb = T & 127, h = (T >> 7) & 7, b = T >> 10;
            attn_task(QB, KB, VT, YATT, b, h, qb, lane_);
        }
        for (int it = gw; it < M / 16; it += NGW) pool_item(UB, POOL, it * 16, lane_);
        if (BOTH(2) || rep_ + 1 < REPS(2)) GRID_BAR();
    } }

    if (IN(3)) { for (int rep_ = 0; rep_ < REPS(3); ++rep_) {
        pg8::Gemm g{POOL, WEFF, PW}; pg8::DualOrder S; S.init(M, D, F.G, (int)blockIdx.x);
        pg8::EpiDual E{MRG, GPB, GAB};
        pg8::gemm_phase<pg8::EpiDual, pg8::DualOrder, true>(F.lds, g, S, E, F.wave);
        if (IN(5) || rep_ + 1 < REPS(3)) GRID_BAR();
    } }
    if (IN(5)) { for (int rep_ = 0; rep_ < REPS(5); ++rep_) {
        pg8::Gemm g{MRG, WOUT, D}; pg8::StaticOrder S; S.init(M, D, F.G, (int)blockIdx.x);
        pg8::EpiResid E{X1, XB, WSP(float, WS_SSQP)};
        pg8::gemm_phase<pg8::EpiResid, pg8::StaticOrder, true>(F.lds, g, S, E, F.wave);
        if (BOTH(5) || rep_ + 1 < REPS(5)) GRID_BAR();
    } }

    if (IN(6)) { for (int rep_ = 0; rep_ < REPS(6); ++rep_) {
        const int lane_ = lane_id_v(), tid_ = F.wave * 64 + lane_;
        LAS int* lcnt = ltab;
        LAS int* le = ltab + 128;
        for (int chunk = F.vcu; chunk < M / 256; chunk += F.G) {
            if (tid_ < 128) lcnt[tid_] = 0;
            router_task(X1, WRF, b_router, chunk * 256 + F.wave * 32, lane_, WSP(float, WS_SSQP), R2, H2F8, TKE, TKW, le + F.wave * 128);
            __syncthreads();
            v4i rk = {0, 0, 0, 0};
            if (tid_ < 256) {
#pragma unroll
                for (int k = 0; k < 4; ++k) rk[k] = __hip_atomic_fetch_add((int*)(lcnt + k * 32 + le[tid_ * 4 + k]), 1, __ATOMIC_RELAXED, __HIP_MEMORY_SCOPE_WORKGROUP);
            }
            __syncthreads();
            if (tid_ < 128) lcnt[tid_] = __hip_atomic_fetch_add(CUR + tid_, lcnt[tid_], RLX_AGENT);
            __syncthreads();
            if (tid_ < 256) {
                const int tok = chunk * 256 + tid_;
#pragma unroll
                for (int k = 0; k < 4; ++k) { const int sg = k * 32 + le[tid_ * 4 + k]; rk[k] += lcnt[sg]; ROWREL[(size_t)sg * 65536 + rk[k]] = tok; }
                *(GAS v4i*)(TKR + (size_t)tok * 4) = rk;
            }
            __syncthreads();
        }
        if (IN(8) || rep_ + 1 < REPS(6)) GRID_BAR();
    } }

    if (IN(8) || IN(9) || IN(16)) {
        const int tid_ = F.wave * 64 + lane_id_v();
        __syncthreads();
        if (tid_ < 32) {
            const int t0_ = CUR[tid_], t1_ = CUR[32 + tid_], t2_ = CUR[64 + tid_], t3_ = CUR[96 + tid_];
            const int cn = t0_ + t1_ + t2_ + t3_; int nt_ = (cn + 255) >> 8, pt = nt_, ps = cn;
#pragma unroll
            for (int o = 1; o < 32; o <<= 1) { const int a = __shfl_up(pt, o), b = __shfl_up(ps, o); if (tid_ >= o) { pt += a; ps += b; } }
            ltab[tid_] = pt - nt_; ltab[33 + tid_] = ps - cn; ltab[65 + tid_] = cn; if (tid_ == 31) ltab[32] = pt;
            ltab[98 + tid_] = t0_; ltab[130 + tid_] = t1_; ltab[162 + tid_] = t2_; ltab[194 + tid_] = t3_;
            ltab[226 + tid_] = ps - cn; ltab[258 + tid_] = ps - cn + t0_; ltab[290 + tid_] = ps - cn + t0_ + t1_; ltab[322 + tid_] = ps - cn + t0_ + t1_ + t2_; }
        __syncthreads();
    }
    {
        const int T = __builtin_amdgcn_readfirstlane(ltab[32]);
        if (IN(8)) { for (int rep_ = 0; rep_ < REPS(8); ++rep_) {
            pg8::Gemm g{H2F8, WGU, D};
            pg8::MoeOrder<true> S{ltab, ROWREL, WGU, 8, F.G, F.vcu, T * 8, (size_t)2048 * 1024};
            pg8::EpiMoe1 E{ACT, b_gu};
            pg8::gemm_phase<pg8::EpiMoe1, pg8::MoeOrder<true>, MOE_ALIGN, 1>(F.lds, g, S, E, F.wave, STAGGER_MOE);
            if (BOTH(8) || rep_ + 1 < REPS(8)) GRID_BAR();
        } }
        if (IN(9)) { for (int rep_ = 0; rep_ < REPS(9); ++rep_) {
            pg8::Gemm g{ACT, WDN, DE};
            pg8::MoeOrder<false> S{ltab, ROWREL, WDN, 4, F.G, F.vcu, T * 4, (size_t)1024 * 1024};
            pg8::EpiMoe2 E{WSP(unsigned char, WS_C), b_down};
            pg8::gemm_phase<pg8::EpiMoe2, pg8::MoeOrder<false>, MOE_ALIGN, 1>(F.lds, g, S, E, F.wave, STAGGER_MOE);
            if (IN(16) || rep_ + 1 < REPS(9)) GRID_BAR();
        } }
    }

    if (IN(16)) { for (int rep_ = 0; rep_ < REPS(16); ++rep_) {
        const int lane_ = lane_id_v();
        for (int t0 = gw * 4; t0 < M; t0 += NGW * 4) {
            v4i sl[4]; f32x4 tw[4];
#pragma unroll
            for (int i = 0; i < 4; ++i) { const v4i te_ = *(const GAS v4i*)(TKE + (size_t)(t0 + i) * 4), tr_ = *(const GAS v4i*)(TKR + (size_t)(t0 + i) * 4); tw[i] = *(const GAS f32x4*)(TKW + (size_t)(t0 + i) * 4);
#pragma unroll
                for (int k = 0; k < 4; ++k) sl[i][k] = ltab[226 + 32 * k + te_[k]] + tr_[k]; }
#pragma unroll
            for (int i = 0; i < 4; ++i) {
                bf16* xrow = X1 + (size_t)(t0 + i) * D;
                v4u xv[2], yv[4];
                xv[0] = ((const GAS v4u*)xrow)[2 * lane_]; xv[1] = ((const GAS v4u*)xrow)[2 * lane_ + 1];
#pragma unroll
                for (int k = 0; k < 4; ++k) yv[k] = ((const GAS v4u*)(WSP(unsigned char, WS_C) + (size_t)sl[i][k] * D))[lane_];
                float a[16];
                { f32x4 a0, a1, a2, a3; pg8::unpack8(xv[0], a0, a1); pg8::unpack8(xv[1], a2, a3);
#pragma unroll
                  for (int q = 0; q < 4; ++q) { a[q] = a0[q]; a[4 + q] = a1[q]; a[8 + q] = a2[q]; a[12 + q] = a3[q]; } }
#pragma unroll
                for (int k = 0; k < 4; ++k) { const float wk = tw[i][k]; const unsigned yy[4] = {yv[k].x, yv[k].y, yv[k].z, yv[k].w};
#pragma unroll
                    for (int q = 0; q < 4; ++q) { const f32x2 lo2 = __builtin_amdgcn_cvt_pk_f32_fp8((int)yy[q], false), hi2 = __builtin_amdgcn_cvt_pk_f32_fp8((int)yy[q], true);
                        a[4 * q + 0] += lo2[0] * wk; a[4 * q + 1] += lo2[1] * wk; a[4 * q + 2] += hi2[0] * wk; a[4 * q + 3] += hi2[1] * wk; } }
                v4u o0, o1; o0.x = pk2(a[0], a[1]); o0.y = pk2(a[2], a[3]); o0.z = pk2(a[4], a[5]); o0.w = pk2(a[6], a[7]); o1.x = pk2(a[8], a[9]); o1.y = pk2(a[10], a[11]); o1.z = pk2(a[12], a[13]); o1.w = pk2(a[14], a[15]);
                float b[16];
                { f32x4 b0, b1, b2, b3; pg8::unpack8(o0, b0, b1); pg8::unpack8(o1, b2, b3);
#pragma unroll
                  for (int q = 0; q < 4; ++q) { b[q] = b0[q]; b[4 + q] = b1[q]; b[8 + q] = b2[q]; b[12 + q] = b3[q]; } }
                float s = 0.f;
#pragma unroll
                for (int q = 0; q < 16; ++q) s += b[q] * b[q];
                ((GAS v4u*)xrow)[2 * lane_] = o0; ((GAS v4u*)xrow)[2 * lane_ + 1] = o1;
                v4u o8; o8.x = pk4_fp8(b[0], b[1], b[2], b[3]); o8.y = pk4_fp8(b[4], b[5], b[6], b[7]); o8.z = pk4_fp8(b[8], b[9], b[10], b[11]); o8.w = pk4_fp8(b[12], b[13], b[14], b[15]);
                ((GAS v4u*)(X2F8 + (size_t)(t0 + i) * D))[lane_] = o8;
                s = wave_sum(s);
                if (lane_ == 0) R3[t0 + i] = 1.0f / sqrtf(s * (1.f / D) + EPS);
            }
        }
        {
            pg8::Gemm g{PB, WPP, PLE}; pg8::StaticOrder S; S.init(M, D, F.G, (int)blockIdx.x);
            pg8::EpiNative E{PPB, 4};
            pg8::gemm_phase<pg8::EpiNative, pg8::StaticOrder, true>(F.lds, g, S, E, F.wave);
        }
        if (IN(18) || rep_ + 1 < REPS(16)) GRID_BAR();
    } }
    if (IN(18)) { for (int rep_ = 0; rep_ < REPS(18); ++rep_) {
        pg8::Gemm g{X2F8, WPG, D}; pg8::StaticOrder S; S.init(M, D, F.G, (int)blockIdx.x);
        pg8::EpiPle E{X3, X2, PPB, R3};
        pg8::gemm_phase<pg8::EpiPle, pg8::StaticOrder, true, 1>(F.lds, g, S, E, F.wave);
        if (BOTH(18) || rep_ + 1 < REPS(18)) GRID_BAR();
    } }
    if (IN(19)) { for (int rep_ = 0; rep_ < REPS(19); ++rep_) {
        const int lane_ = lane_id_v();
        for (int m = gw; m < M; m += NGW) {
            const GAS v4u* xr = (const GAS v4u*)(X3 + (size_t)m * D) + lane_; const GAS v4u* x2r = (const GAS v4u*)(X2 + (size_t)m * D) + lane_; float f[2][8]; float s = 0.f;
#pragma unroll
            for (int j = 0; j < 2; ++j) { const v4u v = xr[64 * j], w2 = x2r[64 * j]; f[j][0] = bflo(v.x) + bflo(w2.x); f[j][1] = bfhi(v.x) + bfhi(w2.x); f[j][2] = bflo(v.y) + bflo(w2.y); f[j][3] = bfhi(v.y) + bfhi(w2.y); f[j][4] = bflo(v.z) + bflo(w2.z); f[j][5] = bfhi(v.z) + bfhi(w2.z); f[j][6] = bflo(v.w) + bflo(w2.w); f[j][7] = bfhi(v.w) + bfhi(w2.w);
#pragma unroll
                for (int q = 0; q < 8; ++q) s += f[j][q] * f[j][q]; }
            s = wave_sum(s);
            const float r = 1.0f / sqrtf(s * (1.f / D) + EPS);
#pragma unroll
            for (int j = 0; j < 2; ++j) { const int c0 = (64 * j + lane_) * 8;
                const f32x4 g0 = *(const GAS f32x4*)(g_final + c0), g1 = *(const GAS f32x4*)(g_final + c0 + 4);
                f32x4 o0 = {f[j][0] * r * g0.x, f[j][1] * r * g0.y, f[j][2] * r * g0.z, f[j][3] * r * g0.w}, o1 = {f[j][4] * r * g1.x, f[j][5] * r * g1.y, f[j][6] * r * g1.z, f[j][7] * r * g1.w};
                *(GAS f32x4*)(args.out + (size_t)m * D + c0) = o0; *(GAS f32x4*)(args.out + (size_t)m * D + c0 + 4) = o1; }
        }
    } }
#undef IN
#undef BOTH
#undef GRID_BAR
}

extern "C" void kernel_launch(void* const* d_in, const int* in_sizes, int n_in, void* d_out, int out_size, void* d_ws, size_t ws_size, hipStream_t stream) {
    static int grid = 0;
    if (grid == 0) {
        if (n_in != 20 || out_size != M * D || ws_size < WS_END) { fprintf(stderr, "kernel_launch: unexpected shapes (n_in %d, out %d, ws %zu); nothing launched\n", n_in, out_size, ws_size); grid = -1; return; }
        int dev = 0, cus = 0, per_cu = 0;
        if (hipGetDevice(&dev) != hipSuccess || hipDeviceGetAttribute(&cus, hipDeviceAttributeMultiprocessorCount, dev) != hipSuccess) { grid = -1; return; }
        if (hipFuncSetAttribute((const void*)mk_fwd, hipFuncAttributeMaxDynamicSharedMemorySize, LDS_BYTES) != hipSuccess) { fprintf(stderr, "kernel_launch: hipFuncSetAttribute failed\n"); grid = -1; return; }
        if (hipOccupancyMaxActiveBlocksPerMultiprocessor(&per_cu, (const void*)mk_fwd, NWAVES * 64, LDS_BYTES) != hipSuccess || per_cu < 1)
            fprintf(stderr, "kernel_launch: note: occupancy query reports %d workgroups per CU\n", per_cu);
        (void)hipGetLastError();
        grid = cus;
    }
    if (grid < 0) return;
    if (hipMemsetAsync((char*)d_ws + WS_CTL, 0, CTL_ZERO_BYTES, stream) != hipSuccess) return;
    Args a{};
    for (int i = 0; i < 20; ++i) a.in[i] = (const float*)d_in[i];
    a.out = (float*)d_out; a.ws = (unsigned char*)d_ws;
#if MK_SPLIT
    for (int ph = 0; ph < NPH; ++ph) { a.ph_lo = ph; a.ph_hi = ph + 1; hipLaunchKernelGGL(mk_fwd, dim3(grid), dim3(NWAVES * 64), LDS_BYTES, stream, a); }
#else
    a.ph_lo = 0; a.ph_hi = NPH; hipLaunchKernelGGL(mk_fwd, dim3(grid), dim3(NWAVES * 64), LDS_BYTES, stream, a);
#endif
}
```

```cpp
#include <hip/hip_runtime.h>
#include <cstdio>
#include <cstdint>

#ifndef MK_SPLIT
#define MK_SPLIT 0
#endif

#ifndef MOE_ALIGN
#define MOE_ALIGN true
#endif
#ifndef STAGGER_P1
#define STAGGER_P1 0
#endif
#ifndef STAGGER_MOE
#define STAGGER_MOE 0
#endif
#ifndef REP_MASK
#define REP_MASK 0u
#endif
#define REPS(k) ((((REP_MASK) >> (k)) & 1u) ? 2 : 1)

#define GAS __attribute__((address_space(1)))
#define LAS __attribute__((address_space(3)))
typedef unsigned short bf16;
typedef unsigned v4u __attribute__((ext_vector_type(4)));
typedef unsigned v2u __attribute__((ext_vector_type(2)));
typedef int v4i __attribute__((ext_vector_type(4)));
typedef float f32x2 __attribute__((ext_vector_type(2)));
typedef float f32x4 __attribute__((ext_vector_type(4)));
typedef float f32x16 __attribute__((ext_vector_type(16)));
typedef short bf16x8 __attribute__((ext_vector_type(8)));
typedef __bf16 bf16x2_t __attribute__((ext_vector_type(2)));
typedef GAS unsigned gu32;

constexpr int NB = 16, SEQ = 4096, M = NB * SEQ, D = 1024, NH = 8, HD = 64, PW = 512, AW = 512, NE = 32, TOPK = 4, DE = 1024, PLE = 256;
constexpr int NPROJ_A = 3584;
constexpr float EPS = 1e-6f;
constexpr float LOG2E = 1.4426950408889634f;
constexpr float QSCALE = 0.125f * LOG2E;
constexpr float WSCALE = 64.0f, WSCALE_INV = 1.0f / 64.0f;
constexpr int NWAVES = 8;
constexpr int NPH = 20;

constexpr size_t MiB = 1u << 20;
constexpr size_t WS_CTL = 0, CTL_ZERO_BYTES = 1 * MiB;
constexpr size_t WS_R2 = 1 * MiB;
constexpr size_t WS_R3 = WS_R2 + 256 * 1024;
constexpr size_t WS_TKE = 2 * MiB;
constexpr size_t WS_TKW = 3 * MiB;
constexpr size_t WS_TKR = 4 * MiB;
constexpr size_t WS_TKS = 13 * MiB;
constexpr size_t WS_SSQP = 224 * MiB;
constexpr size_t WS_ROWT = 5 * MiB;
constexpr size_t WS_CNTWG = 11 * MiB;
constexpr size_t WS_SEGTOT = WS_CNTWG + 256 * 1024;
constexpr size_t WS_WRF = 12 * MiB;
constexpr size_t WS_WG8 = 14 * MiB;
constexpr size_t WS_WIN = 16 * MiB;
constexpr size_t WS_WEFF = 24 * MiB;
constexpr size_t WS_WAU = 25 * MiB;
constexpr size_t WS_WOUT = 26 * MiB;
constexpr size_t WS_WPG = 28 * MiB;
constexpr size_t WS_WPP = 30 * MiB;
constexpr size_t WS_WGU = 32 * MiB;
constexpr size_t WS_WDN = 96 * MiB;
constexpr size_t WS_H2F8 = 128 * MiB;
constexpr size_t WS_A = 224 * MiB;
constexpr size_t WS_B = 352 * MiB;
constexpr size_t WS_C = 480 * MiB;
constexpr size_t WS_E = 608 * MiB;
constexpr size_t WS_PB = 192 * MiB;
constexpr size_t WS_ACT = 736 * MiB;
constexpr size_t WS_G = 768 * MiB;
constexpr size_t WS_END = 1024 * MiB;
constexpr int CW_BAR = 4096;
constexpr size_t WS_CUR = 512 * 1024;
constexpr size_t WS_ROWREL = 608 * MiB;

constexpr int RING_BYTES = 131072;
constexpr int LDSCTL_OFF = RING_BYTES, MISC_OFF = LDSCTL_OFF + 320;
constexpr int LDS_TAB_OFF = MISC_OFF + 128;
constexpr int LDS_BYTES = 147456;

#define RLX_AGENT __ATOMIC_RELAXED, __HIP_MEMORY_SCOPE_AGENT
#define LDS_WAIT() asm volatile("s_waitcnt lgkmcnt(0)" ::: "memory")
#define VM_WAIT() asm volatile("s_waitcnt vmcnt(0)" ::: "memory")

__device__ __forceinline__ int lane_id_v() { int l; asm volatile("v_mbcnt_lo_u32_b32 %0, -1, 0\n\tv_mbcnt_hi_u32_b32 %0, -1, %0" : "=v"(l)); return l; }
__device__ __forceinline__ unsigned f2bf(float f) { unsigned u = __builtin_bit_cast(unsigned, f); return (u + 0x7fffu + ((u >> 16) & 1u)) >> 16; }
__device__ __forceinline__ unsigned pk2(float lo, float hi) { f32x2 v = {lo, hi}; bf16x2_t b = __builtin_convertvector(v, bf16x2_t); return __builtin_bit_cast(unsigned, b); }
__device__ __forceinline__ void swap16(unsigned& a, unsigned& b) { const auto r = __builtin_amdgcn_permlane16_swap(a, b, false, false); a = r[0]; b = r[1]; }
__device__ __forceinline__ unsigned pk4_fp8(float a, float b, float c, float d) { int r = __builtin_amdgcn_cvt_pk_fp8_f32(a, b, 0, false); r = __builtin_amdgcn_cvt_pk_fp8_f32(c, d, r, true); return (unsigned)r; }
__device__ __forceinline__ float bflo(unsigned u) { return __builtin_bit_cast(float, u << 16); }
__device__ __forceinline__ float bfhi(unsigned u) { return __builtin_bit_cast(float, u & 0xffff0000u); }
__device__ __forceinline__ float fast_sigmoid(float v) { return __builtin_amdgcn_rcpf(1.0f + __builtin_amdgcn_exp2f(-LOG2E * v)); }
__device__ __forceinline__ float wave_sum(float v) {
#pragma unroll
    for (int o = 1; o < 64; o <<= 1) v += __shfl_xor(v, o);
    return v;
}

#define XB_TMO      128
#define XB_XCNT(j)  (256  + 64 * (j))
#define XB_XSUB(j)  (1280 + 64 * (j))
#define XB_XGEN(j)  (2304 + 64 * (j))
#define XB_TOP      3328
#define XB_TOPGEN   3392
#define XCD_BAR_WORDS 3456
#define XB_SPIN_CAP (1u << 18)
__device__ __forceinline__ unsigned xb_ld(unsigned* p)              { return __hip_atomic_load(p, __ATOMIC_RELAXED, __HIP_MEMORY_SCOPE_AGENT); }
__device__ __forceinline__ unsigned xb_add(unsigned* p, unsigned v) { return __hip_atomic_fetch_add(p, v, __ATOMIC_RELAXED, __HIP_MEMORY_SCOPE_AGENT); }
__device__ __forceinline__ unsigned xb_xcc_id() { return (unsigned)__builtin_amdgcn_s_getreg((3 << 11) | 20) & 0xFu; }
#define XB_SPIN(cond, bar) do { unsigned _sp = 0; while (cond) { __builtin_amdgcn_s_sleep(1); \
    if ((++_sp & 255u) == 0u) { if (xb_ld(&(bar)[XB_TMO])) break; if (_sp > XB_SPIN_CAP) { atomicAdd(&(bar)[XB_TMO], 1u); break; } } } } while (0)
struct XcdBarrier { unsigned* bar; unsigned x; volatile LAS unsigned* st; };
__device__ __forceinline__ XcdBarrier xcd_barrier_post(unsigned* bar, volatile LAS unsigned* st, int wave) {
    XcdBarrier b; b.bar = bar; b.x = xb_xcc_id(); b.st = st;
    if (wave == 0 && lane_id_v() == 0) (void)xb_add(&bar[XB_XCNT(b.x)], 1u);
    return b;
}
__device__ __forceinline__ void xcd_barrier_complete(unsigned* bar, unsigned x, unsigned& nloc, unsigned& nx) {
    const unsigned G = gridDim.x * gridDim.y * gridDim.z;
    unsigned sum, cnt, mine, sp = 0u;
    for (;;) {
        sum = 0u; cnt = 0u; mine = 0u;
#pragma unroll
        for (unsigned j = 0; j < 16; ++j) { const unsigned c = xb_ld(&bar[XB_XCNT(j)]); sum += c; cnt += (c > 0u) ? 1u : 0u; mine = (j == x) ? c : mine; }
        if (sum == G) break;
        __builtin_amdgcn_s_sleep(1);
        if ((++sp & 255u) == 0u) { if (xb_ld(&bar[XB_TMO])) break; if (sp > XB_SPIN_CAP) { atomicAdd(&bar[XB_TMO], 1u); break; } }
    }
    nloc = mine > 0u ? mine : 1u; nx = cnt > 0u ? cnt : 1u;
}
__device__ __forceinline__ void xcd_barrier(const XcdBarrier& b, int wave) {
    asm volatile("s_waitcnt vmcnt(0)" ::: "memory");
    __syncthreads();
    if (wave == 0 && lane_id_v() == 0) {
        unsigned* bar = b.bar;
        __builtin_amdgcn_s_waitcnt(0);
        unsigned nloc = b.st[0], nx = b.st[1];
        if (nloc == 0u) { xcd_barrier_complete(bar, b.x, nloc, nx); b.st[0] = nloc; b.st[1] = nx; }
        const unsigned old = xb_add(&bar[XB_XSUB(b.x)], 1u);
        const unsigned gen = old / nloc;
        if (old + 1u == (gen + 1u) * nloc) {
            __builtin_amdgcn_fence(__ATOMIC_RELEASE, "agent");
            asm volatile("s_waitcnt vmcnt(0)" ::: "memory");
            const unsigned og = xb_add(&bar[XB_TOP], 1u);
            const unsigned tg = og / nx;
            if (og + 1u == (tg + 1u) * nx) xb_add(&bar[XB_TOPGEN], 1u);
            else XB_SPIN(xb_ld(&bar[XB_TOPGEN]) == tg, bar);
            __builtin_amdgcn_fence(__ATOMIC_ACQUIRE, "agent");
            xb_add(&bar[XB_XGEN(b.x)], 1u);
            asm volatile("s_waitcnt vmcnt(0)" ::: "memory");
        } else {
            XB_SPIN(xb_ld(&bar[XB_XGEN(b.x)]) == gen, bar);
            __builtin_amdgcn_fence(__ATOMIC_ACQUIRE, "agent");
            asm volatile("s_waitcnt vmcnt(0)" ::: "memory");
        }
    }
    __syncthreads();
}

namespace pg8 {
constexpr int BM = 256, BK = 64, HALF = 128, HTB = HALF * BK * 2, NXCD = 8, WGM = 8;
__host__ __device__ __forceinline__ int lds_byte(int r, int c) { const int st = (r >> 4) * 2 + (c >> 5), rr = r & 15, cc = c & 31, ob = rr * 64 + cc * 2; return st * 1024 + (ob ^ (((ob >> 9) & 1) << 5)); }
__host__ __device__ __forceinline__ void stage_rc(int b, int& R, int& C) { const int st = b / 1024, sb = b % 1024, swz = sb ^ (((sb >> 9) & 1) << 5); R = (st >> 1) * 16 + swz / 64; C = (st & 1) * 32 + (swz % 64) / 2; }
__host__ __device__ __forceinline__ int perm32(int rho) { const int n = rho >> 4, i = rho & 15; return 8 * (i >> 2) + 4 * n + (i & 3); }

typedef int v8i __attribute__((ext_vector_type(8)));
typedef int v4i_ __attribute__((ext_vector_type(4)));
__device__ __forceinline__ v8i cat8(const bf16x8 a, const bf16x8 b) { const v4i_ x = __builtin_bit_cast(v4i_, a), y = __builtin_bit_cast(v4i_, b); return __builtin_shufflevector(x, y, 0, 1, 2, 3, 4, 5, 6, 7); }
struct Unit { int pm, pn, e, row0, nvalid, k; };
struct Gemm { const void* A; const void* Bt; int K; };

struct StaticOrder {
    int nM, nN, nwg, G, c;
    __device__ void init(int Mr, int N, int G_, int c_) { nM = Mr / BM; nN = N / BM; nwg = nM * nN; G = G_; c = c_; }
    __device__ __forceinline__ bool next(int i, Unit& u) const {
        const long L = (long)i * G + c; if (L >= nwg) return false;
        int wgid = (int)L; { const int q = nwg / NXCD, r = nwg % NXCD, xcd = wgid % NXCD, off = wgid / NXCD; wgid = (xcd < r ? xcd * (q + 1) : r * (q + 1) + (xcd - r) * q) + off; }
        const int nig = WGM * nN, gid = wgid / nig, fm = gid * WGM, gsz = (nM - fm) < WGM ? (nM - fm) : WGM;
        u.pm = fm + ((wgid % nig) % gsz); u.pn = (wgid % nig) / gsz; u.e = 0; u.row0 = u.pm * BM; u.nvalid = BM; u.k = 0; return true;
    }
    __device__ __forceinline__ void a_off(const Unit& u, int tid, int pitchB, unsigned (&va)[2][2]) const {
#pragma unroll
        for (int i = 0; i < 2; ++i) { int R, C; stage_rc(tid * 16 + i * 8192, R, C);
#pragma unroll
            for (int h = 0; h < 2; ++h) va[h][i] = (unsigned)((u.pm * BM + h * HALF + R) * pitchB + C * 2); }
    }
    __device__ __forceinline__ const char* b_ptr(const Unit& u, const Gemm& g, int pitchB) const { return (const char*)g.Bt + (size_t)u.pn * BM * pitchB; }
    __device__ __forceinline__ unsigned a_kofs(int kt) const { return (unsigned)kt * 128u; }
    __device__ __forceinline__ bool keep_acc(const Unit&) const { return false; }
};
struct DualOrder {
    StaticOrder so; int Mr, N;
    __device__ void init(int Mr_, int N_, int G_, int c_) { so.init(Mr_, N_, G_, c_); Mr = Mr_; N = N_; }
    __device__ __forceinline__ bool next(int i, Unit& u) const { if (!so.next(i >> 1, u)) return false; u.k = i & 1; return true; }
    __device__ __forceinline__ void a_off(const Unit& u, int tid, int pitchB, unsigned (&va)[2][2]) const {
#pragma unroll
        for (int i = 0; i < 2; ++i) { int R, C; stage_rc(tid * 16 + i * 8192, R, C);
#pragma unroll
            for (int h = 0; h < 2; ++h) va[h][i] = (unsigned)((u.k * Mr + u.pm * BM + h * HALF + R) * pitchB + C * 2); }
    }
    __device__ __forceinline__ const char* b_ptr(const Unit& u, const Gemm& g, int pitchB) const { return (const char*)g.Bt + (size_t)(u.k * N + u.pn * BM) * pitchB; }
    __device__ __forceinline__ unsigned a_kofs(int kt) const { return (unsigned)kt * 128u; }
    __device__ __forceinline__ bool keep_acc(const Unit& u) const { return u.k == 0; }
};

template <class Epi, class Sched, bool ALIGN_EPI, int ES = 2>
__device__ __forceinline__ void gemm_phase(LAS unsigned char* lds, const Gemm g, const Sched& S, const Epi& E, const int wid, const int stagger = 0) {
    const int lane = lane_id_v(), tid = wid * 64 + lane, wr = wid >> 2, wc = wid & 3, fr = lane & 15, fq = lane >> 4;
    const int K = g.K, pitchB = K * ES; int nt = pitchB / 128;
    asm volatile("" : "+s"(nt));
    unsigned voffB[2];
#pragma unroll
    for (int i = 0; i < 2; ++i) { int R, C; stage_rc(tid * 16 + i * 8192, R, C); const int Rb = Epi::PERM ? ((R & ~31) + perm32(R & 31)) : R;
        voffB[i] = (unsigned)(Rb * pitchB + C * 2); }
    const size_t kstep = (size_t)(BK * 2);
    const size_t hstep = (size_t)HALF * pitchB;
    const unsigned ldsw = (unsigned)wid * 1024u;
    const int aoff = lds_byte(wr * 64 + fr, fq * 8), boff = lds_byte(wc * 32 + fr, fq * 8);
#define PG8_SA(b, h) (((b) * 2 + (h)) * HTB)
#define PG8_SB(b, h) ((4 + (b) * 2 + (h)) * HTB)
#define PG8_STAGE(bufoff, gbase, voff) do { _Pragma("unroll") for (int _i = 0; _i < 2; ++_i) \
        __builtin_amdgcn_global_load_lds((const unsigned*)((const char*)(gbase) + (voff)[_i]), (LAS unsigned*)(lds + (bufoff) + ldsw + _i * 8192), 16, 0, 0); } while (0)
#define PG8_LDA(dst, b, h) do { _Pragma("unroll") for (int m = 0; m < 4; ++m) _Pragma("unroll") for (int k = 0; k < 2; ++k) dst[m][k] = *(const LAS bf16x8*)(lds + PG8_SA(b, h) + aoff + m * 2048 + k * 1024); } while (0)
#define PG8_LDB(dst, b, h) do { _Pragma("unroll") for (int n = 0; n < 2; ++n) _Pragma("unroll") for (int k = 0; k < 2; ++k) dst[n][k] = *(const LAS bf16x8*)(lds + PG8_SB(b, h) + boff + n * 2048 + k * 1024); } while (0)
#define PG8_MMA(ai, bj, At, Bt) do { __builtin_amdgcn_s_setprio(1); _Pragma("unroll") for (int m = 0; m < 4; ++m) _Pragma("unroll") for (int n = 0; n < 2; ++n) { \
        if constexpr (ES == 2) { _Pragma("unroll") for (int k = 0; k < 2; ++k) acc[ai][bj][m][n] = __builtin_amdgcn_mfma_f32_16x16x32_bf16(Bt[n][k], At[m][k], acc[ai][bj][m][n], 0, 0, 0); } \
        else { const v8i a8_ = cat8(Bt[n][0], Bt[n][1]), b8_ = cat8(At[m][0], At[m][1]); \
               if (m == 0 && n == 0) asm volatile("s_nop 1\n\tv_mfma_f32_16x16x128_f8f6f4 %0, %1, %2, %0" : "+v"(acc[ai][bj][m][n]) : "v"(a8_), "v"(b8_)); \
               else asm volatile("v_mfma_f32_16x16x128_f8f6f4 %0, %1, %2, %0" : "+v"(acc[ai][bj][m][n]) : "v"(a8_), "v"(b8_)); } } \
        __builtin_amdgcn_s_setprio(0); } while (0)
#define PG8_WAIT_V(n) asm volatile("s_waitcnt vmcnt(" #n ")" ::: "memory")
#define PG8_WAIT_L(n) asm volatile("s_waitcnt lgkmcnt(" #n ")" ::: "memory")
#define PG8_BAR __builtin_amdgcn_s_barrier()
#define PG8_SCHED __builtin_amdgcn_sched_barrier(0)
    Unit cur, nxt; int ui = 0;
    if (!S.next(0, cur)) return;
    if (stagger > 0) {
        const unsigned long long t0_ = __builtin_amdgcn_s_memrealtime(), dl_ = (unsigned long long)((blockIdx.x >> 3) & 7u) * (unsigned)stagger;
        while (__builtin_amdgcn_s_memrealtime() - t0_ < dl_) __builtin_amdgcn_s_sleep(4); }
    f32x4 acc[2][2][4][2];
#pragma unroll
    for (int a = 0; a < 2; ++a)
#pragma unroll
        for (int b = 0; b < 2; ++b)
#pragma unroll
            for (int m = 0; m < 4; ++m)
#pragma unroll
                for (int n = 0; n < 2; ++n) acc[a][b][m][n] = (f32x4){0.f, 0.f, 0.f, 0.f};
    bf16x8 At[4][2], B0[2][2], B1[2][2];
    unsigned cva[2][2], nva[2][2];
    S.a_off(cur, tid, pitchB, cva);
    const char* const Ab = (const char*)g.A;
    const char* cB = S.b_ptr(cur, g, pitchB);
    PG8_STAGE(PG8_SB(0, 0), cB, voffB); PG8_STAGE(PG8_SB(0, 1), cB + hstep, voffB); PG8_STAGE(PG8_SA(0, 0), Ab, cva[0]); PG8_STAGE(PG8_SA(0, 1), Ab, cva[1]);
    if (wr == 1) PG8_BAR;
    PG8_WAIT_V(2); PG8_BAR;
    PG8_STAGE(PG8_SB(1, 0), cB + kstep, voffB); PG8_STAGE(PG8_SA(1, 0), Ab + S.a_kofs(1), cva[0]); PG8_STAGE(PG8_SB(1, 1), cB + hstep + kstep, voffB);
    PG8_WAIT_V(6); PG8_BAR;
    for (;;) {
        const bool has_next = S.next(ui + 1, nxt);
        const char* nB = cB;
        if (has_next) { S.a_off(nxt, tid, pitchB, nva); nB = S.b_ptr(nxt, g, pitchB); }
        else {
#pragma unroll
            for (int h = 0; h < 2; ++h)
#pragma unroll
                for (int i = 0; i < 2; ++i) nva[h][i] = cva[h][i];
        }
#pragma nounroll
        for (int t = 0; t < nt; t += 2) {
            const bool last = (t == nt - 2);
            const char* Abt = Ab; asm volatile("" : "+s"(Abt));
            const char* a1 = Abt + S.a_kofs(t + 1);
            const char* a2 = last ? Abt : Abt + S.a_kofs(t + 2); const char* b2 = last ? nB : cB + (size_t)(t + 2) * kstep;
            const char* a3 = last ? Abt + S.a_kofs(1) : Abt + S.a_kofs(t + 3); const char* b3 = b2 + kstep;
            unsigned va2[2][2];
#pragma unroll
            for (int h = 0; h < 2; ++h)
#pragma unroll
                for (int i = 0; i < 2; ++i) va2[h][i] = last ? nva[h][i] : cva[h][i];
            PG8_LDB(B0, 0, 0); PG8_LDB(B1, 0, 1); PG8_SCHED; PG8_LDA(At, 0, 0); PG8_STAGE(PG8_SA(1, 1), a1, cva[1]);
            PG8_WAIT_V(8); PG8_WAIT_L(0); PG8_BAR; PG8_MMA(0, 0, At, B0); PG8_MMA(0, 1, At, B1); PG8_BAR; PG8_SCHED;
            PG8_LDA(At, 0, 1); PG8_STAGE(PG8_SB(0, 0), b2, voffB); PG8_STAGE(PG8_SB(0, 1), b2 + hstep, voffB); PG8_STAGE(PG8_SA(0, 0), a2, va2[0]);
            PG8_WAIT_V(8); PG8_WAIT_L(0); PG8_BAR; PG8_MMA(1, 0, At, B0); PG8_MMA(1, 1, At, B1); PG8_BAR; PG8_SCHED;
            PG8_LDB(B0, 1, 0); PG8_LDB(B1, 1, 1); PG8_SCHED; PG8_LDA(At, 1, 0); PG8_STAGE(PG8_SA(0, 1), a2, va2[1]);
            PG8_WAIT_V(8); PG8_WAIT_L(0); PG8_BAR; PG8_MMA(0, 0, At, B0); PG8_MMA(0, 1, At, B1); PG8_BAR; PG8_SCHED;
            PG8_LDA(At, 1, 1); PG8_STAGE(PG8_SB(1, 0), b3, voffB); PG8_STAGE(PG8_SB(1, 1), b3 + hstep, voffB); PG8_STAGE(PG8_SA(1, 0), a3, va2[0]);
            PG8_WAIT_V(8); PG8_WAIT_L(0); PG8_BAR; PG8_MMA(1, 0, At, B0); PG8_MMA(1, 1, At, B1); PG8_BAR; PG8_SCHED;
        }
        if constexpr (ALIGN_EPI) { if (wr == 0) PG8_BAR; }
        if constexpr (ES == 1) asm volatile("s_nop 11");
        E(acc, cur, wr, wc, fr, fq);
        if (!has_next) break;
        if (!S.keep_acc(cur)) {
#pragma unroll
        for (int a = 0; a < 2; ++a)
#pragma unroll
            for (int b = 0; b < 2; ++b)
#pragma unroll
                for (int m = 0; m < 4; ++m)
#pragma unroll
                    for (int n = 0; n < 2; ++n) acc[a][b][m][n] = (f32x4){0.f, 0.f, 0.f, 0.f};
        }
        cur = nxt; cB = nB; ++ui;
#pragma unroll
        for (int h = 0; h < 2; ++h)
#pragma unroll
            for (int i = 0; i < 2; ++i) cva[h][i] = nva[h][i];
        if constexpr (ALIGN_EPI) { if (wr == 1) PG8_BAR; }
    }
    PG8_WAIT_V(0);
    if constexpr (!ALIGN_EPI) { if (wr == 0) PG8_BAR; }
    PG8_BAR;
#undef PG8_SA
#undef PG8_SB
#undef PG8_STAGE
#undef PG8_LDA
#undef PG8_LDB
#undef PG8_MMA
#undef PG8_WAIT_V
#undef PG8_WAIT_L
#undef PG8_BAR
#undef PG8_SCHED
}

__device__ __forceinline__ f32x4 one_plus_expneg4(const f32x4 v) { const f32x4 a = v * (-LOG2E); f32x4 e;
#pragma unroll
    for (int j = 0; j < 4; ++j) e[j] = __builtin_amdgcn_exp2f(a[j]);
    return e + 1.0f; }
__device__ __forceinline__ f32x4 sigmoid4(const f32x4 v) { const f32x4 d = one_plus_expneg4(v); f32x4 r;
#pragma unroll
    for (int j = 0; j < 4; ++j) r[j] = __builtin_amdgcn_rcpf(d[j]);
    return r; }
__device__ __forceinline__ v4u pack8(const f32x4 a, const f32x4 b) { v4u w; w.x = pk2(a[0], a[1]); w.y = pk2(a[2], a[3]); w.z = pk2(b[0], b[1]); w.w = pk2(b[2], b[3]); return w; }
__device__ __forceinline__ void unpack8(const v4u w, f32x4& a, f32x4& b) { a = (f32x4){bflo(w.x), bfhi(w.x), bflo(w.y), bfhi(w.y)}; b = (f32x4){bflo(w.z), bfhi(w.z), bflo(w.w), bfhi(w.w)}; }

__device__ __forceinline__ size_t nat_off(int unit_id, int wr, int wc, int fr, int fq, int ai, int m, int bj) { return ((size_t)((unit_id * 8 + wr * 4 + wc) * 16 + (ai * 8 + m * 2 + bj))) * 512 + (fq * 16 + fr) * 8; }
__device__ __forceinline__ void st16_nt(bf16* p, const v4u v) { asm volatile("global_store_dwordx4 %0, %1, off sc0 sc1 nt\n\ts_nop 1" :: "v"(p), "v"(v) : "memory"); }
struct EpiNative {
    static constexpr bool PERM = true;
    bf16* O; int nN;
    __device__ __forceinline__ void operator()(const f32x4 (&acc)[2][2][4][2], const Unit& u, int wr, int wc, int fr, int fq) const {
        const int uid = u.pm * nN + u.pn;
#pragma unroll
        for (int ai = 0; ai < 2; ++ai)
#pragma unroll
            for (int m = 0; m < 4; ++m)
#pragma unroll
                for (int bj = 0; bj < 2; ++bj) st16_nt(O + nat_off(uid, wr, wc, fr, fq, ai, m, bj), pack8(acc[ai][bj][m][0], acc[ai][bj][m][1]));
    }
};
struct EpiPlain {
    static constexpr bool PERM = true;
    bf16* O; int ldc;
    __device__ __forceinline__ void operator()(const f32x4 (&acc)[2][2][4][2], const Unit& u, int wr, int wc, int fr, int fq) const {
        const int row0 = u.pm * BM + wr * 64 + fr, col0 = u.pn * BM + wc * 32 + 8 * fq;
#pragma unroll
        for (int ai = 0; ai < 2; ++ai)
#pragma unroll
            for (int m = 0; m < 4; ++m) { bf16* rowp = O + (size_t)(row0 + ai * HALF + m * 16) * ldc + col0;
#pragma unroll
                for (int bj = 0; bj < 2; ++bj) *(GAS v4u*)(rowp + bj * HALF) = pack8(acc[ai][bj][m][0], acc[ai][bj][m][1]); }
    }
};
struct EpiProj {
    static constexpr bool PERM = true;
    bf16 *U, *Q, *Kb;
    __device__ __forceinline__ void operator()(const f32x4 (&acc)[2][2][4][2], const Unit& u, int wr, int wc, int fr, int fq) const {
        const int pn = u.pn;
        if (pn >= 2) {
            bf16* base = pn < 4 ? Q : Kb; const int uid = u.pm * 2 + (pn & 1); const float sc = pn < 4 ? QSCALE : 1.f;
#pragma unroll
            for (int ai = 0; ai < 2; ++ai)
#pragma unroll
                for (int m = 0; m < 4; ++m)
#pragma unroll
                    for (int bj = 0; bj < 2; ++bj) st16_nt(base + nat_off(uid, wr, wc, fr, fq, ai, m, bj), pack8(acc[ai][bj][m][0] * sc, acc[ai][bj][m][1] * sc));
            return;
        }
        const int row0 = u.pm * BM + wr * 64 + fr, col0 = pn * 256 + wc * 32 + 8 * fq;
#pragma unroll
        for (int ai = 0; ai < 2; ++ai)
#pragma unroll
            for (int m = 0; m < 4; ++m) { bf16* rowp = U + (size_t)(row0 + ai * HALF + m * 16) * 512 + col0;
#pragma unroll
                for (int bj = 0; bj < 2; ++bj) *(GAS v4u*)(rowp + bj * HALF) = pack8(acc[ai][bj][m][0], acc[ai][bj][m][1]); }
    }
};
struct EpiGate8 {
    static constexpr bool PERM = true;
    bf16 *GP, *GA;
    __device__ __forceinline__ void operator()(const f32x4 (&acc)[2][2][4][2], const Unit& u, int wr, int wc, int fr, int fq) const {
        bf16* base = u.pn < 4 ? GP : GA; const int uid = u.pm * 4 + (u.pn & 3);
#pragma unroll
        for (int ai = 0; ai < 2; ++ai)
#pragma unroll
            for (int m = 0; m < 4; ++m)
#pragma unroll
                for (int bj = 0; bj < 2; ++bj) st16_nt(base + nat_off(uid, wr, wc, fr, fq, ai, m, bj), pack8(acc[ai][bj][m][0] * WSCALE_INV, acc[ai][bj][m][1] * WSCALE_INV));
    }
};
struct EpiDual {
    static constexpr bool PERM = true;
    bf16* O; const bf16* GP; const bf16* GA;
    __device__ __forceinline__ void operator()(f32x4 (&acc)[2][2][4][2], const Unit& u, int wr, int wc, int fr, int fq) const {
        const int uid = u.pm * 4 + u.pn; const int row0 = u.pm * BM + wr * 64 + fr, col0 = u.pn * BM + wc * 32 + 8 * fq;
        if (u.k == 0) {
#pragma unroll
            for (int ai = 0; ai < 2; ++ai)
#pragma unroll
                for (int m = 0; m < 4; ++m)
#pragma unroll
                    for (int bj = 0; bj < 2; ++bj) { const size_t no = nat_off(uid, wr, wc, fr, fq, ai, m, bj);
                        f32x4 b0, b1, a0, a1; unpack8(*(const GAS v4u*)(GA + no), b0, b1); unpack8(*(const GAS v4u*)(GP + no), a0, a1);
                        const f32x4 lim = {-80.f, -80.f, -80.f, -80.f};
                        acc[ai][bj][m][0] = acc[ai][bj][m][0] * (one_plus_expneg4(__builtin_elementwise_max(b0, lim)) * sigmoid4(a0));
                        acc[ai][bj][m][1] = acc[ai][bj][m][1] * (one_plus_expneg4(__builtin_elementwise_max(b1, lim)) * sigmoid4(a1)); }
        } else {
#pragma unroll
            for (int ai = 0; ai < 2; ++ai) {
                v4u gv[4][2];
#pragma unroll
                for (int m = 0; m < 4; ++m)
#pragma unroll
                    for (int bj = 0; bj < 2; ++bj) gv[m][bj] = *(const GAS v4u*)(GA + nat_off(uid, wr, wc, fr, fq, ai, m, bj));
#pragma unroll
                for (int m = 0; m < 4; ++m)
#pragma unroll
                    for (int bj = 0; bj < 2; ++bj) { f32x4 b0, b1; unpack8(gv[m][bj], b0, b1); const f32x4 lim = {-80.f, -80.f, -80.f, -80.f};
                        const f32x4 v0 = acc[ai][bj][m][0] * sigmoid4(__builtin_elementwise_max(b0, lim)), v1 = acc[ai][bj][m][1] * sigmoid4(__builtin_elementwise_max(b1, lim));
                        *(GAS v4u*)(O + (size_t)(row0 + ai * HALF + m * 16) * 1024 + col0 + bj * HALF) = pack8(v0, v1); }
            }
        }
    }
};
struct EpiResid {
    static constexpr bool PERM = true;
    bf16* O; const bf16* X; float* SSQP;
    __device__ __forceinline__ void operator()(const f32x4 (&acc)[2][2][4][2], const Unit& u, int wr, int wc, int fr, int fq) const {
        const int row0 = u.pm * BM + wr * 64 + fr, col0 = u.pn * BM + wc * 32 + 8 * fq;
#pragma unroll
        for (int ai = 0; ai < 2; ++ai) {
            v4u xv[4][2];
#pragma unroll
            for (int m = 0; m < 4; ++m)
#pragma unroll
                for (int bj = 0; bj < 2; ++bj) xv[m][bj] = *(const GAS v4u*)(X + (size_t)(row0 + ai * HALF + m * 16) * 1024 + col0 + bj * HALF);
#pragma unroll
            for (int m = 0; m < 4; ++m) { float s = 0.f;
#pragma unroll
                for (int bj = 0; bj < 2; ++bj) { f32x4 x0, x1; unpack8(xv[m][bj], x0, x1);
                    const v4u o = pack8(acc[ai][bj][m][0] + x0, acc[ai][bj][m][1] + x1); f32x4 y0, y1; unpack8(o, y0, y1);
                    s += (y0[0] * y0[0] + y0[1] * y0[1]) + (y0[2] * y0[2] + y0[3] * y0[3]) + (y1[0] * y1[0] + y1[1] * y1[1]) + (y1[2] * y1[2] + y1[3] * y1[3]);
                    *(GAS v4u*)(O + (size_t)(row0 + ai * HALF + m * 16) * 1024 + col0 + bj * HALF) = o; }
                s += __shfl_xor(s, 16); s += __shfl_xor(s, 32);
                if (fq == 0) SSQP[(size_t)(row0 + ai * HALF + m * 16) * 16 + u.pn * 4 + wc] = s; }
        }
    }
};
struct EpiPle {
    static constexpr bool PERM = true;
    bf16* O; const bf16* X2; const bf16* PP; const float* R3;
    __device__ __forceinline__ void operator()(const f32x4 (&acc)[2][2][4][2], const Unit& u, int wr, int wc, int fr, int fq) const {
        const int row0 = u.pm * BM + wr * 64 + fr, col0 = u.pn * BM + wc * 32 + 8 * fq; const int uid = u.pm * 4 + u.pn;
#pragma unroll
        for (int ai = 0; ai < 2; ++ai) {
            v4u pv[4][2]; float rr[4];
#pragma unroll
            for (int m = 0; m < 4; ++m) { const int row = row0 + ai * HALF + m * 16; rr[m] = R3[row] * WSCALE_INV;
#pragma unroll
                for (int bj = 0; bj < 2; ++bj) pv[m][bj] = *(const GAS v4u*)(PP + nat_off(uid, wr, wc, fr, fq, ai, m, bj)); }
#pragma unroll
            for (int m = 0; m < 4; ++m) { const int row = row0 + ai * HALF + m * 16; const float r = rr[m];
#pragma unroll
                for (int bj = 0; bj < 2; ++bj) { f32x4 p0, p1; unpack8(pv[m][bj], p0, p1);
                    const f32x4 v0 = sigmoid4(acc[ai][bj][m][0] * r) * p0, v1 = sigmoid4(acc[ai][bj][m][1] * r) * p1;
                    *(GAS v4u*)(O + (size_t)row * 1024 + col0 + bj * HALF) = pack8(v0, v1); } }
        }
    }
};

template <bool GATHER> struct MoeOrder {
    const LAS int* tab; const int* row_token; const unsigned char* W; int NT, G, c, total; size_t wstride;
    __device__ __forceinline__ int kstepA() const { return 128; }
    __device__ __forceinline__ bool next(int i, Unit& u) const {
        const int per = G >> 3, x = c / per, j = c - x * per;
        long L;
        if (per > 0 && (G & 7) == 0) { const int chunk = ((total + 7) >> 3); const int off = i * per + j; if (off >= chunk) return false; L = (long)x * chunk + off; }
        else L = (long)i * G + c;
        if (L >= total) return false;
        const int rt = (int)(L / NT); u.pn = (int)(L % NT);
        int lo = 0, hi = 32;
#pragma unroll
        for (int it = 0; it < 5; ++it) { const int mid = (lo + hi) >> 1; const int v = __builtin_amdgcn_readfirstlane(tab[mid]); if (v <= rt) lo = mid; else hi = mid; }
        const int lt = rt - __builtin_amdgcn_readfirstlane(tab[lo]), cn = __builtin_amdgcn_readfirstlane(tab[65 + lo]);
        u.e = lo; u.k = lt * 256; u.pm = rt; u.row0 = __builtin_amdgcn_readfirstlane(tab[33 + lo]) + lt * 256; u.nvalid = (cn - lt * 256) < 256 ? (cn - lt * 256) : 256; return true;
    }
    __device__ __forceinline__ void a_off(const Unit& u, int tid, int pitchB, unsigned (&va)[2][2]) const {
        int R[2], C[2];
#pragma unroll
        for (int i = 0; i < 2; ++i) stage_rc(tid * 16 + i * 8192, R[i], C[i]);
        if constexpr (GATHER) {
            int tok[2][2];
            const int c0 = __builtin_amdgcn_readfirstlane(tab[98 + u.e]), c1 = c0 + __builtin_amdgcn_readfirstlane(tab[130 + u.e]), c2 = c1 + __builtin_amdgcn_readfirstlane(tab[162 + u.e]);
#pragma unroll
            for (int i = 0; i < 2; ++i)
#pragma unroll
                for (int h = 0; h < 2; ++h) { const int rl = h * HALF + R[i]; const int r = u.k + (rl < u.nvalid ? rl : 0);
                    const int k = (r >= c0) + (r >= c1) + (r >= c2); const int idx = r - (k == 0 ? 0 : (k == 1 ? c0 : (k == 2 ? c1 : c2)));
                    tok[h][i] = row_token[(size_t)(k * 32 + u.e) * 65536 + idx]; }
#pragma unroll
            for (int i = 0; i < 2; ++i)
#pragma unroll
                for (int h = 0; h < 2; ++h) va[h][i] = (unsigned)(tok[h][i] * pitchB + C[i] * 2);
        } else {
#pragma unroll
            for (int i = 0; i < 2; ++i)
#pragma unroll
                for (int h = 0; h < 2; ++h) va[h][i] = (unsigned)(u.pm * 8 * 32768 + (h * HALF + R[i]) * 128 + C[i] * 2);
        }
    }
    __device__ __forceinline__ const char* b_ptr(const Unit& u, const Gemm& g, int pitchB) const { return (const char*)(W + (size_t)u.e * wstride + (size_t)u.pn * 256 * pitchB); }
    __device__ __forceinline__ unsigned a_kofs(int kt) const { return GATHER ? (unsigned)kt * 128u : (unsigned)kt * 32768u; }
    __device__ __forceinline__ bool keep_acc(const Unit&) const { return false; }
};
__device__ __forceinline__ void swiglu4(const f32x4 ag, const f32x4 au, const f32x4 bg, const f32x4 bu, f32x4& o) {
#pragma unroll
    for (int h = 0; h < 2; ++h) {
        f32x2 g = (f32x2){ag[2 * h], ag[2 * h + 1]} * WSCALE_INV + (f32x2){bg[2 * h], bg[2 * h + 1]};
        f32x2 up = (f32x2){au[2 * h], au[2 * h + 1]} * WSCALE_INV + (f32x2){bu[2 * h], bu[2 * h + 1]};
        g = __builtin_elementwise_min(g, (f32x2){7.0f, 7.0f});
        up = __builtin_elementwise_min(__builtin_elementwise_max(up, (f32x2){-7.0f, -7.0f}), (f32x2){7.0f, 7.0f});
        const f32x2 a = g * (-1.702f * LOG2E);
        f32x2 e; e.x = __builtin_amdgcn_exp2f(a.x); e.y = __builtin_amdgcn_exp2f(a.y);
        const f32x2 d = e + 1.0f;
        f32x2 rc; rc.x = __builtin_amdgcn_rcpf(d.x); rc.y = __builtin_amdgcn_rcpf(d.y);
        const f32x2 r = (up + 1.0f) * (g * rc);
        o[2 * h] = r.x; o[2 * h + 1] = r.y;
    }
}
struct EpiMoe1 {
    static constexpr bool PERM = true;
    unsigned char* act; const float* bgu;
    __device__ __forceinline__ void operator()(const f32x4 (&acc)[2][2][4][2], const Unit& u, int wr, int wc, int fr, int fq) const {
        const int cl = u.pn * 128 + wc * 32 + 8 * fq;
        const float* bg = bgu + (size_t)u.e * 2048 + cl;
        const f32x4 g0b = *(const GAS f32x4*)(bg), g1b = *(const GAS f32x4*)(bg + 4), u0b = *(const GAS f32x4*)(bg + 1024), u1b = *(const GAS f32x4*)(bg + 1028);
#pragma unroll
        for (int ai = 0; ai < 2; ++ai)
#pragma unroll
            for (int mp = 0; mp < 4; mp += 2) { v2u o8[2];
#pragma unroll
                for (int q = 0; q < 2; ++q) { const int m = mp + q; f32x4 o0, o1;
                    swiglu4(acc[ai][0][m][0], acc[ai][1][m][0], g0b, u0b, o0); swiglu4(acc[ai][0][m][1], acc[ai][1][m][1], g1b, u1b, o1);
                    o8[q].x = pk4_fp8(o0[0], o0[1], o0[2], o0[3]); o8[q].y = pk4_fp8(o1[0], o1[1], o1[2], o1[3]); }
                unsigned ax = o8[0].x, ay = o8[0].y, bx = o8[1].x, by = o8[1].y; swap16(ax, bx); swap16(ay, by);
                const int rl = ai * HALF + wr * 64 + (mp + (fq & 1)) * 16 + fr;
                v4u o; o.x = ax; o.y = ay; o.z = bx; o.w = by;
                *(GAS v4u*)(act + ((size_t)(u.pm * 8 + u.pn) * 256 + rl) * 128 + wc * 32 + 8 * (fq & 2)) = o; }
    }
};
struct EpiMoe2 {
    static constexpr bool PERM = true;
    unsigned char* Y; const float* bdn;
    __device__ __forceinline__ void operator()(const f32x4 (&acc)[2][2][4][2], const Unit& u, int wr, int wc, int fr, int fq) const {
        const int col0 = u.pn * 256 + wc * 32 + 8 * fq;
        const float* bd = bdn + (size_t)u.e * 1024 + col0;
        f32x4 bv[2][2];
#pragma unroll
        for (int bj = 0; bj < 2; ++bj) { bv[bj][0] = *(const GAS f32x4*)(bd + bj * HALF); bv[bj][1] = *(const GAS f32x4*)(bd + bj * HALF + 4); }
#pragma unroll
        for (int ai = 0; ai < 2; ++ai)
#pragma unroll
            for (int mp = 0; mp < 4; mp += 2) { v4u o[2];
#pragma unroll
                for (int bj = 0; bj < 2; ++bj) { v2u o8[2];
#pragma unroll
                    for (int q = 0; q < 2; ++q) { const int m = mp + q; const f32x4 y0 = acc[ai][bj][m][0] * WSCALE_INV + bv[bj][0], y1 = acc[ai][bj][m][1] * WSCALE_INV + bv[bj][1];
                        o8[q].x = pk4_fp8(y0[0], y0[1], y0[2], y0[3]); o8[q].y = pk4_fp8(y1[0], y1[1], y1[2], y1[3]); }
                    unsigned ax = o8[0].x, ay = o8[0].y, bx = o8[1].x, by = o8[1].y; swap16(ax, bx); swap16(ay, by);
                    o[bj].x = ax; o[bj].y = ay; o[bj].z = bx; o[bj].w = by; }
                const int rl = ai * HALF + wr * 64 + (mp + (fq & 1)) * 16 + fr;
                if (rl < u.nvalid) { unsigned char* rowp = Y + (size_t)(u.row0 + rl) * 1024 + u.pn * 256 + wc * 32 + 8 * (fq & 2);
                    *(GAS v4u*)(rowp) = o[0]; *(GAS v4u*)(rowp + HALF) = o[1]; } }
    }
};
}

struct Frame {
    LAS unsigned char* lds; volatile LAS unsigned* MISC; gu32* ctl;
    int wave, vcu, G;
};
struct Args { const float* in[20]; float* out; unsigned char* ws; int ph_lo, ph_hi; };

template <bool F8>
__device__ __forceinline__ void p0_transpose_item(const float* W, int N, int k0, int n0, void* WT, int Kp, int dst_row0, const float* gain, float scale, LAS float* scr, int lane) {
    f32x4 v[8]; float gs[8];
    const int kq = lane >> 3, n4 = 4 * (lane & 7);
#pragma unroll
    for (int i = 0; i < 8; ++i) v[i] = *(const GAS f32x4*)(W + (size_t)(k0 + kq + 8 * i) * N + n0 + n4);
#pragma unroll
    for (int i = 0; i < 8; ++i) gs[i] = gain ? gain[k0 + kq + 8 * i] * scale : scale;
#pragma unroll
    for (int i = 0; i < 8; ++i) { LAS float* s = scr + (kq + 8 * i) * 33 + n4; s[0] = v[i].x * gs[i]; s[1] = v[i].y * gs[i]; s[2] = v[i].z * gs[i]; s[3] = v[i].w * gs[i]; }
    LDS_WAIT(); asm volatile("" ::: "memory");
    if constexpr (!F8) {
        const int c = lane & 7;
#pragma unroll
        for (int j = 0; j < 4; ++j) { const int n = (lane >> 3) + 8 * j; const LAS float* s = scr + (8 * c) * 33 + n;
            v4u o; o.x = pk2(s[0 * 33], s[1 * 33]); o.y = pk2(s[2 * 33], s[3 * 33]); o.z = pk2(s[4 * 33], s[5 * 33]); o.w = pk2(s[6 * 33], s[7 * 33]);
            *(GAS v4u*)((bf16*)WT + (size_t)(dst_row0 + n) * Kp + k0 + 8 * c) = o; }
    } else {
        const int c = lane & 3;
#pragma unroll
        for (int j = 0; j < 2; ++j) { const int n = (lane >> 2) + 16 * j; const LAS float* s = scr + (16 * c) * 33 + n;
            v4u o; o.x = pk4_fp8(s[0 * 33], s[1 * 33], s[2 * 33], s[3 * 33]); o.y = pk4_fp8(s[4 * 33], s[5 * 33], s[6 * 33], s[7 * 33]);
            o.z = pk4_fp8(s[8 * 33], s[9 * 33], s[10 * 33], s[11 * 33]); o.w = pk4_fp8(s[12 * 33], s[13 * 33], s[14 * 33], s[15 * 33]);
            *(GAS v4u*)((unsigned char*)WT + (size_t)(dst_row0 + n) * Kp + k0 + 16 * c) = o; }
    }
    LDS_WAIT(); asm volatile("" ::: "memory");
}
__device__ __forceinline__ void rms_row_f32_to_bf16(const float* xrow, const float* g, bf16* orow, bf16* xbrow, unsigned char* o8row, int lane) {
    f32x4 v[2][2]; float s = 0.f;
#pragma unroll
    for (int j = 0; j < 2; ++j)
#pragma unroll
        for (int q = 0; q < 2; ++q) { v[j][q] = *(const GAS f32x4*)(xrow + 512 * j + 8 * lane + 4 * q); s += (v[j][q].x * v[j][q].x + v[j][q].y * v[j][q].y) + (v[j][q].z * v[j][q].z + v[j][q].w * v[j][q].w); }
    const float r = 1.0f / sqrtf(wave_sum(s) * (1.f / D) + EPS);
#pragma unroll
    for (int j = 0; j < 2; ++j) { const int c0 = 512 * j + 8 * lane;
        const f32x4 g0 = *(const GAS f32x4*)(g + c0), g1 = *(const GAS f32x4*)(g + c0 + 4);
        const f32x4 h0 = {v[j][0].x * r * g0.x, v[j][0].y * r * g0.y, v[j][0].z * r * g0.z, v[j][0].w * r * g0.w}, h1 = {v[j][1].x * r * g1.x, v[j][1].y * r * g1.y, v[j][1].z * r * g1.z, v[j][1].w * r * g1.w};
        *(GAS v4u*)(orow + c0) = pg8::pack8(h0, h1);
        *(GAS v4u*)(xbrow + c0) = pg8::pack8(v[j][0], v[j][1]);
        v2u o8; o8.x = pk4_fp8(h0[0], h0[1], h0[2], h0[3]); o8.y = pk4_fp8(h1[0], h1[1], h1[2], h1[3]);
        *(GAS v2u*)(o8row + c0) = o8; }
}

#define MFMA32(a, b, c) __builtin_amdgcn_mfma_f32_32x32x16_bf16((a), (b), (c), 0, 0, 0)
__device__ __forceinline__ bf16x8 ldg16(const bf16* p) { return *(const GAS bf16x8*)p; }
struct KVFrag { bf16x8 k[4], v[4]; };
struct AttAddr { const bf16* K; const bf16* V; int tb, h; unsigned lk, lv; };
__device__ __forceinline__ void att_load(KVFrag& f, const AttAddr& A, int key0_) {
    const int key0 = key0_ < 0 ? 0 : key0_;
    const int r0 = A.tb + key0, h3 = A.h & 3;
#pragma unroll
    for (int kk = 0; kk < 4; ++kk) {
        const unsigned uoff = (unsigned)((((((r0 >> 8) * 2 + (A.h >> 2)) * 8 + ((r0 >> 6) & 1) * 4 + (2 * (h3 & 1) + (kk >> 1))) * 16 + ((r0 >> 7) & 1) * 8 + ((r0 >> 4) & 3) * 2 + (h3 >> 1)) * 512) + (2 * (kk & 1)) * 128);
        f.k[kk] = ldg16(A.K + uoff + A.lk); }
#pragma unroll
    for (int dj = 0; dj < 4; ++dj) { const int dblk = dj >> 1, j = dj & 1;
        const unsigned uoff = (unsigned)(((((((A.h >> 2) * (M / 256) + (r0 >> 8)) * 8 + (h3 & 1) * 4 + ((r0 >> 5) & 3)) * 16 + (h3 >> 1) * 8 + dblk * 4 + ((r0 >> 7) & 1)) * 512) + (2 * j) * 128));
        f.v[dj] = ldg16(A.V + uoff + A.lv); }
}
__device__ __forceinline__ void att_tile(const KVFrag& f, const bf16x8 (&qf)[4], f32x16& o0, f32x16& o1, float& carry, bool diag, int l31, int hl) {
    f32x16 s;
#pragma unroll
    for (int r = 0; r < 16; ++r) s[r] = 0.f;
#pragma unroll
    for (int kk = 0; kk < 4; ++kk) s = MFMA32(f.k[kk], qf[kk], s);
    float kp[16], bt[16];
    float lo = 1.f, hi = 1.f;
#pragma unroll
    for (int r = 0; r < 16; ++r) {
        const int ko = (r < 8) ? (8 * hl + r) : (16 + 8 * hl + (r - 8));
        const float e = __builtin_amdgcn_exp2f(s[r]);
        float k = __builtin_amdgcn_rcpf(1.0f + e);
        float b = e * k;
        if (e > 3.0e38f) b = 1.0f;
        if (diag && ko >= l31) { k = 1.f; b = 0.f; }
        kp[r] = k; bt[r] = b;
        if (r < 8) lo *= k; else hi *= k;
    }
    const float plo = __shfl_xor(lo, 32), phi = __shfl_xor(hi, 32);
    const float after_lo = (hl == 0) ? (plo * hi * phi) : (hi * phi);
    const float after_hi = (hl == 0) ? phi : 1.f;
    float w[16];
    { float run = carry * after_lo;
#pragma unroll
      for (int r = 7; r >= 0; --r) { w[r] = bt[r] * run; run *= kp[r]; } }
    { float run = carry * after_hi;
#pragma unroll
      for (int r = 15; r >= 8; --r) { w[r] = bt[r] * run; run *= kp[r]; } }
    carry *= (lo * hi) * (plo * phi);
    v4u w0, w1;
    w0.x = pk2(w[0], w[1]); w0.y = pk2(w[2], w[3]); w0.z = pk2(w[4], w[5]); w0.w = pk2(w[6], w[7]);
    w1.x = pk2(w[8], w[9]); w1.y = pk2(w[10], w[11]); w1.z = pk2(w[12], w[13]); w1.w = pk2(w[14], w[15]);
    const bf16x8 W0 = __builtin_bit_cast(bf16x8, w0), W1 = __builtin_bit_cast(bf16x8, w1);
    o0 = MFMA32(f.v[0], W0, o0); o0 = MFMA32(f.v[1], W1, o0);
    o1 = MFMA32(f.v[2], W0, o1); o1 = MFMA32(f.v[3], W1, o1);
}
__device__ __forceinline__ void attn_task(const bf16* __restrict__ Q, const bf16* __restrict__ Kp, const bf16* __restrict__ Vt, bf16* __restrict__ Y, int b, int h, int qb, int lane) {
    const int l31 = lane & 31, hl = lane >> 5;
    const int t0 = qb * 32; const size_t tb = (size_t)b * SEQ;
    const int a_ = l31 >> 3, hh = (l31 >> 2) & 1, c_ = l31 & 3;
    const int pim = 16 * (a_ >> 1) + 8 * hh + 4 * (a_ & 1) + c_;
    AttAddr A; A.K = Kp; A.V = Vt; A.tb = (int)tb; A.h = h;
    A.lk = (unsigned)((pim >> 4) * 1024 + (hl * 16 + (pim & 15)) * 8);
    A.lv = (unsigned)((l31 >> 4) * 1024 + (hl * 16 + (l31 & 15)) * 8);
    bf16x8 qf[4];
    { const int r0 = (int)tb + t0, h3 = h & 3; const unsigned lq = (unsigned)((l31 >> 4) * 1024 + (hl * 16 + (l31 & 15)) * 8);
#pragma unroll
      for (int kk = 0; kk < 4; ++kk) {
          const unsigned uoff = (unsigned)((((((r0 >> 8) * 2 + (h >> 2)) * 8 + ((r0 >> 6) & 1) * 4 + (2 * (h3 & 1) + (kk >> 1))) * 16 + ((r0 >> 7) & 1) * 8 + ((r0 >> 4) & 3) * 2 + (h3 >> 1)) * 512) + (2 * (kk & 1)) * 128);
          qf[kk] = ldg16(Q + uoff + lq); } }
    f32x16 o0, o1;
#pragma unroll
    for (int r = 0; r < 16; ++r) { o0[r] = 0.f; o1[r] = 0.f; }
    float carry = 1.f;
    int key0 = t0;
    KVFrag b0, b1, b2;
    att_load(b0, A, key0); att_load(b1, A, key0 - 32);
    bool diag = true;
#define ATT_STEP(cur, pre) { att_load(pre, A, key0 - 64); att_tile(cur, qf, o0, o1, carry, diag, l31, hl); diag = false; \
        if (key0 - 32 < 0) break; if (__all(carry < 0x1p-64f)) break; key0 -= 32; }
    for (;;) { ATT_STEP(b0, b2) ATT_STEP(b1, b0) ATT_STEP(b2, b1) }
#undef ATT_STEP
    bf16* yrow = Y + (tb + t0 + l31) * 512 + h * 64 + 4 * hl;
#pragma unroll
    for (int a = 0; a < 4; ++a) {
        v2u p0, p1; p0.x = pk2(o0[4 * a], o0[4 * a + 1]); p0.y = pk2(o0[4 * a + 2], o0[4 * a + 3]); p1.x = pk2(o1[4 * a], o1[4 * a + 1]); p1.y = pk2(o1[4 * a + 2], o1[4 * a + 3]);
        *(GAS v2u*)(yrow + 8 * a) = p0; *(GAS v2u*)(yrow + 32 + 8 * a) = p1;
    }
}

__device__ __forceinline__ void pool_unpack(const v4u v, float (&f)[8]) { f[0] = bflo(v.x); f[1] = bfhi(v.x); f[2] = bflo(v.y); f[3] = bfhi(v.y); f[4] = bflo(v.z); f[5] = bfhi(v.z); f[6] = bflo(v.w); f[7] = bfhi(v.w); }
__device__ __forceinline__ void pool_item(const bf16* __restrict__ U, bf16* __restrict__ P, int tok0, int lane) {
    const int t0 = tok0 & (SEQ - 1); const int g = lane >> 4; const int w = 2 << g;
    v4u row[31];
#pragma unroll
    for (int r = 0; r < 31; ++r) { const int rr = (t0 == 0 && r < 15) ? 15 : r; row[r] = *(const GAS v4u*)(U + (size_t)(tok0 - 15 + rr) * 512 + 8 * lane); }
    if (t0 == 0) {
#pragma unroll
        for (int r = 0; r < 15; ++r) row[r] = (v4u){0u, 0u, 0u, 0u};
    }
    float S[8], f[8];
    pool_unpack(row[15], S); pool_unpack(row[14], f);
#pragma unroll
    for (int q = 0; q < 8; ++q) S[q] += f[q];
    float acc4[8], acc8[8], acc16[8];
#pragma unroll
    for (int q = 0; q < 8; ++q) acc4[q] = S[q];
#pragma unroll
    for (int r = 13; r >= 12; --r) { pool_unpack(row[r], f);
#pragma unroll
        for (int q = 0; q < 8; ++q) acc4[q] += f[q]; }
#pragma unroll
    for (int q = 0; q < 8; ++q) acc8[q] = acc4[q];
#pragma unroll
    for (int r = 11; r >= 8; --r) { pool_unpack(row[r], f);
#pragma unroll
        for (int q = 0; q < 8; ++q) acc8[q] += f[q]; }
#pragma unroll
    for (int q = 0; q < 8; ++q) acc16[q] = acc8[q];
#pragma unroll
    for (int r = 7; r >= 0; --r) { pool_unpack(row[r], f);
#pragma unroll
        for (int q = 0; q < 8; ++q) acc16[q] += f[q]; }
#pragma unroll
    for (int q = 0; q < 8; ++q) S[q] = (g == 0) ? S[q] : (g == 1 ? acc4[q] : (g == 2 ? acc8[q] : acc16[q]));
#pragma unroll
    for (int i = 0; i < 16; ++i) {
        float cur[8]; pool_unpack(row[15 + i], cur);
        if (i > 0) {
            const v4u lv = (g == 0) ? row[15 + i - 2] : (g == 1 ? row[15 + i - 4] : (g == 2 ? row[15 + i - 8] : row[15 + i - 16]));
            pool_unpack(lv, f);
#pragma unroll
            for (int q = 0; q < 8; ++q) S[q] += cur[q] - f[q];
        }
        const int t = t0 + i; const int cnt = (t + 1) < w ? (t + 1) : w; const float inv = 1.0f / (float)cnt;
        v4u o; o.x = pk2(S[0] * inv - cur[0], S[1] * inv - cur[1]); o.y = pk2(S[2] * inv - cur[2], S[3] * inv - cur[3]);
        o.z = pk2(S[4] * inv - cur[4], S[5] * inv - cur[5]); o.w = pk2(S[6] * inv - cur[6], S[7] * inv - cur[7]);
        *(GAS v4u*)(P + (size_t)(tok0 + i) * 512 + 8 * lane) = o;
    }
}

__device__ __forceinline__ void router_task(const bf16* __restrict__ X1, const bf16* __restrict__ WrF, const float* __restrict__ b_router, int T0, int lane,
                                            const float* __restrict__ SSQP_, float* __restrict__ R2_, unsigned char* __restrict__ H2, int* __restrict__ TKE_, float* __restrict__ TKW_, LAS int* lds_e  ) {
    const int l31 = lane & 31, hl = lane >> 5;
    const bf16* xr = X1 + (size_t)(T0 + l31) * 1024 + 8 * hl;
    f32x16 acc;
#pragma unroll
    for (int r = 0; r < 16; ++r) acc[r] = 0.f;
    float ssq = 0.f;
    { const GAS f32x4* sp = (const GAS f32x4*)(SSQP_ + (size_t)(T0 + l31) * 16);
#pragma unroll
      for (int j = 0; j < 4; ++j) { const f32x4 t = sp[j]; ssq += (t[0] + t[1]) + (t[2] + t[3]); } }
    const float r = 1.0f / sqrtf(ssq * (1.f / D) + EPS);
    unsigned char* hr = H2 + (size_t)(T0 + l31) * 1024 + 8 * hl;
#pragma unroll 8
    for (int kk = 0; kk < 64; ++kk) {
        const v4u xv = *(const GAS v4u*)(xr + 16 * kk);
        const bf16x8 ah = ldg16(WrF + ((size_t)kk * 64 + lane) * 8), al = ldg16(WrF + 32768 + ((size_t)kk * 64 + lane) * 8);
        v2u o; o.x = pk4_fp8(bflo(xv.x) * r, bfhi(xv.x) * r, bflo(xv.y) * r, bfhi(xv.y) * r); o.y = pk4_fp8(bflo(xv.z) * r, bfhi(xv.z) * r, bflo(xv.w) * r, bfhi(xv.w) * r);
        *(GAS v2u*)(hr + 16 * kk) = o;
        const bf16x8 xb = __builtin_bit_cast(bf16x8, xv);
        acc = MFMA32(ah, xb, acc); acc = MFMA32(al, xb, acc);
    }
    float v[16];
#pragma unroll
    for (int q = 0; q < 16; ++q) { const int e = 8 * (q >> 2) + 4 * hl + (q & 3); v[q] = acc[q] * r + b_router[e]; }
    float cv[8]; int ce[8];
#pragma unroll
    for (int k = 0; k < 4; ++k) {
        float best = -3.0e38f; int bi = 0;
#pragma unroll
        for (int q = 0; q < 16; ++q) { if (v[q] > best) { best = v[q]; bi = q; } }
        cv[k] = best; ce[k] = 8 * (bi >> 2) + 4 * hl + (bi & 3);
#pragma unroll
        for (int q = 0; q < 16; ++q) { if (q == bi) v[q] = -3.0e38f; }
    }
#pragma unroll
    for (int k = 0; k < 4; ++k) { cv[4 + k] = __shfl_xor(cv[k], 32); ce[4 + k] = __shfl_xor(ce[k], 32); }
    float tv[4]; int te[4];
#pragma unroll
    for (int k = 0; k < 4; ++k) {
        float best = -3.0e38f; int be = 1 << 20; int bi = 0;
#pragma unroll
        for (int q = 0; q < 8; ++q) { if (cv[q] > best || (cv[q] == best && ce[q] < be)) { best = cv[q]; be = ce[q]; bi = q; } }
        tv[k] = best; te[k] = be;
#pragma unroll
        for (int q = 0; q < 8; ++q) { if (q == bi) { cv[q] = -3.0e38f; ce[q] = 1 << 21; } }
    }
    const float p1 = __expf(tv[1] - tv[0]), p2 = __expf(tv[2] - tv[0]), p3 = __expf(tv[3] - tv[0]);
    const float inv = 1.0f / (1.0f + p1 + p2 + p3);
    if (hl == 0) {
        const int tok = T0 + l31;
        R2_[tok] = r;
        *(GAS v4i*)(TKE_ + (size_t)tok * 4) = (v4i){te[0], te[1], te[2], te[3]};
        *(GAS f32x4*)(TKW_ + (size_t)tok * 4) = (f32x4){inv, p1 * inv, p2 * inv, p3 * inv};
        lds_e[l31 * 4 + 0] = te[0]; lds_e[l31 * 4 + 1] = te[1]; lds_e[l31 * 4 + 2] = te[2]; lds_e[l31 * 4 + 3] = te[3];
    }
}


#define IN_(i) (args.in[i])
#define x_ IN_(0)
#define p_in IN_(1)
#define g_mix IN_(2)
#define w_in IN_(3)
#define w_pool_grp IN_(4)
#define pool_scale IN_(5)
#define w_pool_up IN_(6)
#define w_attn_up IN_(7)
#define w_out IN_(8)
#define g_ffn IN_(9)
#define w_router IN_(10)
#define b_router IN_(11)
#define w_gu IN_(12)
#define b_gu IN_(13)
#define w_down IN_(14)
#define b_down IN_(15)
#define g_ple IN_(16)
#define w_ple_gate IN_(17)
#define w_ple_proj IN_(18)
#define g_final IN_(19)
#define WSP(T, off) ((T*)(args.ws + (off)))
#define R2 WSP(float, WS_R2)
#define R3 WSP(float, WS_R3)
#define TKE WSP(int, WS_TKE)
#define TKW WSP(float, WS_TKW)
#define TKR WSP(int, WS_TKR)
#define ROWT WSP(int, WS_ROWT)
#define CNTWG WSP(int, WS_CNTWG)
#define SEGTOT WSP(int, WS_SEGTOT)
#define CUR WSP(int, WS_CUR)
#define ROWREL WSP(int, WS_ROWREL)
#define WRF WSP(bf16, WS_WRF)
#define WIN WSP(bf16, WS_WIN)
#define WEFF WSP(bf16, WS_WEFF)
#define WAU WSP(bf16, WS_WAU)
#define WOUT WSP(bf16, WS_WOUT)
#define WPG WSP(unsigned char, WS_WPG)
#define X2F8 WSP(unsigned char, WS_H2F8)
#define WPP WSP(bf16, WS_WPP)
#define WGU WSP(unsigned char, WS_WGU)
#define WDN WSP(unsigned char, WS_WDN)
#define H2F8 WSP(unsigned char, WS_H2F8)
#define TKS WSP(int, WS_TKS)
#define H1 WSP(bf16, WS_A)
#define H1F8 WSP(unsigned char, WS_H2F8)
#define WG8 WSP(unsigned char, WS_WG8)
#define MRG WSP(bf16, WS_C)
#define PPB WSP(bf16, WS_A)
#define UB WSP(bf16, WS_B)
#define QB WSP(bf16, WS_B + 64 * MiB)
#define X1 WSP(bf16, WS_B)
#define KB WSP(bf16, WS_C)
#define VT WSP(bf16, WS_C + 64 * MiB)
#define X2 WSP(bf16, WS_B)
#define POOL WSP(bf16, WS_E)
#define YATT WSP(bf16, WS_E + 64 * MiB)
#define X3 WSP(bf16, WS_E)
#define PB WSP(bf16, WS_PB)
#define GPB WSP(bf16, WS_G)
#define GAB WSP(bf16, WS_G + 128 * MiB)
#define XB ((bf16*)args.out)
#define ACT WSP(unsigned char, WS_ACT)

__global__ void __launch_bounds__(NWAVES * 64, 2) mk_fwd(Args args) {
    extern __shared__ __attribute__((aligned(16))) unsigned char lds[];
    Frame F;
    F.lds = (LAS unsigned char*)lds;
    F.MISC = (volatile LAS unsigned*)(F.lds + MISC_OFF);
    F.wave = __builtin_amdgcn_readfirstlane((int)threadIdx.x >> 6);
    F.G = gridDim.x; { const int bx = blockIdx.x; F.vcu = (F.G % 8 == 0) ? (bx % 8) * (F.G / 8) + bx / 8 : bx; }
    unsigned char* ws = args.ws;
    F.ctl = (gu32*)(ws + WS_CTL);
    for (int u = (int)threadIdx.x; u < (LDS_BYTES - LDSCTL_OFF) / 4; u += NWAVES * 64) ((LAS unsigned*)(F.lds + LDSCTL_OFF))[u] = 0u;
    __syncthreads();
    const int lo = args.ph_lo, hi = args.ph_hi;
    XcdBarrier bar; bar.bar = (unsigned*)(F.ctl + CW_BAR); bar.x = 0; bar.st = nullptr;
    if (hi - lo > 1) bar = xcd_barrier_post((unsigned*)(F.ctl + CW_BAR), F.MISC + 8, F.wave);
#define IN(k) (lo <= (k) && (k) < hi)
#define BOTH(k) (IN(k) && IN((k) + 1))
#define GRID_BAR() xcd_barrier(bar, F.wave)

    const int gw = F.vcu * NWAVES + F.wave, NGW = F.G * NWAVES;
    LAS int* ltab = (LAS int*)(F.lds + LDS_TAB_OFF);

    if (IN(0)) { for (int rep_ = 0; rep_ < REPS(0); ++rep_) {
        const int lane_ = lane_id_v(), tid_ = F.wave * 64 + lane_;
        LAS float* scr = (LAS float*)(F.lds + F.wave * 16384);
        constexpr int I_IN = 16 * 128, I_AU = 8 * 32, I_OUT = 16 * 32, I_PG = 16 * 32, I_PP = 4 * 32, I_GU = 32 * 16 * 64, I_DN = 32 * 16 * 32;
        constexpr int NITEMS = I_IN + I_AU + I_OUT + I_PG + I_PP + I_GU + I_DN;
        for (int it = gw; it < NITEMS; it += NGW) {
            int r = it;
            if (r < I_IN) { const int kb = r / 128, nb = r % 128, n0 = nb * 32;
                const int blk = n0 / 512;
                if (blk >= 4) { p0_transpose_item<true>(w_in, 4096, kb * 64, n0, WG8, 1024, n0 - 2048, nullptr, WSCALE, scr, lane_); continue; }
                const int dst = (blk < 3) ? n0 : 3584 + (n0 - 1536);
                p0_transpose_item<false>(w_in, 4096, kb * 64, n0, WIN, 1024, dst, nullptr, 1.0f, scr, lane_); continue; } r -= I_IN;
            if (r < I_AU) { const int kb = r / 32, nb = r % 32; p0_transpose_item<false>(w_attn_up, 1024, kb * 64, nb * 32, WAU, 512, nb * 32, nullptr, 1.0f, scr, lane_); continue; } r -= I_AU;
            if (r < I_OUT) { const int kb = r / 32, nb = r % 32; p0_transpose_item<false>(w_out, 1024, kb * 64, nb * 32, WOUT, 1024, nb * 32, nullptr, 1.0f, scr, lane_); continue; } r -= I_OUT;
            if (r < I_PG) { const int kb = r / 32, nb = r % 32; p0_transpose_item<true>(w_ple_gate, 1024, kb * 64, nb * 32, WPG, 1024, nb * 32, g_ple, WSCALE, scr, lane_); continue; } r -= I_PG;
            if (r < I_PP) { const int kb = r / 32, nb = r % 32; p0_transpose_item<false>(w_ple_proj, 1024, kb * 64, nb * 32, WPP, 256, nb * 32, nullptr, 1.0f, scr, lane_); continue; } r -= I_PP;
            if (r < I_GU) { const int e = r / 1024, q = r % 1024, kb = q / 64, nb = q % 64, n0 = nb * 32;
                const int j = n0 & 1023; const int dst = 256 * (j / 128) + (j % 128) + (n0 >= 1024 ? 128 : 0);
                p0_transpose_item<true>(w_gu + (size_t)e * 1024 * 2048, 2048, kb * 64, n0, WGU + (size_t)e * 2048 * 1024, 1024, dst, g_ffn, WSCALE, scr, lane_); continue; } r -= I_GU;
            { const int e = r / 512, q = r % 512, kb = q / 32, nb = q % 32;
                p0_transpose_item<true>(w_down + (size_t)e * 1024 * 1024, 1024, kb * 64, nb * 32, WDN + (size_t)e * 1024 * 1024, 1024, nb * 32, nullptr, WSCALE, scr, lane_); }
        }
        for (int it = gw; it < 4 * 16 * 16; it += NGW) {
            const int g = it >> 8, cb = (it >> 4) & 15, db = it & 15; const int d = db * 64 + lane_, c0 = cb * 8;
            float a8[8];
#pragma unroll
            for (int q = 0; q < 8; ++q) a8[q] = 0.f;
            for (int j = 0; j < 128; ++j) { const float wv = w_pool_up[(size_t)(g * 128 + j) * 1024 + d] * pool_scale[g * 128 + j];
#pragma unroll
                for (int q = 0; q < 8; ++q) a8[q] += w_pool_grp[(size_t)(g * 128 + c0 + q) * 128 + j] * wv; }
            v4u o; o.x = pk2(a8[0], a8[1]); o.y = pk2(a8[2], a8[3]); o.z = pk2(a8[4], a8[5]); o.w = pk2(a8[6], a8[7]);
            *(GAS v4u*)(WEFF + (size_t)d * 512 + g * 128 + c0) = o;
        }
        for (int it = gw * 64 + lane_; it < 64 * 64; it += NGW * 64) {
            const int kk = it >> 6, l = it & 63, e = l & 31, k0 = 16 * kk + 8 * (l >> 5);
            unsigned hb[8], lb[8];
#pragma unroll
            for (int i = 0; i < 8; ++i) { const float v = g_ffn[k0 + i] * w_router[(size_t)(k0 + i) * 32 + e]; hb[i] = f2bf(v); lb[i] = f2bf(v - __builtin_bit_cast(float, hb[i] << 16)); }
            v4u oh, ol; oh.x = hb[0] | (hb[1] << 16); oh.y = hb[2] | (hb[3] << 16); oh.z = hb[4] | (hb[5] << 16); oh.w = hb[6] | (hb[7] << 16);
            ol.x = lb[0] | (lb[1] << 16); ol.y = lb[2] | (lb[3] << 16); ol.z = lb[4] | (lb[5] << 16); ol.w = lb[6] | (lb[7] << 16);
            *(GAS v4u*)(WRF + (size_t)it * 8) = oh; *(GAS v4u*)(WRF + 32768 + (size_t)it * 8) = ol;
        }
        for (int m = gw; m < M; m += NGW) rms_row_f32_to_bf16(x_ + (size_t)m * D, g_mix, H1 + (size_t)m * D, XB + (size_t)m * D, H1F8 + (size_t)m * D, lane_);
        for (size_t i = (size_t)gw * 64 + lane_; i < (size_t)M * PLE / 8; i += (size_t)NGW * 64) {
            const f32x4 a = *(const GAS f32x4*)(p_in + i * 8), b = *(const GAS f32x4*)(p_in + i * 8 + 4);
            *(GAS v4u*)(PB + i * 8) = pg8::pack8(a, b);
        }
        if (BOTH(0) || rep_ + 1 < REPS(0)) GRID_BAR();
    } }

    if (IN(1)) { for (int rep_ = 0; rep_ < REPS(1); ++rep_) {
        { pg8::Gemm g{H1, WIN, D}; pg8::StaticOrder S; S.init(M, 1536, F.G, (int)blockIdx.x);
          pg8::EpiProj E{UB, QB, KB};
          pg8::gemm_phase<pg8::EpiProj, pg8::StaticOrder, true>(F.lds, g, S, E, F.wave, STAGGER_P1); }
        { pg8::Gemm g{H1F8, WG8, D}; pg8::StaticOrder S; S.init(M, 2048, F.G, (int)blockIdx.x);
          pg8::EpiGate8 E{GPB, GAB};
          pg8::gemm_phase<pg8::EpiGate8, pg8::StaticOrder, true, 1>(F.lds, g, S, E, F.wave); }
        { pg8::Gemm g{WIN + (size_t)NPROJ_A * D, H1, D}; pg8::StaticOrder S; S.init(512, M, F.G, (int)blockIdx.x);
          pg8::EpiNative E{VT, M / 256};
          pg8::gemm_phase<pg8::EpiNative, pg8::StaticOrder, true>(F.lds, g, S, E, F.wave); }
        if (BOTH(1) || rep_ + 1 < REPS(1)) GRID_BAR();
    } }

    if (IN(2)) { for (int rep_ = 0; rep_ < REPS(2); ++rep_) {
        const int lane_ = lane_id_v(), tid_ = F.wave * 64 + lane_;
        for (int T = gw; T < NB * NH * (SEQ / 32); T += NGW) {
            const int qb = T & 127, h = (T >> 7) & 7, b = T >> 10;
            attn_task(QB, KB, VT, YATT, b, h, qb, lane_);
        }
        for (int it = gw; it < M / 16; it += NGW) pool_item(UB, POOL, it * 16, lane_);
        if (BOTH(2) || rep_ + 1 < REPS(2)) GRID_BAR();
    } }

    if (IN(3)) { for (int rep_ = 0; rep_ < REPS(3); ++rep_) {
        pg8::Gemm g{POOL, WEFF, PW}; pg8::DualOrder S; S.init(M, D, F.G, (int)blockIdx.x);
        pg8::EpiDual E{MRG, GPB, GAB};
        pg8::gemm_phase<pg8::EpiDual, pg8::DualOrder, true>(F.lds, g, S, E, F.wave);
        if (IN(5) || rep_ + 1 < REPS(3)) GRID_BAR();
    } }
    if (IN(5)) { for (int rep_ = 0; rep_ < REPS(5); ++rep_) {
        pg8::Gemm g{MRG, WOUT, D}; pg8::StaticOrder S; S.init(M, D, F.G, (int)blockIdx.x);
        pg8::EpiResid E{X1, XB, WSP(float, WS_SSQP)};
        pg8::gemm_phase<pg8::EpiResid, pg8::StaticOrder, true>(F.lds, g, S, E, F.wave);
        if (BOTH(5) || rep_ + 1 < REPS(5)) GRID_BAR();
    } }

    if (IN(6)) { for (int rep_ = 0; rep_ < REPS(6); ++rep_) {
        const int lane_ = lane_id_v(), tid_ = F.wave * 64 + lane_;
        LAS int* lcnt = ltab;
        LAS int* le = ltab + 128;
        for (int chunk = F.vcu; chunk < M / 256; chunk += F.G) {
            if (tid_ < 128) lcnt[tid_] = 0;
            router_task(X1, WRF, b_router, chunk * 256 + F.wave * 32, lane_, WSP(float, WS_SSQP), R2, H2F8, TKE, TKW, le + F.wave * 128);
            __syncthreads();
            v4i rk = {0, 0, 0, 0};
            if (tid_ < 256) {
#pragma unroll
                for (int k = 0; k < 4; ++k) rk[k] = __hip_atomic_fetch_add((int*)(lcnt + k * 32 + le[tid_ * 4 + k]), 1, __ATOMIC_RELAXED, __HIP_MEMORY_SCOPE_WORKGROUP);
            }
            __syncthreads();
            if (tid_ < 128) lcnt[tid_] = __hip_atomic_fetch_add(CUR + tid_, lcnt[tid_], RLX_AGENT);
            __syncthreads();
            if (tid_ < 256) {
                const int tok = chunk * 256 + tid_;
#pragma unroll
                for (int k = 0; k < 4; ++k) { const int sg = k * 32 + le[tid_ * 4 + k]; rk[k] += lcnt[sg]; ROWREL[(size_t)sg * 65536 + rk[k]] = tok; }
                *(GAS v4i*)(TKR + (size_t)tok * 4) = rk;
            }
            __syncthreads();
        }
        if (IN(8) || rep_ + 1 < REPS(6)) GRID_BAR();
    } }

    if (IN(8) || IN(9) || IN(16)) {
        const int tid_ = F.wave * 64 + lane_id_v();
        __syncthreads();
        if (tid_ < 32) {
            const int t0_ = CUR[tid_], t1_ = CUR[32 + tid_], t2_ = CUR[64 + tid_], t3_ = CUR[96 + tid_];
            const int cn = t0_ + t1_ + t2_ + t3_; int nt_ = (cn + 255) >> 8, pt = nt_, ps = cn;
#pragma unroll
            for (int o = 1; o < 32; o <<= 1) { const int a = __shfl_up(pt, o), b = __shfl_up(ps, o); if (tid_ >= o) { pt += a; ps += b; } }
            ltab[tid_] = pt - nt_; ltab[33 + tid_] = ps - cn; ltab[65 + tid_] = cn; if (tid_ == 31) ltab[32] = pt;
            ltab[98 + tid_] = t0_; ltab[130 + tid_] = t1_; ltab[162 + tid_] = t2_; ltab[194 + tid_] = t3_;
            ltab[226 + tid_] = ps - cn; ltab[258 + tid_] = ps - cn + t0_; ltab[290 + tid_] = ps - cn + t0_ + t1_; ltab[322 + tid_] = ps - cn + t0_ + t1_ + t2_; }
        __syncthreads();
    }
    {
        const int T = __builtin_amdgcn_readfirstlane(ltab[32]);
        if (IN(8)) { for (int rep_ = 0; rep_ < REPS(8); ++rep_) {
            pg8::Gemm g{H2F8, WGU, D};
            pg8::MoeOrder<true> S{ltab, ROWREL, WGU, 8, F.G, F.vcu, T * 8, (size_t)2048 * 1024};
            pg8::EpiMoe1 E{ACT, b_gu};
            pg8::gemm_phase<pg8::EpiMoe1, pg8::MoeOrder<true>, MOE_ALIGN, 1>(F.lds, g, S, E, F.wave, STAGGER_MOE);
            if (BOTH(8) || rep_ + 1 < REPS(8)) GRID_BAR();
        } }
        if (IN(9)) { for (int rep_ = 0; rep_ < REPS(9); ++rep_) {
            pg8::Gemm g{ACT, WDN, DE};
            pg8::MoeOrder<false> S{ltab, ROWREL, WDN, 4, F.G, F.vcu, T * 4, (size_t)1024 * 1024};
            pg8::EpiMoe2 E{WSP(unsigned char, WS_C), b_down};
            pg8::gemm_phase<pg8::EpiMoe2, pg8::MoeOrder<false>, MOE_ALIGN, 1>(F.lds, g, S, E, F.wave, STAGGER_MOE);
            if (IN(16) || rep_ + 1 < REPS(9)) GRID_BAR();
        } }
    }

    if (IN(16)) { for (int rep_ = 0; rep_ < REPS(16); ++rep_) {
        const int lane_ = lane_id_v();
        for (int t0 = gw * 4; t0 < M; t0 += NGW * 4) {
            v4i sl[4]; f32x4 tw[4];
#pragma unroll
            for (int i = 0; i < 4; ++i) { const v4i te_ = *(const GAS v4i*)(TKE + (size_t)(t0 + i) * 4), tr_ = *(const GAS v4i*)(TKR + (size_t)(t0 + i) * 4); tw[i] = *(const GAS f32x4*)(TKW + (size_t)(t0 + i) * 4);
#pragma unroll
                for (int k = 0; k < 4; ++k) sl[i][k] = ltab[226 + 32 * k + te_[k]] + tr_[k]; }
#pragma unroll
            for (int i = 0; i < 4; ++i) {
                bf16* xrow = X1 + (size_t)(t0 + i) * D;
                v4u xv[2], yv[4];
                xv[0] = ((const GAS v4u*)xrow)[2 * lane_]; xv[1] = ((const GAS v4u*)xrow)[2 * lane_ + 1];
#pragma unroll
                for (int k = 0; k < 4; ++k) yv[k] = ((const GAS v4u*)(WSP(unsigned char, WS_C) + (size_t)sl[i][k] * D))[lane_];
                float a[16];
                { f32x4 a0, a1, a2, a3; pg8::unpack8(xv[0], a0, a1); pg8::unpack8(xv[1], a2, a3);
#pragma unroll
                  for (int q = 0; q < 4; ++q) { a[q] = a0[q]; a[4 + q] = a1[q]; a[8 + q] = a2[q]; a[12 + q] = a3[q]; } }
#pragma unroll
                for (int k = 0; k < 4; ++k) { const float wk = tw[i][k]; const unsigned yy[4] = {yv[k].x, yv[k].y, yv[k].z, yv[k].w};
#pragma unroll
                    for (int q = 0; q < 4; ++q) { const f32x2 lo2 = __builtin_amdgcn_cvt_pk_f32_fp8((int)yy[q], false), hi2 = __builtin_amdgcn_cvt_pk_f32_fp8((int)yy[q], true);
                        a[4 * q + 0] += lo2[0] * wk; a[4 * q + 1] += lo2[1] * wk; a[4 * q + 2] += hi2[0] * wk; a[4 * q + 3] += hi2[1] * wk; } }
                v4u o0, o1; o0.x = pk2(a[0], a[1]); o0.y = pk2(a[2], a[3]); o0.z = pk2(a[4], a[5]); o0.w = pk2(a[6], a[7]); o1.x = pk2(a[8], a[9]); o1.y = pk2(a[10], a[11]); o1.z = pk2(a[12], a[13]); o1.w = pk2(a[14], a[15]);
                float b[16];
                { f32x4 b0, b1, b2, b3; pg8::unpack8(o0, b0, b1); pg8::unpack8(o1, b2, b3);
#pragma unroll
                  for (int q = 0; q < 4; ++q) { b[q] = b0[q]; b[4 + q] = b1[q]; b[8 + q] = b2[q]; b[12 + q] = b3[q]; } }
                float s = 0.f;
#pragma unroll
                for (int q = 0; q < 16; ++q) s += b[q] * b[q];
                ((GAS v4u*)xrow)[2 * lane_] = o0; ((GAS v4u*)xrow)[2 * lane_ + 1] = o1;
                v4u o8; o8.x = pk4_fp8(b[0], b[1], b[2], b[3]); o8.y = pk4_fp8(b[4], b[5], b[6], b[7]); o8.z = pk4_fp8(b[8], b[9], b[10], b[11]); o8.w = pk4_fp8(b[12], b[13], b[14], b[15]);
                ((GAS v4u*)(X2F8 + (size_t)(t0 + i) * D))[lane_] = o8;
                s = wave_sum(s);
                if (lane_ == 0) R3[t0 + i] = 1.0f / sqrtf(s * (1.f / D) + EPS);
            }
        }
        {
            pg8::Gemm g{PB, WPP, PLE}; pg8::StaticOrder S; S.init(M, D, F.G, (int)blockIdx.x);
            pg8::EpiNative E{PPB, 4};
            pg8::gemm_phase<pg8::EpiNative, pg8::StaticOrder, true>(F.lds, g, S, E, F.wave);
        }
        if (IN(18) || rep_ + 1 < REPS(16)) GRID_BAR();
    } }
    if (IN(18)) { for (int rep_ = 0; rep_ < REPS(18); ++rep_) {
        pg8::Gemm g{X2F8, WPG, D}; pg8::StaticOrder S; S.init(M, D, F.G, (int)blockIdx.x);
        pg8::EpiPle E{X3, X2, PPB, R3};
        pg8::gemm_phase<pg8::EpiPle, pg8::StaticOrder, true, 1>(F.lds, g, S, E, F.wave);
        if (BOTH(18) || rep_ + 1 < REPS(18)) GRID_BAR();
    } }
    if (IN(19)) { for (int rep_ = 0; rep_ < REPS(19); ++rep_) {
        const int lane_ = lane_id_v();
        for (int m = gw; m < M; m += NGW) {
            const GAS v4u* xr = (const GAS v4u*)(X3 + (size_t)m * D) + lane_; const GAS v4u* x2r = (const GAS v4u*)(X2 + (size_t)m * D) + lane_; float f[2][8]; float s = 0.f;
#pragma unroll
            for (int j = 0; j < 2; ++j) { const v4u v = xr[64 * j], w2 = x2r[64 * j]; f[j][0] = bflo(v.x) + bflo(w2.x); f[j][1] = bfhi(v.x) + bfhi(w2.x); f[j][2] = bflo(v.y) + bflo(w2.y); f[j][3] = bfhi(v.y) + bfhi(w2.y); f[j][4] = bflo(v.z) + bflo(w2.z); f[j][5] = bfhi(v.z) + bfhi(w2.z); f[j][6] = bflo(v.w) + bflo(w2.w); f[j][7] = bfhi(v.w) + bfhi(w2.w);
#pragma unroll
                for (int q = 0; q < 8; ++q) s += f[j][q] * f[j][q]; }
            s = wave_sum(s);
            const float r = 1.0f / sqrtf(s * (1.f / D) + EPS);
#pragma unroll
            for (int j = 0; j < 2; ++j) { const int c0 = (64 * j + lane_) * 8;
                const f32x4 g0 = *(const GAS f32x4*)(g_final + c0), g1 = *(const GAS f32x4*)(g_final + c0 + 4);
                f32x4 o0 = {f[j][0] * r * g0.x, f[j][1] * r * g0.y, f[j][2] * r * g0.z, f[j][3] * r * g0.w}, o1 = {f[j][4] * r * g1.x, f[j][5] * r * g1.y, f[j][6] * r * g1.z, f[j][7] * r * g1.w};
                *(GAS f32x4*)(args.out + (size_t)m * D + c0) = o0; *(GAS f32x4*)(args.out + (size_t)m * D + c0 + 4) = o1; }
        }
    } }
#undef IN
#undef BOTH
#undef GRID_BAR
}

extern "C" void kernel_launch(void* const* d_in, const int* in_sizes, int n_in, void* d_out, int out_size, void* d_ws, size_t ws_size, hipStream_t stream) {
    static int grid = 0;
    if (grid == 0) {
        if (n_in != 20 || out_size != M * D || ws_size < WS_END) { fprintf(stderr, "kernel_launch: unexpected shapes (n_in %d, out %d, ws %zu); nothing launched\n", n_in, out_size, ws_size); grid = -1; return; }
        int dev = 0, cus = 0, per_cu = 0;
        if (hipGetDevice(&dev) != hipSuccess || hipDeviceGetAttribute(&cus, hipDeviceAttributeMultiprocessorCount, dev) != hipSuccess) { grid = -1; return; }
        if (hipFuncSetAttribute((const void*)mk_fwd, hipFuncAttributeMaxDynamicSharedMemorySize, LDS_BYTES) != hipSuccess) { fprintf(stderr, "kernel_launch: hipFuncSetAttribute failed\n"); grid = -1; return; }
        if (hipOccupancyMaxActiveBlocksPerMultiprocessor(&per_cu, (const void*)mk_fwd, NWAVES * 64, LDS_BYTES) != hipSuccess || per_cu < 1)
            fprintf(stderr, "kernel_launch: note: occupancy query reports %d workgroups per CU\n", per_cu);
        (void)hipGetLastError();
        grid = cus;
    }
    if (grid < 0) return;
    if (hipMemsetAsync((char*)d_ws + WS_CTL, 0, CTL_ZERO_BYTES, stream) != hipSuccess) return;
    Args a{};
    for (int i = 0; i < 20; ++i) a.in[i] = (const float*)d_in[i];
    a.out = (float*)d_out; a.ws = (unsigned char*)d_ws;
#if MK_SPLIT
    for (int ph = 0; ph < NPH; ++ph) { a.ph_lo = ph; a.ph_hi = ph + 1; hipLaunchKernelGGL(mk_fwd, dim3(grid), dim3(NWAVES * 64), LDS_BYTES, stream, a); }
#else
    a.ph_lo = 0; a.ph_hi = NPH; hipLaunchKernelGGL(mk_fwd, dim3(grid), dim3(NWAVES * 64), LDS_BYTES, stream, a);
#endif
}
```
